# Optimizing an MI355X kernel written in HIP

```python
import math
import jax, jax.numpy as jnp
from jax import lax
import numpy as np

D_MODEL = 1024
BATCH = 32
SEQ = 256
DEPTH = 2
DEC_BATCH = 4
DEC_SEQ = 2048
PAST_LEN = 512

GRID_W = 64
D_HY = 512
HY_ORDER = 2
HY_EMB = 33
HY_FFN = 64
HY_FAST_DECAY = 0.3
HY_SLOW_DECAY = 1.5
HY_TARGET = 1e-2
AT_HEADS = 4
AT_DH = 64
AT_DV = 2 * AT_DH
D_AT = AT_HEADS * AT_DV
Q_BLOCK = 128
ROPE_BASE = 10000.0
D_PL = 512
POOL_WINDOWS = (2, 4, 8, 16)
POOL_GC = D_PL // 4
N_BRANCH = 3
NORM_EPS = 1e-6
IN_SPLITS = (3 * D_HY, D_HY, AT_HEADS * 2 * AT_DH, AT_HEADS * 2 * AT_DH, AT_HEADS * AT_DV, D_AT, D_PL, D_PL, N_BRANCH * D_MODEL)
D_IN = 3 * D_HY + D_HY + 2 * AT_HEADS * 2 * AT_DH + AT_HEADS * AT_DV + D_AT + 2 * D_PL + N_BRANCH * D_MODEL

kernel_name = "hybrid_hyena_diffattn_pool_dit_step"

F32 = jnp.float32


def rms_norm(x, g):
    xf = x.astype(F32)
    y = xf * lax.rsqrt(jnp.mean(xf * xf, axis=-1, keepdims=True) + NORM_EPS)
    return (y * g.astype(F32)).astype(x.dtype)


def short_conv_centred(u, w, b):
    L = u.shape[1]
    up = jnp.pad(u, ((0, 0), (1, 1), (0, 0)))
    return up[:, :L] * w[0] + up[:, 1:L + 1] * w[1] + up[:, 2:L + 2] * w[2] + b


def hyena_filter_spectrum(L, p):
    t = jnp.linspace(0.0, 1.0, L, dtype=F32)[:, None]
    bands = (HY_EMB - 1) // 2
    w = 2.0 * math.pi * jnp.arange(L, dtype=F32)[:, None] / L
    f = jnp.linspace(1e-4, bands - 1, bands, dtype=F32)[None, :]
    z = jnp.concatenate([t, jnp.cos(f * w), -jnp.sin(f * w)], axis=-1)
    fq = p['hy_freq'].astype(F32)
    h = jnp.sin(fq[0] * (z @ p['hy_f_w1'].astype(F32) + p['hy_f_b1'].astype(F32)))
    h = jnp.sin(fq[1] * (h @ p['hy_f_w2'].astype(F32) + p['hy_f_b2'].astype(F32)))
    h = (h @ p['hy_f_w3'].astype(F32)).reshape(L, 2, HY_ORDER, D_HY)
    max_decay = math.log(HY_TARGET) / HY_FAST_DECAY
    min_decay = math.log(HY_TARGET) / HY_SLOW_DECAY
    deltas = jnp.abs(jnp.linspace(min_decay, max_decay, D_HY, dtype=F32))
    h = h * jnp.exp(-t * deltas)[:, None, None, :]
    h_f, h_b = h[:, 0], h[:, 1]
    h_full = jnp.concatenate([h_f, jnp.zeros((1, HY_ORDER, D_HY), F32), h_b[1:][::-1]], axis=0)
    h_full = h_full / (jnp.sum(jnp.abs(h_full), axis=0, keepdims=True) + NORM_EPS)
    return jnp.fft.rfft(h_full, axis=0)


def long_conv(u, Hf, bias):
    L = u.shape[1]
    uf = u.astype(F32)
    U = jnp.fft.rfft(uf, n=2 * L, axis=1)
    y = jnp.fft.irfft(U * Hf[None], n=2 * L, axis=1)[:, :L]
    return (y + uf * bias.astype(F32)).astype(u.dtype)


def hyena_branch(proj, p):
    L = proj.shape[1]
    u = short_conv_centred(proj, p['hy_conv_w'], p['hy_conv_b'])
    x1, x2, v = jnp.split(u, 3, axis=-1)
    Hf = hyena_filter_spectrum(L, p)
    y = x1 * long_conv(v, Hf[:, 0], p['hy_bias'][0])
    y = x2 * long_conv(y, Hf[:, 1], p['hy_bias'][1])
    return y


def axial_rope_tables(L):
    rows = L // GRID_W
    row = jnp.repeat(jnp.arange(rows), GRID_W).astype(F32)
    col = jnp.tile(jnp.arange(GRID_W), rows).astype(F32)
    half = AT_DH // 2
    inv = 1.0 / (ROPE_BASE ** (jnp.arange(0, half, 2, dtype=F32) / half))
    ang = jnp.concatenate([row[:, None] * inv, col[:, None] * inv], axis=-1)
    return jnp.cos(ang), jnp.sin(ang)


def apply_axial_rope(x, cos, sin):
    xf = x.astype(F32)
    xp = xf.reshape(x.shape[:-1] + (AT_DH // 2, 2))
    a, b = xp[..., 0], xp[..., 1]
    c = cos[None, :, None, None, :]
    s = sin[None, :, None, None, :]
    out = jnp.stack([a * c - b * s, a * s + b * c], axis=-1).reshape(x.shape)
    return out.astype(x.dtype)


def diff_attention(q, k, v, lam):
    B, Lq = q.shape[:2]
    nb = Lq // Q_BLOCK
    qb = q.astype(F32).reshape(B, nb, Q_BLOCK, AT_HEADS, 2, AT_DH).transpose(1, 0, 2, 3, 4, 5)
    kf = k.astype(F32)
    vf = v.astype(F32)
    scale = AT_DH ** -0.5

    def one_block(qblk):
        s = jnp.einsum('bqhcd,bkhcd->bhcqk', qblk, kf) * scale
        pr = jax.nn.softmax(s, axis=-1)
        w = pr[:, :, 0] - lam * pr[:, :, 1]
        return jnp.einsum('bhqk,bkhe->bqhe', w, vf)

    o = lax.map(one_block, qb)
    return o.transpose(1, 0, 2, 3, 4).reshape(B, Lq, AT_HEADS, AT_DV).astype(v.dtype)


def attn_branch(q, k, v, p, lam, lam_init, rope, ctx_k, ctx_v):
    B, L = q.shape[:2]
    q = rms_norm(q.reshape(B, L, AT_HEADS, 2, AT_DH), p['q_norm_g'])
    k = rms_norm(k.reshape(B, L, AT_HEADS, 2, AT_DH), p['k_norm_g'])
    v = v.reshape(B, L, AT_HEADS, AT_DV)
    kv_out = (k, v)
    if rope is None:
        keys, vals = k, v
    else:
        q = apply_axial_rope(q, rope[0], rope[1])
        k = apply_axial_rope(k, rope[0], rope[1])
        keys = jnp.concatenate([k, ctx_k.astype(k.dtype)], axis=1)
        vals = jnp.concatenate([v, ctx_v.astype(v.dtype)], axis=1)
    o = diff_attention(q, keys, vals, lam)
    o = rms_norm(o, p['subln_g']) * (1.0 - lam_init)
    return o.reshape(B, L, D_AT), kv_out


def pool_branch(u, p):
    B, L, _ = u.shape
    uf = u.astype(F32)
    cs = jnp.concatenate([jnp.zeros((B, 1, D_PL), F32), jnp.cumsum(uf, axis=1)], axis=1)
    t = jnp.arange(L)
    means = []
    for g, w in enumerate(POOL_WINDOWS):
        lo = jnp.clip(t - w // 2, 0, L)
        hi = jnp.clip(t + w // 2, 0, L)
        csg = cs[:, :, g * POOL_GC:(g + 1) * POOL_GC]
        means.append((csg[:, hi] - csg[:, lo]) / (hi - lo).astype(F32)[None, :, None])
    m = (jnp.concatenate(means, axis=-1) - uf).reshape(B, L, 4, POOL_GC)
    y = jnp.einsum('blgc,gcd->blgd', m, p['pool_w'].astype(F32)).reshape(B, L, D_PL)
    return (y * p['pool_scale'].astype(F32)).astype(u.dtype)


def trunk_layer(x, cond, p, lam, lam_init, rope, ctx_k, ctx_v):
    B, L, _ = x.shape
    mod = jax.nn.silu(cond) @ p['w_ada'] + p['b_ada']
    shift, scale, gate = jnp.split(mod[:, None, :], 3, axis=-1)
    h = rms_norm(x, p['norm_g']) * (1.0 + scale) + shift
    proj = h @ p['w_in']
    cuts = np.cumsum(IN_SPLITS)[:-1].tolist()
    hy_u, hy_z, q, k, v, at_z, pl_u, pl_z, mg = jnp.split(proj, cuts, axis=-1)
    y_hy = hyena_branch(hy_u, p) * jax.nn.silu(hy_z)
    y_at, kv = attn_branch(q, k, v, p, lam, lam_init, rope, ctx_k, ctx_v)
    y_at = y_at * jax.nn.silu(at_z)
    y_pl = pool_branch(pl_u, p) * jax.nn.silu(pl_z)
    r = jax.nn.sigmoid(mg).reshape(B, L, N_BRANCH, D_MODEL)
    merged = (r[:, :, 0] * (y_hy @ p['w_hy_o'])
              + r[:, :, 1] * (y_at @ p['w_at_o'])
              + r[:, :, 2] * (y_pl @ p['w_pl_o']))
    out = merged @ p['w_out']
    return x + gate * out, kv


def setup_inputs(seed: int = 0) -> dict:
    key = jax.random.key(seed)
    ks = iter(jax.random.split(key, 40))

    def nrm(shape, s):
        return jax.random.normal(next(ks), shape, F32) * s

    D = D_MODEL
    return {
        'x_prompt': nrm((BATCH, SEQ, D), 1.0),
        'x_sample': nrm((DEC_BATCH, DEC_SEQ, D), 1.0),
        'cache_k': nrm((DEC_BATCH, DEPTH, PAST_LEN, AT_HEADS, 2, AT_DH), 1.0),
        'cache_v': nrm((DEC_BATCH, DEPTH, PAST_LEN, AT_HEADS, AT_DV), 1.0),
        'c': nrm((DEC_BATCH, D), 1.0),
        'c_ctx': nrm((D,), 1.0),
        'norm_g': 1.0 + nrm((DEPTH, D), 0.05),
        'w_ada': nrm((DEPTH, D, 3 * D), 0.5 * D ** -0.5),
        'b_ada': nrm((DEPTH, 3 * D), 0.02),
        'w_in': nrm((DEPTH, D, D_IN), D ** -0.5),
        'hy_conv_w': nrm((DEPTH, 3, 3 * D_HY), 0.5),
        'hy_conv_b': nrm((DEPTH, 3 * D_HY), 0.02),
        'hy_f_w1': nrm((DEPTH, HY_EMB, HY_FFN), HY_EMB ** -0.5),
        'hy_f_b1': nrm((DEPTH, HY_FFN), 0.1),
        'hy_f_w2': nrm((DEPTH, HY_FFN, HY_FFN), HY_FFN ** -0.5),
        'hy_f_b2': nrm((DEPTH, HY_FFN), 0.1),
        'hy_f_w3': nrm((DEPTH, HY_FFN, 2 * HY_ORDER * D_HY), HY_FFN ** -0.5),
        'hy_freq': 1.0 + nrm((DEPTH, 2, HY_FFN), 0.1),
        'hy_bias': nrm((DEPTH, HY_ORDER, D_HY), 0.5),
        'q_norm_g': 1.0 + nrm((DEPTH, AT_DH), 0.05),
        'k_norm_g': 1.0 + nrm((DEPTH, AT_DH), 0.05),
        'lam_q': nrm((DEPTH, 2, AT_DH), 0.1),
        'lam_k': nrm((DEPTH, 2, AT_DH), 0.1),
        'subln_g': 1.0 + nrm((DEPTH, AT_DV), 0.05),
        'pool_w': nrm((DEPTH, 4, POOL_GC, POOL_GC), POOL_GC ** -0.5),
        'pool_scale': 1.0 + nrm((DEPTH, D_PL), 0.1),
        'w_hy_o': nrm((DEPTH, D_HY, D), D_HY ** -0.5),
        'w_at_o': nrm((DEPTH, D_AT, D), D_AT ** -0.5),
        'w_pl_o': nrm((DEPTH, D_PL, D), D_PL ** -0.5),
        'w_out': nrm((DEPTH, D, D), D ** -0.5),
    }


def reference(x_prompt, x_sample, cache_k, cache_v, c, c_ctx, norm_g, w_ada, b_ada, w_in,
              hy_conv_w, hy_conv_b, hy_f_w1, hy_f_b1, hy_f_w2, hy_f_b2, hy_f_w3, hy_freq, hy_bias,
              q_norm_g, k_norm_g, lam_q, lam_k, subln_g, pool_w, pool_scale,
              w_hy_o, w_at_o, w_pl_o, w_out):
    rope = axial_rope_tables(x_sample.shape[1])
    yp = x_prompt
    ys = x_sample
    new_ks = []
    new_vs = []
    for l in range(DEPTH):
        p = dict(norm_g=norm_g[l], w_ada=w_ada[l], b_ada=b_ada[l], w_in=w_in[l],
                 hy_conv_w=hy_conv_w[l], hy_conv_b=hy_conv_b[l], hy_f_w1=hy_f_w1[l], hy_f_b1=hy_f_b1[l],
                 hy_f_w2=hy_f_w2[l], hy_f_b2=hy_f_b2[l], hy_f_w3=hy_f_w3[l], hy_freq=hy_freq[l],
                 hy_bias=hy_bias[l], q_norm_g=q_norm_g[l], k_norm_g=k_norm_g[l], subln_g=subln_g[l],
                 pool_w=pool_w[l], pool_scale=pool_scale[l], w_hy_o=w_hy_o[l], w_at_o=w_at_o[l],
                 w_pl_o=w_pl_o[l], w_out=w_out[l])
        lam_init = 0.8 - 0.6 * math.exp(-0.3 * l)
        lq = lam_q[l].astype(F32)
        lk = lam_k[l].astype(F32)
        lam = jnp.exp(jnp.sum(lq[0] * lk[0])) - jnp.exp(jnp.sum(lq[1] * lk[1])) + lam_init
        yp, (k_l, v_l) = trunk_layer(yp, c_ctx[None, :], p, lam, lam_init, None, None, None)
        new_ks.append(k_l)
        new_vs.append(v_l)
        ys, _ = trunk_layer(ys, c, p, lam, lam_init, rope, cache_k[:, l], cache_v[:, l])
    new_k = jnp.stack(new_ks, axis=1)
    new_v = jnp.stack(new_vs, axis=1)
    return (yp, ys, new_k, new_v)
```

```cpp
#include <hip/hip_runtime.h>
#include <hip/hip_cooperative_groups.h>
#include <cstdio>
#include <cstdint>
namespace cg = cooperative_groups;
namespace pg8 {
#define PG8_LAS __attribute__((address_space(3)))
typedef unsigned short bf16_t;
typedef short bf16x8 __attribute__((ext_vector_type(8)));
typedef float f32x4 __attribute__((ext_vector_type(4)));
typedef unsigned u32x4 __attribute__((ext_vector_type(4)));
constexpr int BM = 256, BK = 64, HALF = 128, HTB = HALF * BK * 2  , STAGE_BYTES = 8 * HTB, NXCD = 8, WGM = 8;

__host__ __device__ __forceinline__ int lds_byte(int r, int c) { const int st = (r >> 4) * 2 + (c >> 5), rr = r & 15, cc = c & 31, ob = rr * 64 + cc * 2; return st * 1024 + (ob ^ (((ob >> 9) & 1) << 5)); }
__host__ __device__ __forceinline__ void stage_rc(int b, int& R, int& C) { const int st = b / 1024, sb = b % 1024, swz = sb ^ (((sb >> 9) & 1) << 5); R = (st >> 1) * 16 + swz / 64; C = (st & 1) * 32 + (swz % 64) / 2; }
__host__ __device__ __forceinline__ int perm32(int rho) { const int n = rho >> 4, i = rho & 15; return 8 * (i >> 2) + 4 * n + (i & 3); }

struct Unit { int pm, pn; };
struct Gemm { const bf16_t* A; const bf16_t* Bt; int M, N, K; };

struct StaticOrder {
    int nM, nN, nwg, G, c;
    __host__ __device__ void init(int M, int N, int G_, int c_) { nM = M / BM; nN = N / BM; nwg = nM * nN; G = G_; c = c_; }
    __host__ __device__ bool next(int i, Unit& u) const {
        const long L = (long)i * G + c; if (L >= nwg) return false;
        int wgid = (int)L; { const int q = nwg / NXCD, r = nwg % NXCD, xcd = wgid % NXCD, off = wgid / NXCD; wgid = (xcd < r ? xcd * (q + 1) : r * (q + 1) + (xcd - r) * q) + off; }
        const int nig = WGM * nN, gid = wgid / nig, fm = gid * WGM, gsz = (nM - fm) < WGM ? (nM - fm) : WGM;
        u.pm = fm + ((wgid % nig) % gsz); u.pn = (wgid % nig) / gsz; return true;
    }
    __device__ __forceinline__ void a_ready(const Unit&) const {}
    __device__ __forceinline__ void done(const Unit&) const {}
};

__device__ __forceinline__ unsigned cvt_pk_bf16(float lo, float hi) { unsigned r; asm volatile("v_cvt_pk_bf16_f32 %0, %1, %2" : "=v"(r) : "v"(lo), "v"(hi)); return r; }
typedef float f32x2 __attribute__((ext_vector_type(2)));
template <class Epi, class Sched, bool ALIGN_EPI = false, bool SP2 = false>
__device__ __forceinline__ void gemm_phase(PG8_LAS unsigned char* lds, const Gemm g, const Sched& S, const Epi& E) {
    int tid_l = threadIdx.x; asm volatile("" : "+v"(tid_l)); const int tid = tid_l, wid = __builtin_amdgcn_readfirstlane(tid >> 6), lane = tid & 63, wr = wid >> 2, wc = wid & 3, fr = lane & 15, fq = lane >> 4;
    const int K = g.K, nt = K / BK;
    unsigned voffA[2], voffB[2];
#pragma unroll
    for (int i = 0; i < 2; ++i) { int R, C; stage_rc(tid * 16 + i * 8192, R, C); const int Rb = Epi::PERM ? ((R & ~31) + perm32(R & 31)) : R;
        voffA[i] = (unsigned)(R * K + C) * 2u; voffB[i] = (unsigned)(Rb * K + C) * 2u; }
    const size_t kstep = (size_t)(BK * 2);
    const size_t hstep = (size_t)HALF * K * 2;
    const size_t tstep = 2 * hstep;
    const unsigned ldsw = (unsigned)wid * 1024u;
    const int aoff = lds_byte(wr * 64 + fr, fq * 8), boff = lds_byte(wc * 32 + fr, fq * 8);
#define PG8_SA(b, h) (((b) * 2 + (h)) * HTB)
#define PG8_SB(b, h) ((4 + (b) * 2 + (h)) * HTB)
#define PG8_STAGE(bufoff, gbase, voff) do { _Pragma("unroll") for (int _i = 0; _i < 2; ++_i) \
        __builtin_amdgcn_global_load_lds((const unsigned*)((const char*)(gbase) + (voff)[_i]), (PG8_LAS unsigned*)(lds + (bufoff) + ldsw + _i * 8192), 16, 0, 0); } while (0)
#define PG8_LDA(dst, b, h) do { _Pragma("unroll") for (int m = 0; m < 4; ++m) _Pragma("unroll") for (int k = 0; k < 2; ++k) dst[m][k] = *(const PG8_LAS bf16x8*)(lds + PG8_SA(b, h) + aoff + m * 2048 + k * 1024); } while (0)
#define PG8_LDB(dst, b, h) do { _Pragma("unroll") for (int n = 0; n < 2; ++n) _Pragma("unroll") for (int k = 0; k < 2; ++k) dst[n][k] = *(const PG8_LAS bf16x8*)(lds + PG8_SB(b, h) + boff + n * 2048 + k * 1024); } while (0)
#define PG8_MMA(ai, bj, At, Bt) do { __builtin_amdgcn_s_setprio(1); _Pragma("unroll") for (int m = 0; m < 4; ++m) _Pragma("unroll") for (int n = 0; n < 2; ++n) _Pragma("unroll") for (int k = 0; k < 2; ++k) \
        acc[ai][bj][m][n] = __builtin_amdgcn_mfma_f32_16x16x32_bf16(Bt[n][k], At[m][k], acc[ai][bj][m][n], 0, 0, 0); __builtin_amdgcn_s_setprio(0); } while (0)
#define PG8_WAIT_V(n) asm volatile("s_waitcnt vmcnt(" #n ")" ::: "memory")
#define PG8_WAIT_L(n) asm volatile("s_waitcnt lgkmcnt(" #n ")" ::: "memory")
#define PG8_BAR __builtin_amdgcn_s_barrier()
#define PG8_SCHED __builtin_amdgcn_sched_barrier(0)
    Unit cur, nxt; int ui = 0;
    if (!S.next(0, cur)) return;
    f32x4 acc[2][2][4][2];
#pragma unroll
    for (int a = 0; a < 2; ++a)
#pragma unroll
        for (int b = 0; b < 2; ++b)
#pragma unroll
            for (int m = 0; m < 4; ++m)
#pragma unroll
                for (int n = 0; n < 2; ++n) acc[a][b][m][n] = (f32x4){0.f, 0.f, 0.f, 0.f};
    bf16x8 At[4][2], B0[2][2], B1[2][2];
    const char* cA = (const char*)g.A + (size_t)cur.pm * tstep; const char* cB = (const char*)g.Bt + (size_t)cur.pn * tstep;
    S.a_ready(cur);
    if constexpr (SP2) {
        PG8_STAGE(PG8_SB(0, 0), cB, voffB); PG8_STAGE(PG8_SB(0, 1), cB + hstep, voffB); PG8_STAGE(PG8_SA(0, 0), cA, voffA); PG8_STAGE(PG8_SA(0, 1), cA + hstep, voffA);
        if (wr == 1) PG8_BAR;
        PG8_WAIT_V(2); PG8_BAR;
        PG8_STAGE(PG8_SB(1, 0), cB + kstep, voffB); PG8_STAGE(PG8_SA(1, 0), cA + kstep, voffA); PG8_STAGE(PG8_SB(1, 1), cB + hstep + kstep, voffB);
        PG8_WAIT_V(6); PG8_BAR;
    } else {
        PG8_STAGE(PG8_SB(0, 0), cB, voffB); PG8_STAGE(PG8_SA(0, 0), cA, voffA); PG8_STAGE(PG8_SB(0, 1), cB + hstep, voffB); PG8_STAGE(PG8_SA(0, 1), cA + hstep, voffA);
        if (wr == 1) PG8_BAR;
        PG8_WAIT_V(4); PG8_BAR;
        PG8_STAGE(PG8_SB(1, 0), cB + kstep, voffB); PG8_STAGE(PG8_SA(1, 0), cA + kstep, voffA); PG8_STAGE(PG8_SB(1, 1), cB + hstep + kstep, voffB);
        PG8_WAIT_V(6); PG8_BAR;
    }
    for (;;) {
        const bool has_next = S.next(ui + 1, nxt);
        const char* nA = has_next ? (const char*)g.A + (size_t)nxt.pm * tstep : cA; const char* nB = has_next ? (const char*)g.Bt + (size_t)nxt.pn * tstep : cB;
        for (int t = 0; t < nt; t += 2) {
            const bool last = (t == nt - 2);
            const char* a1 = cA + (size_t)(t + 1) * kstep;
            const char* a2 = last ? nA : cA + (size_t)(t + 2) * kstep; const char* b2 = last ? nB : cB + (size_t)(t + 2) * kstep;
            const char* a3 = a2 + kstep; const char* b3 = b2 + kstep;
            if (last && has_next) S.a_ready(nxt);
            if constexpr (SP2) {
            PG8_LDB(B0, 0, 0); PG8_LDB(B1, 0, 1); PG8_SCHED; PG8_LDA(At, 0, 0); PG8_STAGE(PG8_SA(1, 1), a1 + hstep, voffA);
            PG8_WAIT_V(8); PG8_WAIT_L(0); PG8_BAR; PG8_MMA(0, 0, At, B0); PG8_MMA(0, 1, At, B1); PG8_BAR; PG8_SCHED;
            PG8_LDA(At, 0, 1); PG8_STAGE(PG8_SB(0, 0), b2, voffB); PG8_STAGE(PG8_SB(0, 1), b2 + hstep, voffB); PG8_STAGE(PG8_SA(0, 0), a2, voffA);
            PG8_WAIT_V(8); PG8_WAIT_L(0); PG8_BAR; PG8_MMA(1, 0, At, B0); PG8_MMA(1, 1, At, B1); PG8_BAR; PG8_SCHED;
            PG8_LDB(B0, 1, 0); PG8_LDB(B1, 1, 1); PG8_SCHED; PG8_LDA(At, 1, 0); PG8_STAGE(PG8_SA(0, 1), a2 + hstep, voffA);
            PG8_WAIT_V(8); PG8_WAIT_L(0); PG8_BAR; PG8_MMA(0, 0, At, B0); PG8_MMA(0, 1, At, B1); PG8_BAR; PG8_SCHED;
            PG8_LDA(At, 1, 1); PG8_STAGE(PG8_SB(1, 0), b3, voffB); PG8_STAGE(PG8_SB(1, 1), b3 + hstep, voffB); PG8_STAGE(PG8_SA(1, 0), a3, voffA);
            PG8_WAIT_V(8); PG8_WAIT_L(0); PG8_BAR; PG8_MMA(1, 0, At, B0); PG8_MMA(1, 1, At, B1); PG8_BAR; PG8_SCHED;
            } else {
            PG8_LDB(B0, 0, 0); PG8_SCHED; PG8_LDA(At, 0, 0); PG8_STAGE(PG8_SA(1, 1), a1 + hstep, voffA);
            PG8_WAIT_L(8); PG8_BAR; PG8_WAIT_L(0); PG8_MMA(0, 0, At, B0); PG8_BAR; PG8_SCHED;
            PG8_LDB(B1, 0, 1); PG8_STAGE(PG8_SB(0, 0), b2, voffB);
            PG8_BAR; PG8_WAIT_L(0); PG8_MMA(0, 1, At, B1); PG8_BAR;
            PG8_LDA(At, 0, 1); PG8_STAGE(PG8_SA(0, 0), a2, voffA);
            PG8_BAR; PG8_WAIT_L(0); PG8_MMA(1, 0, At, B0); PG8_BAR; PG8_SCHED;
            PG8_STAGE(PG8_SB(0, 1), b2 + hstep, voffB);
            PG8_WAIT_V(6); PG8_BAR; PG8_MMA(1, 1, At, B1); PG8_BAR;
            PG8_LDB(B0, 1, 0); PG8_SCHED; PG8_LDA(At, 1, 0); PG8_STAGE(PG8_SA(0, 1), a2 + hstep, voffA);
            PG8_WAIT_L(8); PG8_BAR; PG8_WAIT_L(0); PG8_MMA(0, 0, At, B0); PG8_BAR; PG8_SCHED;
            PG8_LDB(B1, 1, 1); PG8_STAGE(PG8_SB(1, 0), b3, voffB);
            PG8_BAR; PG8_WAIT_L(0); PG8_MMA(0, 1, At, B1); PG8_BAR;
            PG8_LDA(At, 1, 1); PG8_STAGE(PG8_SA(1, 0), a3, voffA);
            PG8_BAR; PG8_WAIT_L(0); PG8_MMA(1, 0, At, B0); PG8_BAR; PG8_SCHED;
            PG8_STAGE(PG8_SB(1, 1), b3 + hstep, voffB);
            PG8_WAIT_V(6); PG8_BAR; PG8_MMA(1, 1, At, B1); PG8_BAR;
            }
        }
        if constexpr (ALIGN_EPI) { if (wr == 0) PG8_BAR; }
        if constexpr (!Epi::AFTER_DRAIN) { E(acc, cur, wr, wc, fr, fq); S.done(cur); }
        if (!has_next) break;
#pragma unroll
        for (int a = 0; a < 2; ++a)
#pragma unroll
            for (int b = 0; b < 2; ++b)
#pragma unroll
                for (int m = 0; m < 4; ++m)
#pragma unroll
                    for (int n = 0; n < 2; ++n) acc[a][b][m][n] = (f32x4){0.f, 0.f, 0.f, 0.f};
        cur = nxt; cA = nA; cB = nB; ++ui;
        if constexpr (ALIGN_EPI) { if (wr == 1) PG8_BAR; }
    }
    PG8_WAIT_V(0);
    if constexpr (!ALIGN_EPI) { if (wr == 0) PG8_BAR; }
    PG8_BAR;
    if constexpr (Epi::AFTER_DRAIN) { E.fused(acc, cur, wr, wc, fr, fq, lds, wid, lane); S.done(cur); }
#undef PG8_SA
#undef PG8_SB
#undef PG8_STAGE
#undef PG8_LDA
#undef PG8_LDB
#undef PG8_MMA
#undef PG8_WAIT_V
#undef PG8_WAIT_L
#undef PG8_BAR
#undef PG8_SCHED
}
}

#define LAS __attribute__((address_space(3)))
typedef unsigned short bf16;
typedef unsigned v4u __attribute__((ext_vector_type(4)));
typedef unsigned v2u __attribute__((ext_vector_type(2)));
typedef float f32x4 __attribute__((ext_vector_type(4)));
typedef float f32x2 __attribute__((ext_vector_type(2)));
typedef float f32x16 __attribute__((ext_vector_type(16)));
typedef short bf16x8 __attribute__((ext_vector_type(8)));
#define DI __device__ __forceinline__
#define MFMA32(a, b, c) __builtin_amdgcn_mfma_f32_32x32x16_bf16((a), (b), (c), 0, 0, 0)
#define MFMA16(a, b, c) __builtin_amdgcn_mfma_f32_16x16x32_bf16((a), (b), (c), 0, 0, 0)

constexpr int LDS_BYTES = 147456;
constexpr int NTOK = 16384, NPT = 8192, DM = 1024, DIN = 8192;
constexpr size_t MiB = 1u << 20;
constexpr size_t WS_LAM = 4096;
constexpr size_t WS_MOD = 1 * MiB;
constexpr size_t WS_ROPE = 1 * MiB + 256 * 1024;
constexpr size_t WS_POOLT = 1 * MiB + 768 * 1024;
constexpr size_t WS_WINT = 2 * MiB;
constexpr size_t WS_WOT = 18 * MiB;
constexpr size_t WS_WOUT3 = 21 * MiB;
constexpr size_t WS_HRAW = 27 * MiB;
constexpr size_t WS_H = 36 * MiB;
constexpr size_t WS_YHY = 68 * MiB;
constexpr size_t WS_ATZ = 84 * MiB;
constexpr size_t WS_PLZ = 100 * MiB;
constexpr size_t WS_PLU = 116 * MiB;
constexpr size_t WS_HYT = 132 * MiB;
constexpr size_t WS_Q = 196 * MiB;
constexpr size_t WS_K = 212 * MiB;
constexpr size_t WS_VT = 230 * MiB;
constexpr size_t WS_BBUF = 132 * MiB;
constexpr size_t WS_END = 248 * MiB;

struct Params { const float* in[30]; float* out; unsigned char* ws; };

DI unsigned f2bf(float f) { unsigned u = __builtin_bit_cast(unsigned, f); return (u + 0x7fffu + ((u >> 16) & 1u)) >> 16; }
DI unsigned pk2(float lo, float hi) { return f2bf(lo) | (f2bf(hi) << 16); }
DI float bf2f(unsigned h) { return __builtin_bit_cast(float, h << 16); }
DI float bflo(unsigned w) { return __builtin_bit_cast(float, w << 16); }
DI float bfhi(unsigned w) { return __builtin_bit_cast(float, w & 0xffff0000u); }
DI float siluf(float x) { return x * __builtin_amdgcn_rcpf(1.f + __expf(-x)); }
DI float sigmf(float x) { return __builtin_amdgcn_rcpf(1.f + __expf(-x)); }
#define LDS_WAIT() asm volatile("s_waitcnt lgkmcnt(0)" ::: "memory")

DI void tr_item(const float* src, size_t lds_, bf16* dst, size_t ldd, LAS float* scr, int lane) {
#pragma unroll 8
    for (int i = 0; i < 32; ++i) { const int kk = 2 * i + (lane >> 5); scr[kk * 33 + (lane & 31)] = src[(size_t)kk * lds_ + (lane & 31)]; }
    LDS_WAIT(); asm volatile("" ::: "memory");
    const int c = lane & 7;
#pragma unroll
    for (int j = 0; j < 4; ++j) { const int n = (lane >> 3) + 8 * j; const LAS float* s = scr + (8 * c) * 33 + n;
        v4u o; o.x = pk2(s[0 * 33], s[1 * 33]); o.y = pk2(s[2 * 33], s[3 * 33]); o.z = pk2(s[4 * 33], s[5 * 33]); o.w = pk2(s[6 * 33], s[7 * 33]);
        *(v4u*)(dst + (size_t)n * ldd + 8 * c) = o; }
    LDS_WAIT(); asm volatile("" ::: "memory");
}

DI void phase_a(const Params& P, LAS unsigned char* lds, int tid, int bid, int G) {
    const float* c = P.in[4]; const float* cctx = P.in[5]; const float* w_ada = P.in[7]; const float* b_ada = P.in[8];
    float* mod = (float*)(P.ws + WS_MOD);
    LAS float* sc = (LAS float*)lds; LAS float* red = sc + 5 * 1024;
    for (int it = bid; it < 96; it += G) {
        const int l = it / 48, n0 = (it % 48) * 64;
        for (int idx = tid; idx < 5 * 1024; idx += 512) { const int r = idx >> 10, k = idx & 1023; const float cv = r == 0 ? cctx[k] : c[(r - 1) * 1024 + k]; sc[idx] = cv / (1.f + __expf(-cv)); }
        __syncthreads();
        const int kg = tid >> 6, col = tid & 63; float acc[5] = {0.f, 0.f, 0.f, 0.f, 0.f};
        for (int k = kg * 128; k < kg * 128 + 128; ++k) { const float w = w_ada[((size_t)l * 1024 + k) * 3072 + n0 + col];
#pragma unroll
            for (int r = 0; r < 5; ++r) acc[r] += sc[r * 1024 + k] * w; }
#pragma unroll
        for (int r = 0; r < 5; ++r) red[(kg * 5 + r) * 64 + col] = acc[r];
        __syncthreads();
        if (tid < 320) { const int r = tid >> 6; float s = b_ada[l * 3072 + n0 + col];
#pragma unroll
            for (int g = 0; g < 8; ++g) s += red[(g * 5 + r) * 64 + col];
            mod[(l * 5 + r) * 3072 + n0 + col] = s; }
        __syncthreads();
    }
    float* rc = (float*)(P.ws + WS_ROPE); float* rs = rc + 2048 * 32;
    for (int idx = bid * 512 + tid; idx < 2048 * 32; idx += G * 512) {
        const int pos = idx >> 5, i = idx & 31; const int row = pos >> 6, colp = pos & 63;
        const float inv = expf(-(float)(i & 15) * (9.210340371976184f / 16.f));
        const float ang = (float)(i < 16 ? row : colp) * inv;
        rc[idx] = cosf(ang); rs[idx] = sinf(ang);
    }
    if (bid == 0 && tid < 2) {
        const int l = tid; const float* lq = P.in[21] + l * 128; const float* lk = P.in[22] + l * 128; float s0 = 0.f, s1 = 0.f;
        for (int i = 0; i < 64; ++i) { s0 += lq[i] * lk[i]; s1 += lq[64 + i] * lk[64 + i]; }
        const float lam_init = 0.8f - 0.6f * expf(-0.3f * (float)l);
        ((float*)(P.ws + WS_LAM))[l] = expf(s0) - expf(s1) + lam_init;
    }
}

DI void hraw_item(const Params& P, LAS unsigned char* lds, int l, int stream, int t0, int tid) {
    const int L = stream ? 2048 : 256;
    const float* w1 = P.in[12] + l * 33 * 64; const float* b1 = P.in[13] + l * 64; const float* w2 = P.in[14] + l * 64 * 64; const float* b2 = P.in[15] + l * 64;
    const float* w3 = P.in[16] + (size_t)l * 64 * 2048; const float* fq = P.in[17] + l * 128;
    bf16* out = (bf16*)(P.ws + WS_HRAW) + (stream ? 0 : (size_t)2 * 512 * 2 * 2048);
    LAS float* z = (LAS float*)lds; LAS float* h1 = z + 8 * 33 + 8; LAS float* h2 = h1 + 512;
    if (tid < 8 * 33) { const int pos = tid / 33, j = tid % 33; const int t = t0 + pos; float v;
        if (j == 0) v = (float)t / (float)(L - 1);
        else { const int b = (j - 1) & 15; const float f = 1e-4f + (float)b * ((15.f - 1e-4f) / 15.f); const float w = 6.283185307179586f * (float)t / (float)L;
               v = (j <= 16) ? cosf(f * w) : -sinf(f * w); }
        z[pos * 33 + j] = v; }
    __syncthreads();
    { const int pos = tid >> 6, n = tid & 63; float a = b1[n];
      for (int j = 0; j < 33; ++j) a += z[pos * 33 + j] * w1[j * 64 + n];
      h1[pos * 64 + n] = sinf(fq[n] * a); }
    __syncthreads();
    { const int pos = tid >> 6, n = tid & 63; float a = b2[n];
      for (int j = 0; j < 64; ++j) a += h1[pos * 64 + j] * w2[j * 64 + n];
      h2[pos * 64 + n] = sinf(fq[64 + n] * a); }
    __syncthreads();
#pragma unroll 1
    for (int jn = 0; jn < 4; ++jn) {
        const int n = tid + 512 * jn; float acc[8] = {0.f, 0.f, 0.f, 0.f, 0.f, 0.f, 0.f, 0.f};
        for (int k = 0; k < 64; ++k) { const float w = w3[k * 2048 + n];
#pragma unroll
            for (int p = 0; p < 8; ++p) acc[p] += h2[p * 64 + k] * w; }
        const int dir = n >> 10, o = (n >> 9) & 1, cc = n & 511;
        const float delta = 3.0701134573253944f + (float)cc * (12.280453829301578f / 511.f);
        float v[8];
#pragma unroll
        for (int p = 0; p < 8; ++p) { const float tn = (float)(t0 + p) / (float)(L - 1); v[p] = acc[p] * __expf(-tn * delta); }
        v4u w; w.x = pk2(v[0], v[1]); w.y = pk2(v[2], v[3]); w.z = pk2(v[4], v[5]); w.w = pk2(v[6], v[7]);
        *(v4u*)(out + ((size_t)((o * 512 + cc) * 2 + dir)) * L + t0) = w;
    }
    __syncthreads();
}

DI void phase_p0(const Params& P, LAS unsigned char* lds, int l, const float* xsrcP, const float* xsrcS, int tid, int lane, int wave, int bid, int G) {
    const int gw = bid * 8 + wave, NGW = G * 8;
    LAS float* scr = (LAS float*)(lds + wave * 16384);
    bf16* WinT = (bf16*)(P.ws + WS_WINT); bf16* WoT = (bf16*)(P.ws + WS_WOT); bf16* Wout3 = (bf16*)(P.ws + WS_WOUT3); bf16* poolT = (bf16*)(P.ws + WS_POOLT);
    const float* w_in = P.in[9] + (size_t)l * 1024 * 8192;
    constexpr int I_IN = 16 * 256, I_O = 3 * 256, I_OUT = 3 * 512, I_PL = 32, I_CV = 512;
    constexpr int NIT = I_IN + I_O + I_OUT + I_PL + I_CV;
    for (int it = gw; it < NIT; it += NGW) {
        int r = it;
        if (r < I_IN) { const int kb = r >> 8, nb = r & 255, n0 = nb * 32; int drow = n0;
            if (n0 >= 2048 && n0 < 3072) { const int tb = n0 & ~255, lb = (n0 >> 5) & 7; drow = tb + 128 * (lb & 1) + 32 * (lb >> 1); }
            tr_item(w_in + (size_t)(64 * kb) * 8192 + n0, 8192, WinT + (size_t)drow * 1024 + 64 * kb, 1024, scr, lane); continue; }
        r -= I_IN;
        if (r < I_O) { const int j = r >> 8, q = r & 255, kb = q >> 5, nb = q & 31; const float* W = (j == 0 ? P.in[26] : j == 1 ? P.in[27] : P.in[28]) + (size_t)l * 512 * 1024;
            tr_item(W + (size_t)(64 * kb) * 1024 + 32 * nb, 1024, WoT + (size_t)(j * 1024 + 32 * nb) * 512 + 64 * kb, 512, scr, lane); continue; }
        r -= I_O;
        if (r < I_OUT) { const int j = r >> 9, q = r & 511, kb = q >> 5, nb = q & 31; const float* W = P.in[29] + (size_t)l * 1024 * 1024;
            tr_item(W + (size_t)(64 * kb) * 1024 + 32 * nb, 1024, Wout3 + (size_t)(32 * nb) * 3072 + j * 1024 + 64 * kb, 3072, scr, lane); continue; }
        r -= I_OUT;
        if (r < I_PL) { const int g = r >> 3, q = r & 7, kb = q >> 2, nb = q & 3; const float* W = P.in[24] + (size_t)(l * 4 + g) * 16384;
            tr_item(W + (size_t)(64 * kb) * 128 + 32 * nb, 128, poolT + (size_t)g * 16384 + (size_t)(32 * nb) * 128 + 64 * kb, 128, scr, lane); continue; }
        r -= I_PL;
        { const int b = r >> 7, q = r & 127, h = q >> 5, q2 = q & 31, kb = q2 >> 2, nb = q2 & 3;
          const float* src = P.in[3] + ((size_t)(b * 2 + l) * 512 + 64 * kb) * 512 + h * 128 + 32 * nb;
          bf16* dst = (bf16*)(P.ws + WS_VT + 8 * MiB) + ((size_t)(b * 4 + h) * 128 + 32 * nb) * 2560 + 2048 + 64 * kb;
          tr_item(src, 512, dst, 2560, scr, lane); }
    }
    __syncthreads();
    { bf16* kS = (bf16*)(P.ws + WS_K + 8 * MiB);
      for (int idx = bid * 512 + tid; idx < 4 * 512 * 4 * 2 * 16; idx += G * 512) {
          const int d4 = idx & 15, map = (idx >> 4) & 1, h = (idx >> 5) & 3, p = (idx >> 7) & 511, b = idx >> 16;
          const f32x4 v = *(const f32x4*)(P.in[2] + ((((size_t)(b * 2 + l) * 512 + p) * 4 + h) * 2 + map) * 64 + d4 * 4);
          v2u w; w.x = pk2(v.x, v.y); w.y = pk2(v.z, v.w);
          *(v2u*)(kS + (((size_t)(b * 4 + h) * 2 + map) * 2560 + 2048 + p) * 64 + d4 * 4) = w; } }
    { const float* g = P.in[6] + l * 1024; const float* mod = (const float*)(P.ws + WS_MOD) + l * 5 * 3072; bf16* H = (bf16*)(P.ws + WS_H);
      for (int m = gw; m < NTOK; m += NGW) {
          const float* xr = m < NPT ? xsrcP + (size_t)m * 1024 : xsrcS + (size_t)(m - NPT) * 1024;
          const int r = m < NPT ? 0 : 1 + ((m - NPT) >> 11); const float* md = mod + r * 3072;
          f32x4 v[4]; float s = 0.f;
#pragma unroll
          for (int j = 0; j < 4; ++j) { v[j] = *(const f32x4*)(xr + 4 * lane + 256 * j); s += (v[j].x * v[j].x + v[j].y * v[j].y) + (v[j].z * v[j].z + v[j].w * v[j].w); }
#pragma unroll
          for (int o = 1; o < 64; o <<= 1) s += __shfl_xor(s, o);
          const float rstd = rsqrtf(s * (1.f / 1024.f) + 1e-6f);
#pragma unroll
          for (int j = 0; j < 4; ++j) { const int c0 = 4 * lane + 256 * j; const f32x4 gg = *(const f32x4*)(g + c0), sh = *(const f32x4*)(md + c0), scl = *(const f32x4*)(md + 1024 + c0);
              const f32x4 o = v[j] * rstd * gg * (scl + 1.f) + sh; v2u w; w.x = pk2(o.x, o.y); w.y = pk2(o.z, o.w);
              *(v2u*)(H + (size_t)m * 1024 + c0) = w; }
      } }
    for (int it = bid; it < 288; it += G) { const int stream = it < 256 ? 1 : 0; const int t0 = (stream ? it : it - 256) * 8; hraw_item(P, lds, l, stream, t0, tid); }
}

using pg8::Unit; using pg8::cvt_pk_bf16;
DI v4u pack8(f32x4 a, f32x4 b) { v4u w; w.x = cvt_pk_bf16(a[0], a[1]); w.y = cvt_pk_bf16(a[2], a[3]); w.z = cvt_pk_bf16(b[0], b[1]); w.w = cvt_pk_bf16(b[2], b[3]); return w; }
DI f32x4 silu4(f32x4 v) { return (f32x4){siluf(v[0]), siluf(v[1]), siluf(v[2]), siluf(v[3])}; }

struct EpiHyT {
    static constexpr bool PERM = true, AFTER_DRAIN = false; bf16* O;
    DI void operator()(const f32x4 (&acc)[2][2][4][2], const Unit& u, int wr, int wc, int fr, int fq) const {
        const bool act = u.pm >= 6; const int row0 = u.pm * 256 + wr * 64 + fr, col0 = u.pn * 256 + wc * 32 + 8 * fq;
#pragma unroll
        for (int ai = 0; ai < 2; ++ai)
#pragma unroll
            for (int m = 0; m < 4; ++m) { bf16* rowp = O + (size_t)(row0 + ai * 128 + m * 16) * NTOK + col0;
#pragma unroll
                for (int bj = 0; bj < 2; ++bj) { f32x4 v0 = acc[ai][bj][m][0], v1 = acc[ai][bj][m][1]; if (act) { v0 = silu4(v0); v1 = silu4(v1); }
                    *(v4u*)(rowp + bj * 128) = pack8(v0, v1); } }
    }
};

struct EpiB {
    static constexpr bool PERM = true, AFTER_DRAIN = false;
    int l; const float *gq, *gk, *ropec, *ropes; unsigned char* ws; float* newk; float* newv;
    DI void operator()(const f32x4 (&acc)[2][2][4][2], const Unit& u, int wr, int wc, int fr, int fq) const {
        const int pn = u.pn; const bool isS = u.pm >= 32;
        const int tok0 = u.pm * 256 + wr * 64 + fr;
        if (pn < 4) {
            const bool isk = pn >= 2; const int hd = 2 * (pn & 1) + (wc >> 1), map = wc & 1; const float* g = isk ? gk : gq;
            f32x4 gv[2][2];
#pragma unroll
            for (int bj = 0; bj < 2; ++bj)
#pragma unroll
                for (int n = 0; n < 2; ++n) gv[bj][n] = *(const f32x4*)(g + 32 * bj + 8 * fq + 4 * n);
            bf16* base = (bf16*)(ws + (isk ? WS_K : WS_Q) + (isS ? 8 * MiB : 0)); const int Lb = isS ? (isk ? 2560 : 2048) : 256;
#pragma unroll
            for (int ai = 0; ai < 2; ++ai)
#pragma unroll
                for (int m = 0; m < 4; ++m) {
                    const int tok = tok0 + ai * 128 + m * 16; int b, t; if (isS) { const int tt = tok - NPT; b = tt >> 11; t = tt & 2047; } else { b = tok >> 8; t = tok & 255; }
                    float ss = 0.f; f32x4 v[2][2];
#pragma unroll
                    for (int bj = 0; bj < 2; ++bj)
#pragma unroll
                        for (int n = 0; n < 2; ++n) { const f32x4 x = acc[ai][bj][m][n]; ss += (x[0] * x[0] + x[1] * x[1]) + (x[2] * x[2] + x[3] * x[3]); }
                    ss += __shfl_xor(ss, 16); ss += __shfl_xor(ss, 32);
                    const float rstd = rsqrtf(ss * (1.f / 64.f) + 1e-6f);
#pragma unroll
                    for (int bj = 0; bj < 2; ++bj)
#pragma unroll
                        for (int n = 0; n < 2; ++n) v[bj][n] = acc[ai][bj][m][n] * rstd * gv[bj][n];
                    if (isk && !isS) { float* nk = newk + ((size_t)(b * 2 + l) * 256 + t) * 512 + hd * 128 + map * 64 + 8 * fq;
#pragma unroll
                        for (int bj = 0; bj < 2; ++bj)
#pragma unroll
                            for (int n = 0; n < 2; ++n) *(f32x4*)(nk + 32 * bj + 4 * n) = v[bj][n]; }
                    if (isS) {
#pragma unroll
                        for (int bj = 0; bj < 2; ++bj)
#pragma unroll
                            for (int n = 0; n < 2; ++n) { const int i0 = 16 * bj + 4 * fq + 2 * n; const f32x2 cc = *(const f32x2*)(ropec + t * 32 + i0), sn = *(const f32x2*)(ropes + t * 32 + i0);
                                const f32x4 x = v[bj][n]; v[bj][n] = (f32x4){x[0] * cc.x - x[1] * sn.x, x[0] * sn.x + x[1] * cc.x, x[2] * cc.y - x[3] * sn.y, x[2] * sn.y + x[3] * cc.y}; }
                    }
                    if (!isk) {
#pragma unroll
                        for (int bj = 0; bj < 2; ++bj)
#pragma unroll
                            for (int n = 0; n < 2; ++n) v[bj][n] = v[bj][n] * 0.18033688011112042f;
                    }
                    bf16* dp = base + ((size_t)((b * 4 + hd) * 2 + map) * Lb + t) * 64 + 8 * fq;
#pragma unroll
                    for (int bj = 0; bj < 2; ++bj) *(v4u*)(dp + 32 * bj) = pack8(v[bj][0], v[bj][1]);
                }
        } else if (pn < 6) {
            bf16* vt = (bf16*)(ws + WS_VT + (isS ? 8 * MiB : 0)); const int Lk = isS ? 2560 : 256;
#pragma unroll
            for (int ai = 0; ai < 2; ++ai)
#pragma unroll
                for (int m = 0; m < 4; ++m) {
                    const int tok = tok0 + ai * 128 + m * 16; int b, t; if (isS) { const int tt = tok - NPT; b = tt >> 11; t = tt & 2047; } else { b = tok >> 8; t = tok & 255; }
#pragma unroll
                    for (int bj = 0; bj < 2; ++bj) { const int hd = 2 * (pn - 4) + bj;
#pragma unroll
                        for (int n = 0; n < 2; ++n) { const int dv = 32 * wc + 8 * fq + 4 * n; const f32x4 x = acc[ai][bj][m][n];
                            if (!isS) *(f32x4*)(newv + ((size_t)(b * 2 + l) * 256 + t) * 512 + hd * 128 + dv) = x;
                            bf16* vp = vt + ((size_t)(b * 4 + hd) * 128 + dv) * Lk + t;
#pragma unroll
                            for (int e = 0; e < 4; ++e) vp[(size_t)e * Lk] = (bf16)f2bf(x[e]); } }
                }
        } else {
            const int which = (pn - 6) >> 1; bf16* dst = (bf16*)(ws + (which == 0 ? WS_ATZ : which == 1 ? WS_PLU : WS_PLZ)); const bool act = which != 1;
            const int col0 = 256 * ((pn - 6) & 1) + 32 * wc + 8 * fq;
#pragma unroll
            for (int ai = 0; ai < 2; ++ai)
#pragma unroll
                for (int m = 0; m < 4; ++m) { bf16* rowp = dst + (size_t)(tok0 + ai * 128 + m * 16) * 512 + col0;
#pragma unroll
                    for (int bj = 0; bj < 2; ++bj) { f32x4 v0 = acc[ai][bj][m][0], v1 = acc[ai][bj][m][1]; if (act) { v0 = silu4(v0); v1 = silu4(v1); }
                        *(v4u*)(rowp + bj * 128) = pack8(v0, v1); } }
        }
    }
};

struct BrOrder {
    int G, c;
    DI bool next(int i, Unit& u) const { const int L = i * G + c; if (L >= 768) return false; const int j = L >> 8, r = L & 255; u.pm = j * 64 + (r >> 2); u.pn = j * 4 + (r & 3); return true; }
    DI void a_ready(const Unit&) const {}
    DI void done(const Unit&) const {}
};
struct EpiBr {
    static constexpr bool PERM = true, AFTER_DRAIN = false; bf16* O;
    DI void operator()(const f32x4 (&acc)[2][2][4][2], const Unit& u, int wr, int wc, int fr, int fq) const {
        const int row0 = (u.pm & 63) * 256 + wr * 64 + fr, col0 = u.pn * 256 + wc * 32 + 8 * fq;
#pragma unroll
        for (int ai = 0; ai < 2; ++ai)
#pragma unroll
            for (int m = 0; m < 4; ++m) { bf16* rowp = O + (size_t)(row0 + ai * 128 + m * 16) * 3072 + col0;
#pragma unroll
                for (int bj = 0; bj < 2; ++bj) *(v4u*)(rowp + bj * 128) = pack8(acc[ai][bj][m][0], acc[ai][bj][m][1]); }
    }
};
struct EpiGate {
    static constexpr bool PERM = true, AFTER_DRAIN = false; bf16* O;
    DI void operator()(const f32x4 (&acc)[2][2][4][2], const Unit& u, int wr, int wc, int fr, int fq) const {
        const int row0 = u.pm * 256 + wr * 64 + fr, col0 = u.pn * 256 + wc * 32 + 8 * fq;
#pragma unroll
        for (int ai = 0; ai < 2; ++ai)
#pragma unroll
            for (int m = 0; m < 4; ++m) { bf16* rowp = O + (size_t)(row0 + ai * 128 + m * 16) * 3072 + col0;
#pragma unroll
                for (int bj = 0; bj < 2; ++bj) { const v4u b = *(const v4u*)(rowp + bj * 128); const f32x4 g0 = acc[ai][bj][m][0], g1 = acc[ai][bj][m][1];
                    const f32x4 o0 = (f32x4){sigmf(g0[0]) * bflo(b.x), sigmf(g0[1]) * bfhi(b.x), sigmf(g0[2]) * bflo(b.y), sigmf(g0[3]) * bfhi(b.y)};
                    const f32x4 o1 = (f32x4){sigmf(g1[0]) * bflo(b.z), sigmf(g1[1]) * bfhi(b.z), sigmf(g1[2]) * bflo(b.w), sigmf(g1[3]) * bfhi(b.w)};
                    *(v4u*)(rowp + bj * 128) = pack8(o0, o1); } }
    }
};
struct EpiOut {
    static constexpr bool PERM = true, AFTER_DRAIN = false; const float* xP; const float* xS; float* out; const float* mod;
    DI void operator()(const f32x4 (&acc)[2][2][4][2], const Unit& u, int wr, int wc, int fr, int fq) const {
        const int row0 = u.pm * 256 + wr * 64 + fr, col0 = u.pn * 256 + wc * 32 + 8 * fq;
#pragma unroll
        for (int ai = 0; ai < 2; ++ai)
#pragma unroll
            for (int m = 0; m < 4; ++m) { const int row = row0 + ai * 128 + m * 16; const int r = row < NPT ? 0 : 1 + ((row - NPT) >> 11);
                const float* xr = (row < NPT ? xP + (size_t)row * 1024 : xS + (size_t)(row - NPT) * 1024) + col0; const float* gt = mod + r * 3072 + 2048 + col0; float* orow = out + (size_t)row * 1024 + col0;
#pragma unroll
                for (int bj = 0; bj < 2; ++bj)
#pragma unroll
                    for (int n = 0; n < 2; ++n) { const f32x4 x = *(const f32x4*)(xr + bj * 128 + 4 * n), g = *(const f32x4*)(gt + bj * 128 + 4 * n);
                        *(f32x4*)(orow + bj * 128 + 4 * n) = x + g * acc[ai][bj][m][n]; } }
    }
};

DI f32x4 conv4(const bf16* row, int s0, int t4, int L, float w0, float w1, float w2, float bias) {
    const bf16* p = row + s0 + t4; const v2u raw = *(const v2u*)p;
    const float x0 = bflo(raw.x), x1 = bfhi(raw.x), x2 = bflo(raw.y), x3 = bfhi(raw.y);
    const float xm = t4 > 0 ? bf2f(p[-1]) : 0.f, xp = (t4 + 4 < L) ? bf2f(p[4]) : 0.f;
    return (f32x4){w0 * xm + w1 * x0 + w2 * x1 + bias, w0 * x0 + w1 * x1 + w2 * x2 + bias, w0 * x1 + w1 * x2 + w2 * x3 + bias, w0 * x2 + w1 * x3 + w2 * xp + bias};
}

DI void hyena_job(const Params& P, LAS unsigned char* lds, int l, int stream, int c, int tid, int lane, int wave) {
    const int L = stream ? 2048 : 256, Bn = stream ? 4 : 32, NB = L / 16, tokbase = stream ? NPT : 0;
    const int RCS = 2 * L + 24;
    const int RCB = 8 * RCS * 2, UN = Bn * (L + 256) + 256, UB = UN * 2;
    LAS bf16* RC = (LAS bf16*)lds; LAS bf16* U1 = (LAS bf16*)(lds + RCB); LAS bf16* U2 = (LAS bf16*)(lds + RCB + UB);
    LAS bf16* Gt = (LAS bf16*)(lds + RCB + 2 * UB); LAS float* red = (LAS float*)(lds + RCB + 2 * UB + (2 * L + 64) * 2);
    const bf16* hyT = (const bf16*)(P.ws + WS_HYT);
    const bf16* rx1 = hyT + (size_t)c * NTOK; const bf16* rx2 = hyT + (size_t)(512 + c) * NTOK; const bf16* rv = hyT + (size_t)(1024 + c) * NTOK; const bf16* rz = hyT + (size_t)(1536 + c) * NTOK;
    const float* cw = P.in[10] + l * 3 * 1536; const float* cb = P.in[11] + l * 1536;
    const bf16* hraw = (const bf16*)(P.ws + WS_HRAW) + (stream ? 0 : (size_t)2 * 512 * 2 * 2048);
    for (int i = tid; i < (2 * UB) / 16; i += 512) ((LAS v4u*)U1)[i] = (v4u){0u, 0u, 0u, 0u};
    float nsum[2];
#pragma unroll
    for (int o = 0; o < 2; ++o) { const bf16* hp = hraw + (size_t)((o * 512 + c) * 2) * L; float s = 0.f;
        for (int i = tid; i < 2 * L; i += 512) { if (i != L) s += fabsf(bf2f(hp[i])); }
#pragma unroll
        for (int of = 1; of < 64; of <<= 1) s += __shfl_xor(s, of);
        nsum[o] = s; }
    if (lane == 0) { red[wave * 2] = nsum[0]; red[wave * 2 + 1] = nsum[1]; }
    __syncthreads();
    float inv[2];
#pragma unroll
    for (int o = 0; o < 2; ++o) { float s = 0.f;
#pragma unroll
        for (int w = 0; w < 8; ++w) s += red[w * 2 + o];
        inv[o] = 1.f / (s + 1e-6f); }
    { const float w0 = cw[1024 + c], w1 = cw[1536 + 1024 + c], w2 = cw[3072 + 1024 + c], bb = cb[1024 + c];
      for (int q = tid; q < Bn * L / 4; q += 512) { const int b = q / (L / 4), t4 = (q % (L / 4)) * 4; const f32x4 v = conv4(rv, tokbase + b * L, t4, L, w0, w1, w2, bb);
          v2u w; w.x = pk2(v[0], v[1]); w.y = pk2(v[2], v[3]); *(LAS v2u*)(U1 + 256 + b * (L + 256) + t4) = w; } }
    const int a = lane & 15, g = lane >> 4, gb = g & 1, gh = g >> 1;
    const int kap = (16 - a) & 7, A8 = (a + 7) & ~7;
    const int i0 = stream ? 16 * wave : 0, b0 = stream ? 0 : 4 * wave;
    const int mlo = i0 - NB, nks = (NB + 16) / 2;
    const int t4o = 16 * (i0 + a) + 4 * g;
#pragma unroll 1
    for (int o = 0; o < 2; ++o) {
        { const bf16* hf = hraw + (size_t)((o * 512 + c) * 2) * L; const bf16* hb = hf + L;
          for (int e = tid; e < 2 * L + 32; e += 512) { const int d = e - (L + 24); float v = 0.f; if (d >= 0 && d < L) v = bf2f(hf[d]) * inv[o]; else if (d < 0 && d > -L) v = bf2f(hb[-d]) * inv[o]; Gt[e] = (bf16)f2bf(v); } }
        __syncthreads();
        for (int q = tid; q < 8 * (RCS / 4); q += 512) { const int k = q / (RCS / 4), y = (q % (RCS / 4)) * 4; const int e = (L - y - k) + (L + 24);
            unsigned short v0 = 0, v1 = 0, v2 = 0, v3 = 0;
            if (e >= 0 && e < 2 * L + 32) v0 = Gt[e];
            if (e - 1 >= 0 && e - 1 < 2 * L + 32) v1 = Gt[e - 1];
            if (e - 2 >= 0 && e - 2 < 2 * L + 32) v2 = Gt[e - 2];
            if (e - 3 >= 0 && e - 3 < 2 * L + 32) v3 = Gt[e - 3];
            v2u w; w.x = (unsigned)v0 | ((unsigned)v1 << 16); w.y = (unsigned)v2 | ((unsigned)v3 << 16); *(LAS v2u*)(RC + k * RCS + y) = w; }
        __syncthreads();
        LAS bf16* U = o == 0 ? U1 : U2;
        f32x4 acc[4];
#pragma unroll
        for (int b = 0; b < 4; ++b) acc[b] = (f32x4){0.f, 0.f, 0.f, 0.f};
        const LAS bf16* ap = RC + kap * RCS + L - 16 * (mlo + gh) - A8 + 8 * gb;
        const LAS bf16* bp = U + 256 + b0 * (L + 256) + 16 * (i0 + a - mlo - gh) + 8 * gb;
#pragma unroll 2
        for (int ks = 0; ks < nks; ++ks) {
            const bf16x8 af = *(const LAS bf16x8*)(ap - 32 * ks);
#pragma unroll
            for (int b = 0; b < 4; ++b) { const bf16x8 bfr = *(const LAS bf16x8*)(bp - 32 * ks + b * (L + 256)); acc[b] = MFMA16(af, bfr, acc[b]); }
        }
        const float bias = P.in[18][(l * 2 + o) * 512 + c];
        if (o == 0) {
            const float w0 = cw[c], w1 = cw[1536 + c], w2 = cw[3072 + c], bb = cb[c];
#pragma unroll
            for (int b = 0; b < 4; ++b) { const int bq = b0 + b; const f32x4 x1 = conv4(rx1, tokbase + bq * L, t4o, L, w0, w1, w2, bb);
                const v2u uv = *(const LAS v2u*)(U1 + 256 + bq * (L + 256) + t4o);
                const f32x4 y = (f32x4){x1[0] * (acc[b][0] + bias * bflo(uv.x)), x1[1] * (acc[b][1] + bias * bfhi(uv.x)), x1[2] * (acc[b][2] + bias * bflo(uv.y)), x1[3] * (acc[b][3] + bias * bfhi(uv.y))};
                v2u w; w.x = pk2(y[0], y[1]); w.y = pk2(y[2], y[3]); *(LAS v2u*)(U2 + 256 + bq * (L + 256) + t4o) = w; }
        } else {
            const float w0 = cw[512 + c], w1 = cw[1536 + 512 + c], w2 = cw[3072 + 512 + c], bb = cb[512 + c];
            bf16* yh = (bf16*)(P.ws + WS_YHY);
#pragma unroll
            for (int b = 0; b < 4; ++b) { const int bq = b0 + b; const int tok = tokbase + bq * L + t4o; const f32x4 x2 = conv4(rx2, tokbase + bq * L, t4o, L, w0, w1, w2, bb);
                const v2u uv = *(const LAS v2u*)(U2 + 256 + bq * (L + 256) + t4o); const v2u zz = *(const v2u*)(rz + tok);
                const f32x4 y = (f32x4){x2[0] * (acc[b][0] + bias * bflo(uv.x)) * bflo(zz.x), x2[1] * (acc[b][1] + bias * bfhi(uv.x)) * bfhi(zz.x),
                                        x2[2] * (acc[b][2] + bias * bflo(uv.y)) * bflo(zz.y), x2[3] * (acc[b][3] + bias * bfhi(uv.y)) * bfhi(zz.y)};
#pragma unroll
                for (int e = 0; e < 4; ++e) yh[(size_t)(tok + e) * 512 + c] = (bf16)f2bf(y[e]); }
        }
        __syncthreads();
    }
}

DI void attn_job(const Params& P, LAS unsigned char* lds, int l, int stream, int job, int tid, int lane, int wave) {
    const int Lq = stream ? 2048 : 256, Lk = stream ? 2560 : 256, nqb = Lq / 128;
    const int qb = job % nqb, bh = job / nqb;
    const int qs = wave >> 1, map = wave & 1, r = lane & 31, hh = lane >> 5;
    const bf16* Q = (const bf16*)(P.ws + WS_Q + (stream ? 8 * MiB : 0)) + ((size_t)(bh * 2 + map) * Lq + qb * 128 + qs * 32 + r) * 64;
    const bf16* K = (const bf16*)(P.ws + WS_K + (stream ? 8 * MiB : 0)) + (size_t)(bh * 2) * Lk * 64;
    const bf16* VT = (const bf16*)(P.ws + WS_VT + (stream ? 8 * MiB : 0)) + (size_t)bh * 128 * Lk;
    bf16x8 qf[4];
#pragma unroll
    for (int ks = 0; ks < 4; ++ks) qf[ks] = *(const bf16x8*)(Q + 16 * ks + 8 * hh);
    constexpr int KTB = 18432, BUFB = 36864, PWOFF = 2 * BUFB;
    LAS unsigned char* pw = lds + PWOFF + wave * 4608;
    const bf16* ksrc[2]; int kdst[2]; const bf16* vsrc[2]; int vdst[2];
#pragma unroll
    for (int i = 0; i < 2; ++i) { const int idx = tid + 512 * i; const int mp = idx >> 9, key = (idx >> 3) & 63, ch = idx & 7;
        ksrc[i] = K + ((size_t)mp * Lk + key) * 64 + ch * 8; kdst[i] = mp * 9216 + key * 144 + ch * 16;
        const int dv = idx >> 3; vsrc[i] = VT + (size_t)dv * Lk + ch * 8; vdst[i] = KTB + dv * 144 + ch * 16; }
    const int nkt = Lk / 64;
    v4u kr[2], vr[2];
#pragma unroll
    for (int i = 0; i < 2; ++i) { kr[i] = *(const v4u*)ksrc[i]; vr[i] = *(const v4u*)vsrc[i]; }
#pragma unroll
    for (int i = 0; i < 2; ++i) { *(LAS v4u*)(lds + kdst[i]) = kr[i]; *(LAS v4u*)(lds + vdst[i]) = vr[i]; }
    __syncthreads();
    f32x16 oacc[4];
#pragma unroll
    for (int d = 0; d < 4; ++d)
#pragma unroll
        for (int i = 0; i < 16; ++i) oacc[d][i] = 0.f;
    float mrun = -1e30f, lsum = 0.f;
#pragma unroll 1
    for (int kt = 0; kt < nkt; ++kt) {
        const int buf = kt & 1; const bool more = kt + 1 < nkt;
        if (more) {
#pragma unroll
            for (int i = 0; i < 2; ++i) { kr[i] = *(const v4u*)(ksrc[i] + (size_t)(kt + 1) * 64 * 64); vr[i] = *(const v4u*)(vsrc[i] + (kt + 1) * 64); } }
        const LAS unsigned char* kt_ = lds + buf * BUFB + map * 9216; const LAS unsigned char* vt_ = lds + buf * BUFB + KTB;
        f32x16 s[2];
#pragma unroll
        for (int kh = 0; kh < 2; ++kh) {
#pragma unroll
            for (int i = 0; i < 16; ++i) s[kh][i] = 0.f;
#pragma unroll
            for (int ks = 0; ks < 4; ++ks) { const bf16x8 kf = *(const LAS bf16x8*)(kt_ + (32 * kh + r) * 144 + (16 * ks + 8 * hh) * 2); s[kh] = MFMA32(kf, qf[ks], s[kh]); }
        }
        float mx = s[0][0];
#pragma unroll
        for (int kh = 0; kh < 2; ++kh)
#pragma unroll
            for (int i = 0; i < 16; ++i) mx = fmaxf(mx, s[kh][i]);
        mx = fmaxf(mx, __shfl_xor(mx, 32));
        const float mnew = fmaxf(mrun, mx); const float alpha = __builtin_amdgcn_exp2f(mrun - mnew); mrun = mnew;
        float ps = 0.f;
#pragma unroll
        for (int kh = 0; kh < 2; ++kh)
#pragma unroll
            for (int i = 0; i < 16; ++i) { const float p = __builtin_amdgcn_exp2f(s[kh][i] - mnew); s[kh][i] = p; ps += p; }
        lsum = lsum * alpha + ps;
#pragma unroll
        for (int d = 0; d < 4; ++d)
#pragma unroll
            for (int i = 0; i < 16; ++i) oacc[d][i] *= alpha;
#pragma unroll
        for (int kh = 0; kh < 2; ++kh)
#pragma unroll
            for (int rg = 0; rg < 4; ++rg) { v2u w; w.x = cvt_pk_bf16(s[kh][4 * rg], s[kh][4 * rg + 1]); w.y = cvt_pk_bf16(s[kh][4 * rg + 2], s[kh][4 * rg + 3]);
                *(LAS v2u*)(pw + r * 144 + (32 * kh + 8 * rg + 4 * hh) * 2) = w; }
        LDS_WAIT(); asm volatile("" ::: "memory");
#pragma unroll
        for (int k2 = 0; k2 < 4; ++k2) { const bf16x8 pf = *(const LAS bf16x8*)(pw + r * 144 + (16 * k2 + 8 * hh) * 2);
#pragma unroll
            for (int d = 0; d < 4; ++d) { const bf16x8 vf = *(const LAS bf16x8*)(vt_ + (32 * d + r) * 144 + (16 * k2 + 8 * hh) * 2); oacc[d] = MFMA32(vf, pf, oacc[d]); } }
        if (more) {
#pragma unroll
            for (int i = 0; i < 2; ++i) { *(LAS v4u*)(lds + (buf ^ 1) * BUFB + kdst[i]) = kr[i]; *(LAS v4u*)(lds + (buf ^ 1) * BUFB + vdst[i]) = vr[i]; } }
        __syncthreads();
    }
    lsum += __shfl_xor(lsum, 32);
    const float il = 1.f / lsum;
    LAS float* X = (LAS float*)lds + qs * 4096;
    if (map == 1) {
#pragma unroll
        for (int d = 0; d < 4; ++d)
#pragma unroll
            for (int i = 0; i < 16; ++i) { const int dv = 32 * d + (i & 3) + 8 * (i >> 2) + 4 * hh; X[dv * 32 + r] = oacc[d][i] * il; }
    }
    __syncthreads();
    if (map == 0) {
        const float lam = ((const float*)(P.ws + WS_LAM))[l]; const float lam_init = 0.8f - 0.6f * expf(-0.3f * (float)l);
        float ss = 0.f;
#pragma unroll
        for (int d = 0; d < 4; ++d)
#pragma unroll
            for (int i = 0; i < 16; ++i) { const int dv = 32 * d + (i & 3) + 8 * (i >> 2) + 4 * hh; const float o = oacc[d][i] * il - lam * X[dv * 32 + r]; oacc[d][i] = o; ss += o * o; }
        ss += __shfl_xor(ss, 32);
        const float rstd = rsqrtf(ss * (1.f / 128.f) + 1e-6f) * (1.f - lam_init);
        const float* sg = P.in[23] + l * 128;
        const int b = bh >> 2, h = bh & 3; const int tok = (stream ? NPT + b * 2048 : b * 256) + qb * 128 + qs * 32 + r;
        bf16* yat = (bf16*)(P.ws + WS_ATZ) + (size_t)tok * 512 + h * 128;
#pragma unroll
        for (int d = 0; d < 4; ++d)
#pragma unroll
            for (int rg = 0; rg < 4; ++rg) { const int dv = 32 * d + 8 * rg + 4 * hh; const f32x4 gg = *(const f32x4*)(sg + dv); const v2u zz = *(const v2u*)(yat + dv);
                v2u w; w.x = pk2(oacc[d][4 * rg] * rstd * gg[0] * bflo(zz.x), oacc[d][4 * rg + 1] * rstd * gg[1] * bfhi(zz.x));
                w.y = pk2(oacc[d][4 * rg + 2] * rstd * gg[2] * bflo(zz.y), oacc[d][4 * rg + 3] * rstd * gg[3] * bfhi(zz.y));
                *(v2u*)(yat + dv) = w; }
    }
    __syncthreads();
}

DI void pool_job(const Params& P, LAS unsigned char* lds, int l, int job, int tid, int lane, int wave) {
    const int tile = job >> 2, g = job & 3, half = 1 << g;
    const int tok0 = tile * 256; int t0, L; if (tile < 32) { t0 = 0; L = 256; } else { t0 = (tok0 - NPT) & 2047; L = 2048; }
    const bf16* plu = (const bf16*)(P.ws + WS_PLU); bf16* plz = (bf16*)(P.ws + WS_PLZ);
    LAS bf16* Mt = (LAS bf16*)lds; LAS bf16* PW = (LAS bf16*)(lds + 69632);
    { const bf16* src = (const bf16*)(P.ws + WS_POOLT) + (size_t)g * 16384;
      for (int q = tid; q < 128 * 16; q += 512) { const int n = q >> 4, ch = q & 15; *(LAS v4u*)(PW + n * 136 + ch * 8) = *(const v4u*)(src + n * 128 + ch * 8); } }
    { const int cc = tid & 127, seg = tid >> 7; const bf16* col = plu + (size_t)(tok0 - t0) * 512 + g * 128 + cc;
      const int ts = t0 + seg * 64; float s = 0.f;
      for (int tau = ts - half; tau < ts + half; ++tau) if (tau >= 0 && tau < L) s += bf2f(col[(size_t)tau * 512]);
      for (int t = ts; t < ts + 64; ++t) {
          const int lo = t - half < 0 ? 0 : t - half, hi = t + half > L ? L : t + half;
          const float u = bf2f(col[(size_t)t * 512]);
          Mt[(t - t0) * 136 + cc] = (bf16)f2bf(s / (float)(hi - lo) - u);
          if (t + half < L) s += bf2f(col[(size_t)(t + half) * 512]);
          if (t - half >= 0) s -= bf2f(col[(size_t)(t - half) * 512]);
      } }
    __syncthreads();
    const int r = lane & 31, hh = lane >> 5;
    f32x16 acc[4];
#pragma unroll
    for (int mb = 0; mb < 4; ++mb)
#pragma unroll
        for (int i = 0; i < 16; ++i) acc[mb][i] = 0.f;
#pragma unroll
    for (int ks = 0; ks < 8; ++ks) { const bf16x8 bfr = *(const LAS bf16x8*)(Mt + (32 * wave + r) * 136 + 16 * ks + 8 * hh);
#pragma unroll
        for (int mb = 0; mb < 4; ++mb) { const bf16x8 af = *(const LAS bf16x8*)(PW + (32 * mb + r) * 136 + 16 * ks + 8 * hh); acc[mb] = MFMA32(af, bfr, acc[mb]); } }
    const float* psc = P.in[25] + l * 512 + g * 128; bf16* yrow = plz + (size_t)(tok0 + 32 * wave + r) * 512 + g * 128;
#pragma unroll
    for (int mb = 0; mb < 4; ++mb)
#pragma unroll
        for (int rg = 0; rg < 4; ++rg) { const int n = 32 * mb + 8 * rg + 4 * hh; const f32x4 sc = *(const f32x4*)(psc + n); const v2u zz = *(const v2u*)(yrow + n);
            v2u w; w.x = pk2(acc[mb][4 * rg] * sc[0] * bflo(zz.x), acc[mb][4 * rg + 1] * sc[1] * bfhi(zz.x)); w.y = pk2(acc[mb][4 * rg + 2] * sc[2] * bflo(zz.y), acc[mb][4 * rg + 3] * sc[3] * bfhi(zz.y));
            *(v2u*)(yrow + n) = w; }
    __syncthreads();
}

#ifndef GALIGN
#define GALIGN true
#endif
#ifndef GSP2
#define GSP2 true
#endif
#ifdef NO_SYNC
#define GSYNC() __syncthreads()
#else
#define GSYNC() grid.sync()
#endif
__global__ void __launch_bounds__(512, 2) mk_fwd(Params P) {
    extern __shared__ __attribute__((aligned(16))) unsigned char lds_raw[];
    LAS unsigned char* lds = (LAS unsigned char*)lds_raw;
    cg::grid_group grid = cg::this_grid();
#define TLW() int tid_l = threadIdx.x; asm volatile("" : "+v"(tid_l)); const int tid = tid_l, lane = tid & 63, wave = __builtin_amdgcn_readfirstlane(tid >> 6); (void)lane; (void)wave
    const int G = gridDim.x, bid = blockIdx.x;
    unsigned char* ws = P.ws;
#ifndef NO_PA
    { TLW(); phase_a(P, lds, tid, bid, G); }
#endif
    GSYNC();
#pragma unroll 1
    for (int l = 0; l < 2; ++l) {
        const float* xP = l == 0 ? P.in[0] : P.out; const float* xS = l == 0 ? P.in[1] : P.out + (size_t)NPT * 1024;
#ifndef NO_P0
        { TLW(); phase_p0(P, lds, l, xP, xS, tid, lane, wave, bid, G); }
#endif
        GSYNC();
        {
            { pg8::Gemm g{(const pg8::bf16_t*)(ws + WS_WINT), (const pg8::bf16_t*)(ws + WS_H), 2048, NTOK, 1024}; pg8::StaticOrder S; S.init(2048, NTOK, G, bid);
              EpiHyT E{(bf16*)(ws + WS_HYT)};
#ifndef NO_G1
              pg8::gemm_phase<EpiHyT, pg8::StaticOrder, GALIGN, GSP2>(lds, g, S, E);
#endif
 }
            { pg8::Gemm g{(const pg8::bf16_t*)(ws + WS_H), (const pg8::bf16_t*)(ws + WS_WINT) + (size_t)2048 * 1024, NTOK, 3072, 1024}; pg8::StaticOrder S; S.init(NTOK, 3072, G, bid);
              EpiB E{l, P.in[19] + l * 64, P.in[20] + l * 64, (const float*)(ws + WS_ROPE), (const float*)(ws + WS_ROPE) + 2048 * 32, ws, P.out + (size_t)2 * NPT * 1024, P.out + (size_t)3 * NPT * 1024};
#ifndef NO_G2
              pg8::gemm_phase<EpiB, pg8::StaticOrder, GALIGN, GSP2>(lds, g, S, E);
#endif
 }
        }
        GSYNC();
        {
            for (int j = bid; j < 1792; j += G) { TLW();
#ifndef NO_MIX
                if (j < 256) attn_job(P, lds, l, 1, j, tid, lane, wave);
                else if (j < 768) hyena_job(P, lds, l, 1, j - 256, tid, lane, wave);
                else if (j < 1280) hyena_job(P, lds, l, 0, j - 768, tid, lane, wave);
                else if (j < 1536) attn_job(P, lds, l, 0, j - 1280, tid, lane, wave);
                else pool_job(P, lds, l, j - 1536, tid, lane, wave);
#endif
            }
        }
        GSYNC();
        { pg8::Gemm g{(const pg8::bf16_t*)(ws + WS_YHY), (const pg8::bf16_t*)(ws + WS_WOT), 3 * NTOK, 3072, 512}; BrOrder S{G, bid};
          EpiBr E{(bf16*)(ws + WS_BBUF)};
#ifndef NO_G3
 pg8::gemm_phase<EpiBr, BrOrder, GALIGN, GSP2>(lds, g, S, E);
#endif
 }
        GSYNC();
        { pg8::Gemm g{(const pg8::bf16_t*)(ws + WS_H), (const pg8::bf16_t*)(ws + WS_WINT) + (size_t)5120 * 1024, NTOK, 3072, 1024}; pg8::StaticOrder S; S.init(NTOK, 3072, G, bid);
          EpiGate E{(bf16*)(ws + WS_BBUF)};
#ifndef NO_G4
 pg8::gemm_phase<EpiGate, pg8::StaticOrder, GALIGN, GSP2>(lds, g, S, E);
#endif
 }
        GSYNC();
        { pg8::Gemm g{(const pg8::bf16_t*)(ws + WS_BBUF), (const pg8::bf16_t*)(ws + WS_WOUT3), NTOK, 1024, 3072}; pg8::StaticOrder S; S.init(NTOK, 1024, G, bid);
          EpiOut E{xP, xS, P.out, (const float*)(ws + WS_MOD) + l * 5 * 3072}; pg8::gemm_phase<EpiOut, pg8::StaticOrder, GALIGN, GSP2>(lds, g, S, E); }
        if (l == 0) GSYNC();
    }
}

extern "C" void kernel_launch(void* const* d_in, const int* in_sizes, int n_in, void* d_out, int out_size, void* d_ws, size_t ws_size, hipStream_t stream) {
    static int grid = 0;
    if (grid == 0) {
        if (n_in != 30 || ws_size < WS_END) { fprintf(stderr, "kernel_launch: unexpected n_in %d / ws_size %zu\n", n_in, ws_size); grid = -1; return; }
        int dev = 0, cus = 0, per_cu = 0;
        hipGetDevice(&dev); hipDeviceGetAttribute(&cus, hipDeviceAttributeMultiprocessorCount, dev);
        if (hipFuncSetAttribute((const void*)mk_fwd, hipFuncAttributeMaxDynamicSharedMemorySize, LDS_BYTES) != hipSuccess) { fprintf(stderr, "kernel_launch: hipFuncSetAttribute failed\n"); grid = -1; return; }
        if (hipOccupancyMaxActiveBlocksPerMultiprocessor(&per_cu, (const void*)mk_fwd, 512, LDS_BYTES) != hipSuccess || per_cu < 1) { fprintf(stderr, "kernel_launch: occupancy query says %d\n", per_cu); per_cu = 1; }
        (void)hipGetLastError();
        grid = cus * per_cu;
    }
    if (grid < 0) return;
    Params p{};
    for (int i = 0; i < 30; ++i) p.in[i] = (const float*)d_in[i];
    p.out = (float*)d_out; p.ws = (unsigned char*)d_ws;
    void* args[] = {&p};
    hipError_t e = hipLaunchCooperativeKernel((const void*)mk_fwd, dim3(grid), dim3(512), args, LDS_BYTES, stream);
    if (e != hipSuccess) fprintf(stderr, "cooperative launch failed: %s (grid %d)\n", hipGetErrorString(e), grid);
}
```

```cpp
#include <hip/hip_runtime.h>
#include <hip/hip_cooperative_groups.h>
#include <cstdio>
#include <cstdint>
namespace cg = cooperative_groups;
namespace pg8 {
#define PG8_LAS __attribute__((address_space(3)))
typedef unsigned short bf16_t;
typedef short bf16x8 __attribute__((ext_vector_type(8)));
typedef float f32x4 __attribute__((ext_vector_type(4)));
typedef unsigned u32x4 __attribute__((ext_vector_type(4)));
constexpr int BM = 256, BK = 64, HALF = 128, HTB = HALF * BK * 2  , STAGE_BYTES = 8 * HTB, NXCD = 8, WGM = 8;

__host__ __device__ __forceinline__ int lds_byte(int r, int c) { const int st = (r >> 4) * 2 + (c >> 5), rr = r & 15, cc = c & 31, ob = rr * 64 + cc * 2; return st * 1024 + (ob ^ (((ob >> 9) & 1) << 5)); }
__host__ __device__ __forceinline__ void stage_rc(int b, int& R, int& C) { const int st = b / 1024, sb = b % 1024, swz = sb ^ (((sb >> 9) & 1) << 5); R = (st >> 1) * 16 + swz / 64; C = (st & 1) * 32 + (swz % 64) / 2; }
__host__ __device__ __forceinline__ int perm32(int rho) { const int n = rho >> 4, i = rho & 15; return 8 * (i >> 2) + 4 * n + (i & 3); }

struct Unit { int pm, pn; };
struct Gemm { const bf16_t* A; const bf16_t* Bt; int M, N, K; };

struct StaticOrder {
    int nM, nN, nwg, G, c;
    __host__ __device__ void init(int M, int N, int G_, int c_) { nM = M / BM; nN = N / BM; nwg = nM * nN; G = G_; c = c_; }
    __host__ __device__ bool next(int i, Unit& u) const {
        const long L = (long)i * G + c; if (L >= nwg) return false;
        int wgid = (int)L; { const int q = nwg / NXCD, r = nwg % NXCD, xcd = wgid % NXCD, off = wgid / NXCD; wgid = (xcd < r ? xcd * (q + 1) : r * (q + 1) + (xcd - r) * q) + off; }
        const int nig = WGM * nN, gid = wgid / nig, fm = gid * WGM, gsz = (nM - fm) < WGM ? (nM - fm) : WGM;
        u.pm = fm + ((wgid % nig) % gsz); u.pn = (wgid % nig) / gsz; return true;
    }
    __device__ __forceinline__ void a_ready(const Unit&) const {}
    __device__ __forceinline__ void done(const Unit&) const {}
};

__device__ __forceinline__ unsigned cvt_pk_bf16(float lo, float hi) { unsigned r; asm volatile("v_cvt_pk_bf16_f32 %0, %1, %2" : "=v"(r) : "v"(lo), "v"(hi)); return r; }
typedef float f32x2 __attribute__((ext_vector_type(2)));
template <class Epi, class Sched, bool ALIGN_EPI = false, bool SP2 = false>
__device__ __forceinline__ void gemm_phase(PG8_LAS unsigned char* lds, const Gemm g, const Sched& S, const Epi& E) {
    int tid_l = threadIdx.x; asm volatile("" : "+v"(tid_l)); const int tid = tid_l, wid = __builtin_amdgcn_readfirstlane(tid >> 6), lane = tid & 63, wr = wid >> 2, wc = wid & 3, fr = lane & 15, fq = lane >> 4;
    const int K = g.K, nt = K / BK;
    unsigned voffA[2], voffB[2];
#pragma unroll
    for (int i = 0; i < 2; ++i) { int R, C; stage_rc(tid * 16 + i * 8192, R, C); const int Rb = Epi::PERM ? ((R & ~31) + perm32(R & 31)) : R;
        voffA[i] = (unsigned)(R * K + C) * 2u; voffB[i] = (unsigned)(Rb * K + C) * 2u; }
    const size_t kstep = (size_t)(BK * 2);
    const size_t hstep = (size_t)HALF * K * 2;
    const size_t tstep = 2 * hstep;
    const unsigned ldsw = (unsigned)wid * 1024u;
    const int aoff = lds_byte(wr * 64 + fr, fq * 8), boff = lds_byte(wc * 32 + fr, fq * 8);
#define PG8_SA(b, h) (((b) * 2 + (h)) * HTB)
#define PG8_SB(b, h) ((4 + (b) * 2 + (h)) * HTB)
#define PG8_STAGE(bufoff, gbase, voff) do { _Pragma("unroll") for (int _i = 0; _i < 2; ++_i) \
        __builtin_amdgcn_global_load_lds((const unsigned*)((const char*)(gbase) + (voff)[_i]), (PG8_LAS unsigned*)(lds + (bufoff) + ldsw + _i * 8192), 16, 0, 0); } while (0)
#define PG8_LDA(dst, b, h) do { _Pragma("unroll") for (int m = 0; m < 4; ++m) _Pragma("unroll") for (int k = 0; k < 2; ++k) dst[m][k] = *(const PG8_LAS bf16x8*)(lds + PG8_SA(b, h) + aoff + m * 2048 + k * 1024); } while (0)
#define PG8_LDB(dst, b, h) do { _Pragma("unroll") for (int n = 0; n < 2; ++n) _Pragma("unroll") for (int k = 0; k < 2; ++k) dst[n][k] = *(const PG8_LAS bf16x8*)(lds + PG8_SB(b, h) + boff + n * 2048 + k * 1024); } while (0)
#define PG8_MMA(ai, bj, At, Bt) do { __builtin_amdgcn_s_setprio(1); _Pragma("unroll") for (int m = 0; m < 4; ++m) _Pragma("unroll") for (int n = 0; n < 2; ++n) _Pragma("unroll") for (int k = 0; k < 2; ++k) \
        acc[ai][bj][m][n] = __builtin_amdgcn_mfma_f32_16x16x32_bf16(Bt[n][k], At[m][k], acc[ai][bj][m][n], 0, 0, 0); __builtin_amdgcn_s_setprio(0); } while (0)
#define PG8_WAIT_V(n) asm volatile("s_waitcnt vmcnt(" #n ")" ::: "memory")
#define PG8_WAIT_L(n) asm volatile("s_waitcnt lgkmcnt(" #n ")" ::: "memory")
#define PG8_BAR __builtin_amdgcn_s_barrier()
#define PG8_SCHED __builtin_amdgcn_sched_barrier(0)
    Unit cur, nxt; int ui = 0;
    if (!S.next(0, cur)) return;
    f32x4 acc[2][2][4][2];
#pragma unroll
    for (int a = 0; a < 2; ++a)
#pragma unroll
        for (int b = 0; b < 2; ++b)
#pragma unroll
            for (int m = 0; m < 4; ++m)
#pragma unroll
                for (int n = 0; n < 2; ++n) acc[a][b][m][n] = (f32x4){0.f, 0.f, 0.f, 0.f};
    bf16x8 At[4][2], B0[2][2], B1[2][2];
    const char* cA = (const char*)g.A + (size_t)cur.pm * tstep; const char* cB = (const char*)g.Bt + (size_t)cur.pn * tstep;
    S.a_ready(cur);
    if constexpr (SP2) {
        PG8_STAGE(PG8_SB(0, 0), cB, voffB); PG8_STAGE(PG8_SB(0, 1), cB + hstep, voffB); PG8_STAGE(PG8_SA(0, 0), cA, voffA); PG8_STAGE(PG8_SA(0, 1), cA + hstep, voffA);
        if (wr == 1) PG8_BAR;
        PG8_WAIT_V(2); PG8_BAR;
        PG8_STAGE(PG8_SB(1, 0), cB + kstep, voffB); PG8_STAGE(PG8_SA(1, 0), cA + kstep, voffA); PG8_STAGE(PG8_SB(1, 1), cB + hstep + kstep, voffB);
        PG8_WAIT_V(6); PG8_BAR;
    } else {
        PG8_STAGE(PG8_SB(0, 0), cB, voffB); PG8_STAGE(PG8_SA(0, 0), cA, voffA); PG8_STAGE(PG8_SB(0, 1), cB + hstep, voffB); PG8_STAGE(PG8_SA(0, 1), cA + hstep, voffA);
        if (wr == 1) PG8_BAR;
        PG8_WAIT_V(4); PG8_BAR;
        PG8_STAGE(PG8_SB(1, 0), cB + kstep, voffB); PG8_STAGE(PG8_SA(1, 0), cA + kstep, voffA); PG8_STAGE(PG8_SB(1, 1), cB + hstep + kstep, voffB);
        PG8_WAIT_V(6); PG8_BAR;
    }
    for (;;) {
        const bool has_next = S.next(ui + 1, nxt);
        const char* nA = has_next ? (const char*)g.A + (size_t)nxt.pm * tstep : cA; const char* nB = has_next ? (const char*)g.Bt + (size_t)nxt.pn * tstep : cB;
        for (int t = 0; t < nt; t += 2) {
            const bool last = (t == nt - 2);
            const char* a1 = cA + (size_t)(t + 1) * kstep;
            const char* a2 = last ? nA : cA + (size_t)(t + 2) * kstep; const char* b2 = last ? nB : cB + (size_t)(t + 2) * kstep;
            const char* a3 = a2 + kstep; const char* b3 = b2 + kstep;
            if (last && has_next) S.a_ready(nxt);
            if constexpr (SP2) {
            PG8_LDB(B0, 0, 0); PG8_LDB(B1, 0, 1); PG8_SCHED; PG8_LDA(At, 0, 0); PG8_STAGE(PG8_SA(1, 1), a1 + hstep, voffA);
            PG8_WAIT_V(8); PG8_WAIT_L(0); PG8_BAR; PG8_MMA(0, 0, At, B0); PG8_MMA(0, 1, At, B1); PG8_BAR; PG8_SCHED;
            PG8_LDA(At, 0, 1); PG8_STAGE(PG8_SB(0, 0), b2, voffB); PG8_STAGE(PG8_SB(0, 1), b2 + hstep, voffB); PG8_STAGE(PG8_SA(0, 0), a2, voffA);
            PG8_WAIT_V(8); PG8_WAIT_L(0); PG8_BAR; PG8_MMA(1, 0, At, B0); PG8_MMA(1, 1, At, B1); PG8_BAR; PG8_SCHED;
            PG8_LDB(B0, 1, 0); PG8_LDB(B1, 1, 1); PG8_SCHED; PG8_LDA(At, 1, 0); PG8_STAGE(PG8_SA(0, 1), a2 + hstep, voffA);
            PG8_WAIT_V(8); PG8_WAIT_L(0); PG8_BAR; PG8_MMA(0, 0, At, B0); PG8_MMA(0, 1, At, B1); PG8_BAR; PG8_SCHED;
            PG8_LDA(At, 1, 1); PG8_STAGE(PG8_SB(1, 0), b3, voffB); PG8_STAGE(PG8_SB(1, 1), b3 + hstep, voffB); PG8_STAGE(PG8_SA(1, 0), a3, voffA);
            PG8_WAIT_V(8); PG8_WAIT_L(0); PG8_BAR; PG8_MMA(1, 0, At, B0); PG8_MMA(1, 1, At, B1); PG8_BAR; PG8_SCHED;
            } else {
            PG8_LDB(B0, 0, 0); PG8_SCHED; PG8_LDA(At, 0, 0); PG8_STAGE(PG8_SA(1, 1), a1 + hstep, voffA);
            PG8_WAIT_L(8); PG8_BAR; PG8_WAIT_L(0); PG8_MMA(0, 0, At, B0); PG8_BAR; PG8_SCHED;
            PG8_LDB(B1, 0, 1); PG8_STAGE(PG8_SB(0, 0), b2, voffB);
            PG8_BAR; PG8_WAIT_L(0); PG8_MMA(0, 1, At, B1); PG8_BAR;
            PG8_LDA(At, 0, 1); PG8_STAGE(PG8_SA(0, 0), a2, voffA);
            PG8_BAR; PG8_WAIT_L(0); PG8_MMA(1, 0, At, B0); PG8_BAR; PG8_SCHED;
            PG8_STAGE(PG8_SB(0, 1), b2 + hstep, voffB);
            PG8_WAIT_V(6); PG8_BAR; PG8_MMA(1, 1, At, B1); PG8_BAR;
            PG8_LDB(B0, 1, 0); PG8_SCHED; PG8_LDA(At, 1, 0); PG8_STAGE(PG8_SA(0, 1), a2 + hstep, voffA);
            PG8_WAIT_L(8); PG8_BAR; PG8_WAIT_L(0); PG8_MMA(0, 0, At, B0); PG8_BAR; PG8_SCHED;
            PG8_LDB(B1, 1, 1); PG8_STAGE(PG8_SB(1, 0), b3, voffB);
            PG8_BAR; PG8_WAIT_L(0); PG8_MMA(0, 1, At, B1); PG8_BAR;
            PG8_LDA(At, 1, 1); PG8_STAGE(PG8_SA(1, 0), a3, voffA);
            PG8_BAR; PG8_WAIT_L(0); PG8_MMA(1, 0, At, B0); PG8_BAR; PG8_SCHED;
            PG8_STAGE(PG8_SB(1, 1), b3 + hstep, voffB);
            PG8_WAIT_V(6); PG8_BAR; PG8_MMA(1, 1, At, B1); PG8_BAR;
            }
        }
        if constexpr (ALIGN_EPI) { if (wr == 0) PG8_BAR; }
        if constexpr (!Epi::AFTER_DRAIN) { E(acc, cur, wr, wc, fr, fq); S.done(cur); }
        if (!has_next) break;
#pragma unroll
        for (int a = 0; a < 2; ++a)
#pragma unroll
            for (int b = 0; b < 2; ++b)
#pragma unroll
                for (int m = 0; m < 4; ++m)
#pragma unroll
                    for (int n = 0; n < 2; ++n) acc[a][b][m][n] = (f32x4){0.f, 0.f, 0.f, 0.f};
        cur = nxt; cA = nA; cB = nB; ++ui;
        if constexpr (ALIGN_EPI) { if (wr == 1) PG8_BAR; }
    }
    PG8_WAIT_V(0);
    if constexpr (!ALIGN_EPI) { if (wr == 0) PG8_BAR; }
    PG8_BAR;
    if constexpr (Epi::AFTER_DRAIN) { E.fused(acc, cur, wr, wc, fr, fq, lds, wid, lane); S.done(cur); }
#undef PG8_SA
#undef PG8_SB
#undef PG8_STAGE
#undef PG8_LDA
#undef PG8_LDB
#undef PG8_MMA
#undef PG8_WAIT_V
#undef PG8_WAIT_L
#undef PG8_BAR
#undef PG8_SCHED
}
}

#define LAS __attribute__((address_space(3)))
typedef unsigned short bf16;
typedef unsigned v4u __attribute__((ext_vector_type(4)));
typedef unsigned v2u __attribute__((ext_vector_type(2)));
typedef float f32x4 __attribute__((ext_vector_type(4)));
typedef float f32x2 __attribute__((ext_vector_type(2)));
typedef float f32x16 __attribute__((ext_vector_type(16)));
typedef short bf16x8 __attribute__((ext_vector_type(8)));
#define DI __device__ __forceinline__
#define MFMA32(a, b, c) __builtin_amdgcn_mfma_f32_32x32x16_bf16((a), (b), (c), 0, 0, 0)
#define MFMA16(a, b, c) __builtin_amdgcn_mfma_f32_16x16x32_bf16((a), (b), (c), 0, 0, 0)

constexpr int LDS_BYTES = 147456;
constexpr int NTOK = 16384, NPT = 8192, DM = 1024, DIN = 8192;
constexpr size_t MiB = 1u << 20;
constexpr size_t WS_BAR = 65536;
constexpr size_t WS_LAM = 4096;
constexpr size_t WS_MOD = 1 * MiB;
constexpr size_t WS_ROPE = 1 * MiB + 256 * 1024;
constexpr size_t WS_POOLT = 1 * MiB + 768 * 1024;
constexpr size_t WS_WINT = 2 * MiB;
constexpr size_t WS_WOT = 18 * MiB;
constexpr size_t WS_WOUT3 = 21 * MiB;
constexpr size_t WS_HRAW = 27 * MiB;
constexpr size_t WS_H = 36 * MiB;
constexpr size_t WS_YHY = 68 * MiB;
constexpr size_t WS_ATZ = 84 * MiB;
constexpr size_t WS_PLZ = 100 * MiB;
constexpr size_t WS_PLU = 116 * MiB;
constexpr size_t WS_HYT = 132 * MiB;
constexpr size_t WS_Q = 196 * MiB;
constexpr size_t WS_K = 212 * MiB;
constexpr size_t WS_VT = 230 * MiB;
constexpr size_t WS_BBUF = 132 * MiB;
constexpr size_t WS_END = 248 * MiB;

struct Params { const float* in[30]; float* out; unsigned char* ws; };

DI unsigned f2bf(float f) { unsigned u = __builtin_bit_cast(unsigned, f); return (u + 0x7fffu + ((u >> 16) & 1u)) >> 16; }
DI unsigned pk2(float lo, float hi) { return f2bf(lo) | (f2bf(hi) << 16); }
DI float bf2f(unsigned h) { return __builtin_bit_cast(float, h << 16); }
DI float bflo(unsigned w) { return __builtin_bit_cast(float, w << 16); }
DI float bfhi(unsigned w) { return __builtin_bit_cast(float, w & 0xffff0000u); }
DI float siluf(float x) { return x * __builtin_amdgcn_rcpf(1.f + __expf(-x)); }
DI float sigmf(float x) { return __builtin_amdgcn_rcpf(1.f + __expf(-x)); }
#define LDS_WAIT() asm volatile("s_waitcnt lgkmcnt(0)" ::: "memory")

#define XB_TMO      128
#define XB_XCNT(j)  (256  + 64 * (j))
#define XB_XSUB(j)  (1280 + 64 * (j))
#define XB_XGEN(j)  (2304 + 64 * (j))
#define XB_TOP      3328
#define XB_TOPGEN   3392
#define XCD_BAR_WORDS 3456
#define XB_SPIN_CAP (1u << 18)

__device__ __forceinline__ unsigned xb_ld(unsigned* p)              { return __hip_atomic_load(p, __ATOMIC_RELAXED, __HIP_MEMORY_SCOPE_AGENT); }
__device__ __forceinline__ unsigned xb_add(unsigned* p, unsigned v) { return __hip_atomic_fetch_add(p, v, __ATOMIC_RELAXED, __HIP_MEMORY_SCOPE_AGENT); }
__device__ __forceinline__ unsigned xb_xcc_id() { return (unsigned)__builtin_amdgcn_s_getreg((3 << 11) | 20) & 0xFu; }
#define XB_SPIN(cond, bar) do { unsigned _sp = 0; while (cond) { __builtin_amdgcn_s_sleep(1); \
    if ((++_sp & 255u) == 0u) { if (xb_ld(&(bar)[XB_TMO])) break; if (_sp > XB_SPIN_CAP) { atomicAdd(&(bar)[XB_TMO], 1u); break; } } } } while (0)

struct XcdBarrier {
    unsigned* bar; unsigned x;
    volatile LAS unsigned* st;
};

__device__ __forceinline__ XcdBarrier xcd_barrier_post(unsigned* bar, volatile LAS unsigned* st) {
    XcdBarrier b; b.bar = bar; b.x = xb_xcc_id(); b.st = st;
    if (threadIdx.x == 0) (void)xb_add(&bar[XB_XCNT(b.x)], 1u);
    return b;
}
__device__ __forceinline__ void xcd_barrier_complete(unsigned* bar, unsigned x, unsigned& nloc, unsigned& nx) {
    const unsigned G = gridDim.x * gridDim.y * gridDim.z;
    unsigned sum, cnt, mine, sp = 0u;
    for (;;) {
        sum = 0u; cnt = 0u; mine = 0u;
#pragma unroll
        for (unsigned j = 0; j < 16; ++j) { const unsigned c = xb_ld(&bar[XB_XCNT(j)]); sum += c; cnt += (c > 0u) ? 1u : 0u; mine = (j == x) ? c : mine; }
        if (sum == G) break;
        __builtin_amdgcn_s_sleep(1);
        if ((++sp & 255u) == 0u) { if (xb_ld(&bar[XB_TMO])) break; if (sp > XB_SPIN_CAP) { atomicAdd(&bar[XB_TMO], 1u); break; } }
    }
    nloc = mine > 0u ? mine : 1u; nx = cnt > 0u ? cnt : 1u;
}

__device__ __forceinline__ void xcd_barrier(const XcdBarrier& b) {
    asm volatile("s_waitcnt vmcnt(0)" ::: "memory");
    __syncthreads();
    if (threadIdx.x == 0) {
        unsigned* bar = b.bar;
        __builtin_amdgcn_s_waitcnt(0);
        unsigned nloc = b.st[0], nx = b.st[1];
        if (nloc == 0u) { xcd_barrier_complete(bar, b.x, nloc, nx); b.st[0] = nloc; b.st[1] = nx; }
        const unsigned old = xb_add(&bar[XB_XSUB(b.x)], 1u);
        const unsigned gen = old / nloc;
        if (old + 1u == (gen + 1u) * nloc) {
            __builtin_amdgcn_fence(__ATOMIC_RELEASE, "agent");
            asm volatile("s_waitcnt vmcnt(0)" ::: "memory");
            const unsigned og = xb_add(&bar[XB_TOP], 1u);
            const unsigned tg = og / nx;
            if (og + 1u == (tg + 1u) * nx) xb_add(&bar[XB_TOPGEN], 1u);
            else XB_SPIN(xb_ld(&bar[XB_TOPGEN]) == tg, bar);
            __builtin_amdgcn_fence(__ATOMIC_ACQUIRE, "agent");
            xb_add(&bar[XB_XGEN(b.x)], 1u);
            asm volatile("s_waitcnt vmcnt(0)" ::: "memory");
        } else {
            XB_SPIN(xb_ld(&bar[XB_XGEN(b.x)]) == gen, bar);
            __builtin_amdgcn_fence(__ATOMIC_ACQUIRE, "agent");
            asm volatile("s_waitcnt vmcnt(0)" ::: "memory");
        }
    }
    __syncthreads();
}

DI void tr_item(const float* src, size_t lds_, bf16* dst, size_t ldd, LAS float* scr, int lane) {
    float tv[32];
#pragma unroll
    for (int i = 0; i < 32; ++i) { const int kk = 2 * i + (lane >> 5); tv[i] = src[(size_t)kk * lds_ + (lane & 31)]; }
#pragma unroll
    for (int i = 0; i < 32; ++i) { const int kk = 2 * i + (lane >> 5); scr[kk * 33 + (lane & 31)] = tv[i]; }
    LDS_WAIT(); asm volatile("" ::: "memory");
    const int c = lane & 7;
#pragma unroll
    for (int j = 0; j < 4; ++j) { const int n = (lane >> 3) + 8 * j; const LAS float* s = scr + (8 * c) * 33 + n;
        v4u o; o.x = pk2(s[0 * 33], s[1 * 33]); o.y = pk2(s[2 * 33], s[3 * 33]); o.z = pk2(s[4 * 33], s[5 * 33]); o.w = pk2(s[6 * 33], s[7 * 33]);
        *(v4u*)(dst + (size_t)n * ldd + 8 * c) = o; }
    LDS_WAIT(); asm volatile("" ::: "memory");
}

DI void hraw_item(const Params& P, LAS unsigned char* lds, int l, int stream, int t0, int tid);
DI void phase_a(const Params& P, LAS unsigned char* lds, int tid, int bid, int G) {
    const float* c = P.in[4]; const float* cctx = P.in[5]; const float* w_ada = P.in[7]; const float* b_ada = P.in[8];
    float* mod = (float*)(P.ws + WS_MOD);
    LAS float* sc = (LAS float*)lds; LAS float* red = sc + 5 * 1024;
    for (int it = bid; it < 192; it += G) {
        const int l = it / 96, n0 = (it % 96) * 32;
        for (int idx = tid; idx < 5 * 1024; idx += 512) { const int r = idx >> 10, k = idx & 1023; const float cv = r == 0 ? cctx[k] : c[(r - 1) * 1024 + k]; sc[idx] = cv / (1.f + __expf(-cv)); }
        __syncthreads();
        const int cq = tid & 7, kg = tid >> 3; f32x4 acc[5]; f32x4 w[16];
#pragma unroll
        for (int r = 0; r < 5; ++r) acc[r] = (f32x4){0.f, 0.f, 0.f, 0.f};
#pragma unroll
        for (int kk = 0; kk < 16; ++kk) w[kk] = *(const f32x4*)(w_ada + ((size_t)l * 1024 + kg * 16 + kk) * 3072 + n0 + 4 * cq);
#pragma unroll
        for (int kk = 0; kk < 16; ++kk)
#pragma unroll
            for (int r = 0; r < 5; ++r) acc[r] += sc[r * 1024 + kg * 16 + kk] * w[kk];
#pragma unroll
        for (int r = 0; r < 5; ++r) *(LAS f32x4*)(red + (kg * 5 + r) * 32 + 4 * cq) = acc[r];
        __syncthreads();
        if (tid < 160) { const int r = tid >> 5, col = tid & 31; float s = b_ada[l * 3072 + n0 + col];
            for (int g = 0; g < 64; ++g) s += red[(g * 5 + r) * 32 + col];
            mod[(l * 5 + r) * 3072 + n0 + col] = s; }
        __syncthreads();
    }
    if (bid == 0 && tid < 2) {
        const int l = tid; const float* lq = P.in[21] + l * 128; const float* lk = P.in[22] + l * 128; float s0 = 0.f, s1 = 0.f;
        for (int i = 0; i < 64; ++i) { s0 += lq[i] * lk[i]; s1 += lq[64 + i] * lk[64 + i]; }
        const float lam_init = 0.8f - 0.6f * expf(-0.3f * (float)l);
        ((float*)(P.ws + WS_LAM))[l] = expf(s0) - expf(s1) + lam_init;
    }
}

DI void hraw_item(const Params& P, LAS unsigned char* lds, int l, int stream, int t0, int tid) {
    const int L = stream ? 2048 : 256;
    const float* w1 = P.in[12] + l * 33 * 64; const float* b1 = P.in[13] + l * 64; const float* w2 = P.in[14] + l * 64 * 64; const float* b2 = P.in[15] + l * 64;
    const float* w3 = P.in[16] + (size_t)l * 64 * 2048; const float* fq = P.in[17] + l * 128;
    bf16* out = (bf16*)(P.ws + WS_HRAW) + (stream ? 0 : (size_t)2 * 512 * 2 * 2048);
    LAS float* z = (LAS float*)lds; LAS float* h1 = z + 8 * 33 + 8; LAS float* h2 = h1 + 512; LAS float* w1s = h2 + 512; LAS float* w2s = w1s + 33 * 64;
    { const f32x4 a0 = *(const f32x4*)(w2 + 4 * tid), a1 = *(const f32x4*)(w2 + 2048 + 4 * tid);
      f32x4 b0 = (f32x4){0.f, 0.f, 0.f, 0.f}; const f32x4* w1v = (const f32x4*)w1; b0 = w1v[tid < 528 ? tid : 0]; f32x4 b1 = w1v[tid + 512 < 528 ? tid + 512 : 0];
      *(LAS f32x4*)(w2s + 4 * tid) = a0; *(LAS f32x4*)(w2s + 2048 + 4 * tid) = a1;
      *(LAS f32x4*)(w1s + 4 * tid) = b0; if (tid + 512 < 528) *(LAS f32x4*)(w1s + 4 * (tid + 512)) = b1; }
    if (tid < 8 * 33) { const int pos = tid / 33, j = tid % 33; const int t = t0 + pos; float v;
        if (j == 0) v = (float)t / (float)(L - 1);
        else { const int b = (j - 1) & 15; const float f = 1e-4f + (float)b * ((15.f - 1e-4f) / 15.f); const float w = 6.283185307179586f * (float)t / (float)L;
               v = (j <= 16) ? cosf(f * w) : -sinf(f * w); }
        z[pos * 33 + j] = v; }
    __syncthreads();
    { const int pos = tid >> 6, n = tid & 63; float a = b1[n];
#pragma unroll
      for (int j = 0; j < 33; ++j) a += z[pos * 33 + j] * w1s[j * 64 + n];
      h1[pos * 64 + n] = sinf(fq[n] * a); }
    __syncthreads();
    { const int pos = tid >> 6, n = tid & 63; float a = b2[n];
#pragma unroll 16
      for (int j = 0; j < 64; ++j) a += h1[pos * 64 + j] * w2s[j * 64 + n];
      h2[pos * 64 + n] = sinf(fq[64 + n] * a); }
    __syncthreads();
    { f32x4 acc[8];
#pragma unroll
      for (int p = 0; p < 8; ++p) acc[p] = (f32x4){0.f, 0.f, 0.f, 0.f};
#pragma unroll 1
      for (int k0 = 0; k0 < 64; k0 += 4) { f32x4 w[4];
#pragma unroll
          for (int kk = 0; kk < 4; ++kk) w[kk] = *(const f32x4*)(w3 + (size_t)(k0 + kk) * 2048 + 4 * tid);
#pragma unroll
          for (int p = 0; p < 8; ++p) { const f32x4 ha = *(const LAS f32x4*)(h2 + p * 64 + k0);
              acc[p] += ha[0] * w[0] + ha[1] * w[1] + ha[2] * w[2] + ha[3] * w[3]; } }
      const int n0 = 4 * tid, dir = n0 >> 10, o = (n0 >> 9) & 1;
#pragma unroll
      for (int e = 0; e < 4; ++e) { const int cc = (n0 & 511) + e; const float delta = 3.0701134573253944f + (float)cc * (12.280453829301578f / 511.f); float v[8];
#pragma unroll
          for (int p = 0; p < 8; ++p) { const float tn = (float)(t0 + p) / (float)(L - 1); v[p] = acc[p][e] * __expf(-tn * delta); }
          v4u w; w.x = pk2(v[0], v[1]); w.y = pk2(v[2], v[3]); w.z = pk2(v[4], v[5]); w.w = pk2(v[6], v[7]);
          *(v4u*)(out + ((size_t)((o * 512 + cc) * 2 + dir)) * L + t0) = w; } }
    __syncthreads();
}

DI void phase_p0(const Params& P, LAS unsigned char* lds, int l, const float* xsrcP, const float* xsrcS, int tid, int lane, int wave, int bid, int G) {
    const int gw = bid * 8 + wave, NGW = G * 8;
    LAS float* scr = (LAS float*)(lds + wave * 16384);
    bf16* WinT = (bf16*)(P.ws + WS_WINT); bf16* WoT = (bf16*)(P.ws + WS_WOT); bf16* Wout3 = (bf16*)(P.ws + WS_WOUT3); bf16* poolT = (bf16*)(P.ws + WS_POOLT);
    const float* w_in = P.in[9] + (size_t)l * 1024 * 8192;
    constexpr int I_IN = 16 * 256, I_O = 3 * 256, I_OUT = 512, I_PL = 32, I_CV = 512;
    constexpr int NIT = I_IN + I_O + I_OUT + I_PL + I_CV;
    for (int it = gw; it < NIT; it += NGW) {
        int r = it; const float* src; size_t sld; bf16* dst; size_t dld;
        if (r < I_IN) { const int kb = r >> 8, nb = r & 255, n0 = nb * 32; int drow = n0;
            if (n0 >= 2048 && n0 < 3072) { const int tb = n0 & ~255, lb = (n0 >> 5) & 7; drow = tb + 128 * (lb & 1) + 32 * (lb >> 1); }
            src = w_in + (size_t)(64 * kb) * 8192 + n0; sld = 8192; dst = WinT + (size_t)drow * 1024 + 64 * kb; dld = 1024; }
        else if ((r -= I_IN) < I_O) { const int j = r >> 8, q = r & 255, kb = q >> 5, nb = q & 31; const float* W = (j == 0 ? P.in[26] : j == 1 ? P.in[27] : P.in[28]) + (size_t)l * 512 * 1024;
            src = W + (size_t)(64 * kb) * 1024 + 32 * nb; sld = 1024; dst = WoT + (size_t)(j * 1024 + 32 * nb) * 512 + 64 * kb; dld = 512; }
        else if ((r -= I_O) < I_OUT) { const int kb = r >> 5, nb = r & 31; const float* W = P.in[29] + (size_t)l * 1024 * 1024;
            src = W + (size_t)(64 * kb) * 1024 + 32 * nb; sld = 1024; dst = Wout3 + (size_t)(32 * nb) * 1024 + 64 * kb; dld = 1024; }
        else if ((r -= I_OUT) < I_PL) { const int g = r >> 3, q = r & 7, kb = q >> 2, nb = q & 3; const float* W = P.in[24] + (size_t)(l * 4 + g) * 16384;
            src = W + (size_t)(64 * kb) * 128 + 32 * nb; sld = 128; dst = poolT + (size_t)g * 16384 + (size_t)(32 * nb) * 128 + 64 * kb; dld = 128; }
        else { r -= I_PL; const int b = r >> 7, q = r & 127, h = q >> 5, q2 = q & 31, kb = q2 >> 2, nb = q2 & 3;
            src = P.in[3] + ((size_t)(b * 2 + l) * 512 + 64 * kb) * 512 + h * 128 + 32 * nb; sld = 512;
            dst = (bf16*)(P.ws + WS_VT + 8 * MiB) + ((size_t)(b * 4 + h) * 128 + 32 * nb) * 2560 + 2048 + 64 * kb; dld = 2560; }
        tr_item(src, sld, dst, dld, scr, lane);
    }
    __syncthreads();
    { bf16* kS = (bf16*)(P.ws + WS_K + 8 * MiB);
      for (int idx = bid * 512 + tid; idx < 4 * 512 * 4 * 2 * 16; idx += G * 512) {
          const int d4 = idx & 15, map = (idx >> 4) & 1, h = (idx >> 5) & 3, p = (idx >> 7) & 511, b = idx >> 16;
          const f32x4 v = *(const f32x4*)(P.in[2] + ((((size_t)(b * 2 + l) * 512 + p) * 4 + h) * 2 + map) * 64 + d4 * 4);
          v2u w; w.x = pk2(v.x, v.y); w.y = pk2(v.z, v.w);
          *(v2u*)(kS + (((size_t)(b * 4 + h) * 2 + map) * 2560 + 2048 + p) * 64 + d4 * 4) = w; } }
    { const float* g = P.in[6] + l * 1024; const float* mod = (const float*)(P.ws + WS_MOD) + l * 5 * 3072; bf16* H = (bf16*)(P.ws + WS_H);
      f32x4 gg[4];
#pragma unroll
      for (int j = 0; j < 4; ++j) gg[j] = *(const f32x4*)(g + 4 * lane + 256 * j);
      const int HB = G >= 256 ? G - 32 : G; const int NGWH = HB * 8;
      if (bid < HB)
      for (int m0 = gw; m0 < NTOK; m0 += 2 * NGWH) {
          f32x4 v[2][4], sh[2][4], scl[2][4]; float s[2] = {0.f, 0.f};
#pragma unroll
          for (int u = 0; u < 2; ++u) { const int m = m0 + u * NGWH < NTOK ? m0 + u * NGWH : m0; const float* xr = m < NPT ? xsrcP + (size_t)m * 1024 : xsrcS + (size_t)(m - NPT) * 1024;
              const int r = m < NPT ? 0 : 1 + ((m - NPT) >> 11); const float* md = mod + r * 3072;
#pragma unroll
              for (int j = 0; j < 4; ++j) { const int c0 = 4 * lane + 256 * j; v[u][j] = *(const f32x4*)(xr + c0); sh[u][j] = *(const f32x4*)(md + c0); scl[u][j] = *(const f32x4*)(md + 1024 + c0); } }
#pragma unroll
          for (int u = 0; u < 2; ++u) { const int m = m0 + u * NGWH; if (m < NTOK) {
#pragma unroll
              for (int j = 0; j < 4; ++j) s[u] += (v[u][j].x * v[u][j].x + v[u][j].y * v[u][j].y) + (v[u][j].z * v[u][j].z + v[u][j].w * v[u][j].w);
#pragma unroll
              for (int o = 1; o < 64; o <<= 1) s[u] += __shfl_xor(s[u], o);
              const float rstd = rsqrtf(s[u] * (1.f / 1024.f) + 1e-6f);
#pragma unroll
              for (int j = 0; j < 4; ++j) { const int c0 = 4 * lane + 256 * j;
                  const f32x4 o = v[u][j] * rstd * gg[j] * (scl[u][j] + 1.f) + sh[u][j]; v2u w; w.x = pk2(o.x, o.y); w.y = pk2(o.z, o.w);
                  *(v2u*)(H + (size_t)m * 1024 + c0) = w; } } }
      } }
    for (int n = 0; ; ++n) {
        int item;
        if (G >= 256) { if (n >= 2) break; item = n == 0 ? (bid < 256 ? bid : -1) : (bid >= G - 32 ? 256 + bid - (G - 32) : -1); }
        else { item = bid + n * G; if (item >= 288) break; }
        if (item < 0) continue;
        const int stream = item < 256 ? 1 : 0; const int t0 = (stream ? item : item - 256) * 8; hraw_item(P, lds, l, stream, t0, tid);
    }
}

using pg8::Unit; using pg8::cvt_pk_bf16;
DI v4u pack8(f32x4 a, f32x4 b) { v4u w; w.x = cvt_pk_bf16(a[0], a[1]); w.y = cvt_pk_bf16(a[2], a[3]); w.z = cvt_pk_bf16(b[0], b[1]); w.w = cvt_pk_bf16(b[2], b[3]); return w; }
DI f32x4 silu4(f32x4 v) { return (f32x4){siluf(v[0]), siluf(v[1]), siluf(v[2]), siluf(v[3])}; }

struct EpiHyT {
    static constexpr bool PERM = true, AFTER_DRAIN = false; bf16* O;
    DI void operator()(const f32x4 (&acc)[2][2][4][2], const Unit& u, int wr, int wc, int fr, int fq) const {
        const bool act = u.pm >= 6; const int row0 = u.pm * 256 + wr * 64 + fr, col0 = u.pn * 256 + wc * 32 + 8 * fq;
#pragma unroll
        for (int ai = 0; ai < 2; ++ai)
#pragma unroll
            for (int m = 0; m < 4; ++m) { bf16* rowp = O + (size_t)(row0 + ai * 128 + m * 16) * NTOK + col0;
#pragma unroll
                for (int bj = 0; bj < 2; ++bj) { f32x4 v0 = acc[ai][bj][m][0], v1 = acc[ai][bj][m][1]; if (act) { v0 = silu4(v0); v1 = silu4(v1); }
                    *(v4u*)(rowp + bj * 128) = pack8(v0, v1); } }
    }
};

struct EpiB {
    static constexpr bool PERM = true, AFTER_DRAIN = false;
    int l; const float *gq, *gk, *ropec, *ropes; unsigned char* ws; float* newk; float* newv;
    DI void operator()(const f32x4 (&acc)[2][2][4][2], const Unit& u, int wr, int wc, int fr, int fq) const {
        const int pn = u.pn; const bool isS = u.pm >= 32;
        const int tok0 = u.pm * 256 + wr * 64 + fr;
        if (pn < 4) {
            const bool isk = pn >= 2; const int hd = 2 * (pn & 1) + (wc >> 1), map = wc & 1; const float* g = isk ? gk : gq;
            f32x4 gv[2][2];
#pragma unroll
            for (int bj = 0; bj < 2; ++bj)
#pragma unroll
                for (int n = 0; n < 2; ++n) gv[bj][n] = *(const f32x4*)(g + 32 * bj + 8 * fq + 4 * n);
            bf16* base = (bf16*)(ws + (isk ? WS_K : WS_Q) + (isS ? 8 * MiB : 0)); const int Lb = isS ? (isk ? 2560 : 2048) : 256;
            float invv[2][2];
#pragma unroll
            for (int n = 0; n < 2; ++n)
#pragma unroll
                for (int p = 0; p < 2; ++p) invv[n][p] = __expf(-(float)(4 * fq + 2 * n + p) * (9.210340371976184f / 16.f));
#pragma unroll
            for (int ai = 0; ai < 2; ++ai)
#pragma unroll
                for (int m = 0; m < 4; ++m) {
                    const int tok = tok0 + ai * 128 + m * 16; int b, t; if (isS) { const int tt = tok - NPT; b = tt >> 11; t = tt & 2047; } else { b = tok >> 8; t = tok & 255; }
                    float ss = 0.f; f32x4 v[2][2];
#pragma unroll
                    for (int bj = 0; bj < 2; ++bj)
#pragma unroll
                        for (int n = 0; n < 2; ++n) { const f32x4 x = acc[ai][bj][m][n]; ss += (x[0] * x[0] + x[1] * x[1]) + (x[2] * x[2] + x[3] * x[3]); }
                    ss += __shfl_xor(ss, 16); ss += __shfl_xor(ss, 32);
                    const float rstd = rsqrtf(ss * (1.f / 64.f) + 1e-6f);
#pragma unroll
                    for (int bj = 0; bj < 2; ++bj)
#pragma unroll
                        for (int n = 0; n < 2; ++n) v[bj][n] = acc[ai][bj][m][n] * rstd * gv[bj][n];
                    if (isk && !isS) { float* nk = newk + ((size_t)(b * 2 + l) * 256 + t) * 512 + hd * 128 + map * 64 + 8 * fq;
#pragma unroll
                        for (int bj = 0; bj < 2; ++bj)
#pragma unroll
                            for (int n = 0; n < 2; ++n) *(f32x4*)(nk + 32 * bj + 4 * n) = v[bj][n]; }
                    if (isS) {
                        int tl = t; asm volatile("" : "+v"(tl)); const float rowf = (float)(tl >> 6), colf = (float)(tl & 63);
#pragma unroll
                        for (int bj = 0; bj < 2; ++bj)
#pragma unroll
                            for (int n = 0; n < 2; ++n) { const float base = bj == 0 ? rowf : colf; const float a0 = base * invv[n][0], a1 = base * invv[n][1];
                                const float r0 = a0 * 0.15915494309189535f, r1 = a1 * 0.15915494309189535f; const float c0 = __builtin_amdgcn_cosf(r0), s0 = __builtin_amdgcn_sinf(r0), c1 = __builtin_amdgcn_cosf(r1), s1 = __builtin_amdgcn_sinf(r1);
                                const f32x4 x = v[bj][n]; v[bj][n] = (f32x4){x[0] * c0 - x[1] * s0, x[0] * s0 + x[1] * c0, x[2] * c1 - x[3] * s1, x[2] * s1 + x[3] * c1}; }
                    }
                    if (!isk) {
#pragma unroll
                        for (int bj = 0; bj < 2; ++bj)
#pragma unroll
                            for (int n = 0; n < 2; ++n) v[bj][n] = v[bj][n] * 0.18033688011112042f;
                    }
                    bf16* dp = base + ((size_t)((b * 4 + hd) * 2 + map) * Lb + t) * 64 + 8 * fq;
#pragma unroll
                    for (int bj = 0; bj < 2; ++bj) *(v4u*)(dp + 32 * bj) = pack8(v[bj][0], v[bj][1]);
                }
        } else if (pn < 6) {
            bf16* vt = (bf16*)(ws + WS_VT + (isS ? 8 * MiB : 0)); const int Lk = isS ? 2560 : 256;
#pragma unroll
            for (int ai = 0; ai < 2; ++ai)
#pragma unroll
                for (int m = 0; m < 4; ++m) {
                    const int tok = tok0 + ai * 128 + m * 16; int b, t; if (isS) { const int tt = tok - NPT; b = tt >> 11; t = tt & 2047; } else { b = tok >> 8; t = tok & 255; }
#pragma unroll
                    for (int bj = 0; bj < 2; ++bj) { const int hd = 2 * (pn - 4) + bj;
#pragma unroll
                        for (int n = 0; n < 2; ++n) { const int dv = 32 * wc + 8 * fq + 4 * n; const f32x4 x = acc[ai][bj][m][n];
                            if (!isS) *(f32x4*)(newv + ((size_t)(b * 2 + l) * 256 + t) * 512 + hd * 128 + dv) = x;
                            bf16* vp = vt + ((size_t)(b * 4 + hd) * 128 + dv) * Lk + t;
#pragma unroll
                            for (int e = 0; e < 4; ++e) vp[(size_t)e * Lk] = (bf16)f2bf(x[e]); } }
                }
        } else {
            const int which = (pn - 6) >> 1; bf16* dst = (bf16*)(ws + (which == 0 ? WS_ATZ : which == 1 ? WS_PLU : WS_PLZ)); const bool act = which != 1;
            const int col0 = 256 * ((pn - 6) & 1) + 32 * wc + 8 * fq;
#pragma unroll
            for (int ai = 0; ai < 2; ++ai)
#pragma unroll
                for (int m = 0; m < 4; ++m) { bf16* rowp = dst + (size_t)(tok0 + ai * 128 + m * 16) * 512 + col0;
#pragma unroll
                    for (int bj = 0; bj < 2; ++bj) { f32x4 v0 = acc[ai][bj][m][0], v1 = acc[ai][bj][m][1]; if (act) { v0 = silu4(v0); v1 = silu4(v1); }
                        *(v4u*)(rowp + bj * 128) = pack8(v0, v1); } }
        }
    }
};

struct BrOrder {
    int G, c;
    DI bool next(int i, Unit& u) const { const int L = i * G + c; if (L >= 768) return false; const int j = L >> 8, r0 = L & 255; const int r = (r0 & 7) * 32 + (r0 >> 3);
        u.pm = j * 64 + (r >> 2); u.pn = j * 4 + (r & 3); return true; }
    DI void a_ready(const Unit&) const {}
    DI void done(const Unit&) const {}
};
struct EpiBr {
    static constexpr bool PERM = true, AFTER_DRAIN = false; bf16* O;
    DI void operator()(const f32x4 (&acc)[2][2][4][2], const Unit& u, int wr, int wc, int fr, int fq) const {
        const int row0 = (u.pm & 63) * 256 + wr * 64 + fr, col0 = u.pn * 256 + wc * 32 + 8 * fq;
#pragma unroll
        for (int ai = 0; ai < 2; ++ai)
#pragma unroll
            for (int m = 0; m < 4; ++m) { bf16* rowp = O + (size_t)(row0 + ai * 128 + m * 16) * 3072 + col0;
#pragma unroll
                for (int bj = 0; bj < 2; ++bj) *(v4u*)(rowp + bj * 128) = pack8(acc[ai][bj][m][0], acc[ai][bj][m][1]); }
    }
};
struct EpiGate {
    static constexpr bool PERM = true, AFTER_DRAIN = false; bf16* O;
    DI void operator()(const f32x4 (&acc)[2][2][4][2], const Unit& u, int wr, int wc, int fr, int fq) const {
        const int row0 = u.pm * 256 + wr * 64 + fr, col0 = u.pn * 256 + wc * 32 + 8 * fq;
        bf16* base = O + (size_t)row0 * 3072 + col0;
        v4u bv[2][4][2];
#pragma unroll
        for (int ai = 0; ai < 2; ++ai)
#pragma unroll
            for (int m = 0; m < 4; ++m)
#pragma unroll
                for (int bj = 0; bj < 2; ++bj) bv[ai][m][bj] = *(const v4u*)(base + (size_t)(ai * 128 + m * 16) * 3072 + bj * 128);
        asm volatile("s_waitcnt vmcnt(0)" ::: "memory");
#pragma unroll
        for (int ai = 0; ai < 2; ++ai)
#pragma unroll
            for (int m = 0; m < 4; ++m)
#pragma unroll
                for (int bj = 0; bj < 2; ++bj) { const v4u b = bv[ai][m][bj]; const f32x4 g0 = acc[ai][bj][m][0], g1 = acc[ai][bj][m][1];
                    const f32x4 o0 = (f32x4){sigmf(g0[0]) * bflo(b.x), sigmf(g0[1]) * bfhi(b.x), sigmf(g0[2]) * bflo(b.y), sigmf(g0[3]) * bfhi(b.y)};
                    const f32x4 o1 = (f32x4){sigmf(g1[0]) * bflo(b.z), sigmf(g1[1]) * bfhi(b.z), sigmf(g1[2]) * bflo(b.w), sigmf(g1[3]) * bfhi(b.w)};
                    *(v4u*)(base + (size_t)(ai * 128 + m * 16) * 3072 + bj * 128) = pack8(o0, o1); }
    }
};
struct EpiOut {
    static constexpr bool PERM = true, AFTER_DRAIN = false; const float* xP; const float* xS; float* out; const float* mod;
    DI void operator()(const f32x4 (&acc)[2][2][4][2], const Unit& u, int wr, int wc, int fr, int fq) const {
        const int row0 = u.pm * 256 + wr * 64 + fr, col0 = u.pn * 256 + wc * 32 + 8 * fq;
        const int r = u.pm < 32 ? 0 : 1 + ((u.pm - 32) >> 3);
        const float* gt = mod + r * 3072 + 2048 + col0;
        f32x4 gv[2][2];
#pragma unroll
        for (int bj = 0; bj < 2; ++bj)
#pragma unroll
            for (int n = 0; n < 2; ++n) gv[bj][n] = *(const f32x4*)(gt + bj * 128 + 4 * n);
        const float* xb = (u.pm < 32 ? xP + (size_t)row0 * 1024 : xS + (size_t)(row0 - NPT) * 1024) + col0; float* ob = out + (size_t)row0 * 1024 + col0;
#pragma unroll
        for (int ai = 0; ai < 2; ++ai) {
            f32x4 xv[4][2][2];
#pragma unroll
            for (int m = 0; m < 4; ++m)
#pragma unroll
                for (int bj = 0; bj < 2; ++bj)
#pragma unroll
                    for (int n = 0; n < 2; ++n) xv[m][bj][n] = *(const f32x4*)(xb + (size_t)(ai * 128 + m * 16) * 1024 + bj * 128 + 4 * n);
            asm volatile("s_waitcnt vmcnt(0)" ::: "memory");
#pragma unroll
            for (int m = 0; m < 4; ++m)
#pragma unroll
                for (int bj = 0; bj < 2; ++bj)
#pragma unroll
                    for (int n = 0; n < 2; ++n) *(f32x4*)(ob + (size_t)(ai * 128 + m * 16) * 1024 + bj * 128 + 4 * n) = xv[m][bj][n] + gv[bj][n] * acc[ai][bj][m][n];
        }
    }
};

DI f32x4 conv4(const bf16* row, int s0, int t4, int L, float w0, float w1, float w2, float bias) {
    const bf16* p = row + s0 + t4; const v2u raw = *(const v2u*)p;
    const float x0 = bflo(raw.x), x1 = bfhi(raw.x), x2 = bflo(raw.y), x3 = bfhi(raw.y);
    const unsigned short rm = p[t4 > 0 ? -1 : 0], rp = p[(t4 + 4 < L) ? 4 : 3];
    const float xm = t4 > 0 ? bf2f(rm) : 0.f, xp = (t4 + 4 < L) ? bf2f(rp) : 0.f;
    return (f32x4){w0 * xm + w1 * x0 + w2 * x1 + bias, w0 * x0 + w1 * x1 + w2 * x2 + bias, w0 * x1 + w1 * x2 + w2 * x3 + bias, w0 * x2 + w1 * x3 + w2 * xp + bias};
}

#define LBAR() do { asm volatile("s_waitcnt lgkmcnt(0)" ::: "memory"); __builtin_amdgcn_s_barrier(); asm volatile("" ::: "memory"); } while (0)
struct Q4 { v2u raw; unsigned rm, rp; };
DI Q4 ld4(const bf16* row, int s0, int t4, int L) { const bf16* p = row + s0 + t4; Q4 q; q.raw = *(const v2u*)p; q.rm = p[t4 > 0 ? -1 : 0]; q.rp = p[(t4 + 4 < L) ? 4 : 3]; return q; }
DI f32x4 cv4(const Q4& q, int t4, int L, float w0, float w1, float w2, float bias) {
    const float x0 = bflo(q.raw.x), x1 = bfhi(q.raw.x), x2 = bflo(q.raw.y), x3 = bfhi(q.raw.y);
    const float xm = t4 > 0 ? bf2f(q.rm) : 0.f, xp = (t4 + 4 < L) ? bf2f(q.rp) : 0.f;
    return (f32x4){w0 * xm + w1 * x0 + w2 * x1 + bias, w0 * x0 + w1 * x1 + w2 * x2 + bias, w0 * x1 + w1 * x2 + w2 * x3 + bias, w0 * x2 + w1 * x3 + w2 * xp + bias};
}
DI void hyena_job(const Params& P, LAS unsigned char* lds, int l, int stream, int c, int tid, int lane, int wave) {
    const int L = stream ? 2048 : 256, Bn = stream ? 4 : 32, NB = L / 16, tokbase = stream ? NPT : 0;
    const int RCS = 2 * L + 16;
    const int RCB = 8 * RCS * 2, UN = Bn * (L + 256) + 256, UB = UN * 2;
    LAS bf16* RC = (LAS bf16*)lds; LAS bf16* U1 = (LAS bf16*)(lds + RCB); LAS bf16* U2 = (LAS bf16*)(lds + RCB + UB);
    LAS bf16* GR = (LAS bf16*)(lds + RCB + 2 * UB); LAS float* red = (LAS float*)(lds + RCB + 2 * UB + 8 * L);
    LAS bf16* GV = (LAS bf16*)(lds + RCB + 2 * UB + 8 * L + 64);
    const bf16* hyT = (const bf16*)(P.ws + WS_HYT);
    const bf16* rx1 = hyT + (size_t)c * NTOK; const bf16* rx2 = hyT + (size_t)(512 + c) * NTOK; const bf16* rv = hyT + (size_t)(1024 + c) * NTOK; const bf16* rz = hyT + (size_t)(1536 + c) * NTOK;
    const float* cw = P.in[10] + l * 3 * 1536; const float* cb = P.in[11] + l * 1536;
    const bf16* hraw = (const bf16*)(P.ws + WS_HRAW) + (stream ? 0 : (size_t)2 * 512 * 2 * 2048);
    const int a = lane & 15, g = lane >> 4, gb = g & 1, gh = g >> 1;
    const int kap = (16 - a) & 7, A8 = (a + 7) & ~7;
    const int i0 = stream ? 32 * (wave & 3) + 16 * (wave >> 2) : 0, b0 = stream ? 0 : 4 * wave;
    const int mlo = i0 - NB, nks = (NB + 16) / 2;
    const int t4o = 16 * (i0 + a) + 4 * g;
    v4u gr[2]; const int nvec = L / 2;
#pragma unroll
    for (int i = 0; i < 2; ++i) { const int idx = tid + 512 * i; const int e8 = (idx < nvec ? idx : 0) * 8; const int o = e8 / (2 * L), rem = e8 - o * 2 * L;
        gr[i] = *(const v4u*)(hraw + (size_t)((o * 512 + c) * 2) * L + rem); }
    Q4 qv[4], q1[4], q2[4]; v2u qz[4];
#pragma unroll
    for (int i = 0; i < 4; ++i) { const int q = tid + 512 * i; const int b = q / (L / 4), t4 = (q % (L / 4)) * 4; qv[i] = ld4(rv, tokbase + b * L, t4, L); }
#pragma unroll
    for (int b = 0; b < 4; ++b) { const int s0 = tokbase + (b0 + b) * L; q1[b] = ld4(rx1, s0, t4o, L); q2[b] = ld4(rx2, s0, t4o, L); qz[b] = *(const v2u*)(rz + s0 + t4o); }
    for (int i = tid; i < (2 * UB) / 16; i += 512) ((LAS v4u*)U1)[i] = (v4u){0u, 0u, 0u, 0u};
    LBAR();
#pragma unroll
    for (int i = 0; i < 2; ++i) { const int idx = tid + 512 * i; if (idx < nvec) *(LAS v4u*)(GR + idx * 8) = gr[i]; }
    { const float w0 = cw[1024 + c], w1 = cw[1536 + 1024 + c], w2 = cw[3072 + 1024 + c], bb = cb[1024 + c];
#pragma unroll
      for (int i = 0; i < 4; ++i) { const int q = tid + 512 * i; const int b = q / (L / 4), t4 = (q % (L / 4)) * 4; const f32x4 v = cv4(qv[i], t4, L, w0, w1, w2, bb);
          v2u w; w.x = pk2(v[0], v[1]); w.y = pk2(v[2], v[3]); *(LAS v2u*)(U1 + 256 + b * (L + 256) + t4) = w; } }
    LBAR();
    { const int per = (2 * L) / 512;
      float s0 = 0.f, s1 = 0.f;
      for (int k = 0; k < per; ++k) { const int e = tid + 512 * k; const float v0 = fabsf(bf2f(GR[e])), v1 = fabsf(bf2f(GR[2 * L + e])); const bool ok = e != L; s0 += ok ? v0 : 0.f; s1 += ok ? v1 : 0.f; }
#pragma unroll
      for (int of = 1; of < 64; of <<= 1) { s0 += __shfl_xor(s0, of); s1 += __shfl_xor(s1, of); }
      if (lane == 0) { red[wave * 2] = s0; red[wave * 2 + 1] = s1; } }
    LBAR();
    float inv[2];
#pragma unroll
    for (int o = 0; o < 2; ++o) { float sm = 0.f;
#pragma unroll
        for (int w = 0; w < 8; ++w) sm += red[w * 2 + o];
        inv[o] = 1.f / (sm + 1e-6f); }
#pragma unroll 1
    for (int o = 0; o < 2; ++o) {
        { const LAS bf16* G0 = GR + o * 2 * L; const float sc = inv[o];
          for (int x = tid; x < 2 * L + 32; x += 512) { const int d = L - x; const bool ok = d > -L && d < L; int idx = d >= 0 ? d : L - d; idx = idx < 0 ? 0 : (idx > 2 * L - 1 ? 2 * L - 1 : idx);
              const float v = bf2f(G0[idx]) * sc; GV[x] = (bf16)f2bf(ok ? v : 0.f); } }
        LBAR();
        for (int yq = tid; yq < RCS / 4; yq += 512) { const int y = 4 * yq; const LAS v2u* gp = (const LAS v2u*)(GV + y);
            const v2u a0 = gp[0], a1 = gp[1], a2 = gp[2]; const unsigned w[6] = {a0.x, a0.y, a1.x, a1.y, a2.x, a2.y};
#pragma unroll
            for (int k = 0; k < 8; ++k) { const int jd = k >> 1; v2u o2;
                if ((k & 1) == 0) { o2.x = w[jd]; o2.y = w[jd + 1]; }
                else { o2.x = __builtin_amdgcn_alignbit(w[jd + 1], w[jd], 16); o2.y = __builtin_amdgcn_alignbit(w[jd + 2], w[jd + 1], 16); }
                *(LAS v2u*)(RC + k * RCS + y) = o2; } }
        LBAR();
        LAS bf16* U = o == 0 ? U1 : U2;
        f32x4 acc[4];
#pragma unroll
        for (int b = 0; b < 4; ++b) acc[b] = (f32x4){0.f, 0.f, 0.f, 0.f};
        if (stream) {
            const int tp = wave & 3, kh = wave >> 2, i0a = 32 * tp, mloa = i0a - NB, hks = nks / 2;
            f32x4 ac2[2][4];
#pragma unroll
            for (int t = 0; t < 2; ++t)
#pragma unroll
                for (int b = 0; b < 4; ++b) ac2[t][b] = (f32x4){0.f, 0.f, 0.f, 0.f};
            const LAS bf16* apa = RC + kap * RCS + L - 16 * (mloa + gh) - A8 + 8 * gb - 32 * (kh * hks);
            const LAS bf16* bpp = U + 256 + 16 * (i0a + a - mloa - gh) + 8 * gb - 32 * (kh * hks);
            bf16x8 afa = *(const LAS bf16x8*)apa, afb = *(const LAS bf16x8*)(apa - 256); bf16x8 bfr[4];
#pragma unroll
            for (int b = 0; b < 4; ++b) bfr[b] = *(const LAS bf16x8*)(bpp + b * (L + 256));
#pragma unroll 2
            for (int ks = 0; ks < hks; ++ks) {
                const int kn = ks + 1 < hks ? ks + 1 : ks;
                const bf16x8 nafa = *(const LAS bf16x8*)(apa - 32 * kn), nafb = *(const LAS bf16x8*)(apa - 256 - 32 * kn); bf16x8 nb[4];
#pragma unroll
                for (int b = 0; b < 4; ++b) nb[b] = *(const LAS bf16x8*)(bpp - 32 * kn + b * (L + 256));
#pragma unroll
                for (int b = 0; b < 4; ++b) { ac2[0][b] = MFMA16(afa, bfr[b], ac2[0][b]); ac2[1][b] = MFMA16(afb, bfr[b], ac2[1][b]); }
                afa = nafa; afb = nafb;
#pragma unroll
                for (int b = 0; b < 4; ++b) bfr[b] = nb[b];
            }
            LBAR();
            LAS f32x4* xch = (LAS f32x4*)RC;
#pragma unroll
            for (int b = 0; b < 4; ++b) xch[(wave * 4 + b) * 64 + lane] = ac2[1 - kh][b];
            LBAR();
#pragma unroll
            for (int b = 0; b < 4; ++b) acc[b] = ac2[kh][b] + xch[((wave ^ 4) * 4 + b) * 64 + lane];
        } else {
        const LAS bf16* ap = RC + kap * RCS + L - 16 * (mlo + gh) - A8 + 8 * gb;
        const LAS bf16* bp = U + 256 + b0 * (L + 256) + 16 * (i0 + a - mlo - gh) + 8 * gb;
        bf16x8 af = *(const LAS bf16x8*)ap; bf16x8 bfr[4];
#pragma unroll
        for (int b = 0; b < 4; ++b) bfr[b] = *(const LAS bf16x8*)(bp + b * (L + 256));
#pragma unroll 4
        for (int ks = 0; ks < nks; ++ks) {
            const int kn = ks + 1 < nks ? ks + 1 : ks;
            const bf16x8 naf = *(const LAS bf16x8*)(ap - 32 * kn); bf16x8 nb[4];
#pragma unroll
            for (int b = 0; b < 4; ++b) nb[b] = *(const LAS bf16x8*)(bp - 32 * kn + b * (L + 256));
#pragma unroll
            for (int b = 0; b < 4; ++b) acc[b] = MFMA16(af, bfr[b], acc[b]);
            af = naf;
#pragma unroll
            for (int b = 0; b < 4; ++b) bfr[b] = nb[b];
        }
        }
        const float bias = P.in[18][(l * 2 + o) * 512 + c];
        if (o == 0) {
            const float w0 = cw[c], w1 = cw[1536 + c], w2 = cw[3072 + c], bb = cb[c];
#pragma unroll
            for (int b = 0; b < 4; ++b) { const int bq = b0 + b; const f32x4 x1 = cv4(q1[b], t4o, L, w0, w1, w2, bb);
                const v2u uv = *(const LAS v2u*)(U1 + 256 + bq * (L + 256) + t4o);
                const f32x4 y = (f32x4){x1[0] * (acc[b][0] + bias * bflo(uv.x)), x1[1] * (acc[b][1] + bias * bfhi(uv.x)), x1[2] * (acc[b][2] + bias * bflo(uv.y)), x1[3] * (acc[b][3] + bias * bfhi(uv.y))};
                v2u w; w.x = pk2(y[0], y[1]); w.y = pk2(y[2], y[3]); *(LAS v2u*)(U2 + 256 + bq * (L + 256) + t4o) = w; }
        } else {
            const float w0 = cw[512 + c], w1 = cw[1536 + 512 + c], w2 = cw[3072 + 512 + c], bb = cb[512 + c];
            bf16* yh = (bf16*)(P.ws + WS_HYT) + (size_t)(1536 + c) * NTOK;
#pragma unroll
            for (int b = 0; b < 4; ++b) { const int bq = b0 + b; const int tok = tokbase + bq * L + t4o; const f32x4 x2 = cv4(q2[b], t4o, L, w0, w1, w2, bb);
                const v2u uv = *(const LAS v2u*)(U2 + 256 + bq * (L + 256) + t4o); const v2u zz = qz[b];
                const f32x4 y = (f32x4){x2[0] * (acc[b][0] + bias * bflo(uv.x)) * bflo(zz.x), x2[1] * (acc[b][1] + bias * bfhi(uv.x)) * bfhi(zz.x),
                                        x2[2] * (acc[b][2] + bias * bflo(uv.y)) * bflo(zz.y), x2[3] * (acc[b][3] + bias * bfhi(uv.y)) * bfhi(zz.y)};
                v2u w; w.x = pk2(y[0], y[1]); w.y = pk2(y[2], y[3]); *(v2u*)(yh + tok) = w; }
        }
        LBAR();
    }
    __syncthreads();
}

DI void yhy_transpose(const Params& P, LAS unsigned char* lds, int lane, int wave, int bid, int G) {
    const bf16* src0 = (const bf16*)(P.ws + WS_HYT) + (size_t)1536 * NTOK; bf16* dst0 = (bf16*)(P.ws + WS_YHY);
    LAS unsigned char* scr = lds + wave * 9216;
    for (int it = bid * 8 + wave; it < 2048; it += G * 8) {
        const int ch0 = (it >> 8) * 64, tok0 = (it & 255) * 64;
        v4u v[8];
#pragma unroll
        for (int i = 0; i < 8; ++i) { const int idx = lane + 64 * i, ch = idx >> 3, chunk = idx & 7; v[i] = *(const v4u*)(src0 + (size_t)(ch0 + ch) * NTOK + tok0 + chunk * 8); }
#pragma unroll
        for (int i = 0; i < 8; ++i) { const int idx = lane + 64 * i, ch = idx >> 3, chunk = idx & 7; *(LAS v4u*)(scr + ch * 144 + chunk * 16) = v[i]; }
        LDS_WAIT(); asm volatile("" ::: "memory");
#pragma unroll
        for (int i = 0; i < 8; ++i) { const int idx = lane + 64 * i, tok = idx >> 3, cc = idx & 7; const LAS bf16* p = (const LAS bf16*)(scr + (cc * 8) * 144) + tok;
            v4u o; o.x = (unsigned)p[0] | ((unsigned)p[72] << 16); o.y = (unsigned)p[144] | ((unsigned)p[216] << 16); o.z = (unsigned)p[288] | ((unsigned)p[360] << 16); o.w = (unsigned)p[432] | ((unsigned)p[504] << 16);
            *(v4u*)(dst0 + (size_t)(tok0 + tok) * 512 + ch0 + cc * 8) = o; }
        LDS_WAIT(); asm volatile("" ::: "memory");
    }
}

DI void merge_sum(const Params& P, int tid, int bid, int G) {
    const bf16* B = (const bf16*)(P.ws + WS_BBUF); bf16* M = (bf16*)(P.ws + WS_YHY);
    for (int idx0 = bid * 512 + tid; idx0 < NTOK * 128; idx0 += 4 * G * 512) {
        v4u a[4], b[4], c[4];
#pragma unroll
        for (int u = 0; u < 4; ++u) { const int idx = idx0 + u * G * 512 < NTOK * 128 ? idx0 + u * G * 512 : idx0; const int row = idx >> 7, c8 = (idx & 127) * 8; const bf16* p = B + (size_t)row * 3072 + c8;
            a[u] = *(const v4u*)p; b[u] = *(const v4u*)(p + 1024); c[u] = *(const v4u*)(p + 2048); }
#pragma unroll
        for (int u = 0; u < 4; ++u) { const int idx = idx0 + u * G * 512; if (idx < NTOK * 128) { const int row = idx >> 7, c8 = (idx & 127) * 8;
            const f32x4 lo = (f32x4){bflo(a[u].x) + bflo(b[u].x) + bflo(c[u].x), bfhi(a[u].x) + bfhi(b[u].x) + bfhi(c[u].x), bflo(a[u].y) + bflo(b[u].y) + bflo(c[u].y), bfhi(a[u].y) + bfhi(b[u].y) + bfhi(c[u].y)};
            const f32x4 hi = (f32x4){bflo(a[u].z) + bflo(b[u].z) + bflo(c[u].z), bfhi(a[u].z) + bfhi(b[u].z) + bfhi(c[u].z), bflo(a[u].w) + bflo(b[u].w) + bflo(c[u].w), bfhi(a[u].w) + bfhi(b[u].w) + bfhi(c[u].w)};
            v4u o; o.x = pk2(lo[0], lo[1]); o.y = pk2(lo[2], lo[3]); o.z = pk2(hi[0], hi[1]); o.w = pk2(hi[2], hi[3]);
            *(v4u*)(M + (size_t)row * 1024 + c8) = o; } }
    }
}

DI void attn_job(const Params& P, LAS unsigned char* lds, int l, int stream, int job, int tid, int lane, int wave) {
    const int Lq = stream ? 2048 : 256, Lk = stream ? 2560 : 256, nqb = Lq / 128;
    int jr = job; if ((256 % 8) == 0) { const int xcd = job & 7, idx = job >> 3; jr = xcd * 32 + idx; }
    const int qb = jr % nqb, bh = jr / nqb;
    const int qs = wave >> 1, map = wave & 1, r = lane & 31, hh = lane >> 5;
    const bf16* Q = (const bf16*)(P.ws + WS_Q + (stream ? 8 * MiB : 0)) + ((size_t)(bh * 2 + map) * Lq + qb * 128 + qs * 32 + r) * 64;
    const bf16* K = (const bf16*)(P.ws + WS_K + (stream ? 8 * MiB : 0)) + (size_t)(bh * 2) * Lk * 64;
    const bf16* VT = (const bf16*)(P.ws + WS_VT + (stream ? 8 * MiB : 0)) + (size_t)bh * 128 * Lk;
    bf16x8 qf[4];
#pragma unroll
    for (int ks = 0; ks < 4; ++ks) qf[ks] = *(const bf16x8*)(Q + 16 * ks + 8 * hh);
    constexpr int KTB = 18432, BUFB = 36864, PWOFF = 2 * BUFB;
    LAS unsigned char* pw = lds + PWOFF + wave * 4608;
    const bf16* ksrc[2]; int kdst[2]; const bf16* vsrc[2]; int vdst[2];
#pragma unroll
    for (int i = 0; i < 2; ++i) { const int idx = tid + 512 * i; const int mp = idx >> 9, key = (idx >> 3) & 63, ch = idx & 7;
        ksrc[i] = K + ((size_t)mp * Lk + key) * 64 + ch * 8; kdst[i] = mp * 9216 + key * 144 + ch * 16;
        const int dv = idx >> 3; vsrc[i] = VT + (size_t)dv * Lk + ch * 8; vdst[i] = KTB + dv * 144 + (16 * (ch >> 1) + 4 * (ch & 1)) * 2; }
    const int nkt = Lk / 64;
    v4u kr[2], vr[2];
#pragma unroll
    for (int i = 0; i < 2; ++i) { kr[i] = *(const v4u*)ksrc[i]; vr[i] = *(const v4u*)vsrc[i]; }
#pragma unroll
    for (int i = 0; i < 2; ++i) { *(LAS v4u*)(lds + kdst[i]) = kr[i]; *(LAS v2u*)(lds + vdst[i]) = (v2u){vr[i].x, vr[i].y}; *(LAS v2u*)(lds + vdst[i] + 16) = (v2u){vr[i].z, vr[i].w}; }
    __syncthreads();
    f32x16 oacc[4];
#pragma unroll
    for (int d = 0; d < 4; ++d)
#pragma unroll
        for (int i = 0; i < 16; ++i) oacc[d][i] = 0.f;
    float mrun = -1e30f, lsum = 0.f;
#pragma unroll 1
    for (int kt = 0; kt < nkt; ++kt) {
        const int buf = kt & 1; const bool more = kt + 1 < nkt;
        if (more) {
#pragma unroll
            for (int i = 0; i < 2; ++i) { kr[i] = *(const v4u*)(ksrc[i] + (size_t)(kt + 1) * 64 * 64); vr[i] = *(const v4u*)(vsrc[i] + (kt + 1) * 64); } }
        const LAS unsigned char* kt_ = lds + buf * BUFB + map * 9216; const LAS unsigned char* vt_ = lds + buf * BUFB + KTB;
        f32x16 s[2];
#pragma unroll
        for (int kh = 0; kh < 2; ++kh) {
#pragma unroll
            for (int i = 0; i < 16; ++i) s[kh][i] = 0.f;
#pragma unroll
            for (int ks = 0; ks < 4; ++ks) { const bf16x8 kf = *(const LAS bf16x8*)(kt_ + (32 * kh + r) * 144 + (16 * ks + 8 * hh) * 2); s[kh] = MFMA32(kf, qf[ks], s[kh]); }
        }
        float mx = s[0][0];
#pragma unroll
        for (int kh = 0; kh < 2; ++kh)
#pragma unroll
            for (int i = 0; i < 16; ++i) mx = fmaxf(mx, s[kh][i]);
        mx = fmaxf(mx, __shfl_xor(mx, 32));
        const float mnew = fmaxf(mrun, mx); const float alpha = __builtin_amdgcn_exp2f(mrun - mnew); mrun = mnew;
        float ps = 0.f;
#pragma unroll
        for (int kh = 0; kh < 2; ++kh)
#pragma unroll
            for (int i = 0; i < 16; ++i) { const float p = __builtin_amdgcn_exp2f(s[kh][i] - mnew); s[kh][i] = p; ps += p; }
        lsum = lsum * alpha + ps;
        if (!__all(alpha == 1.0f)) {
#pragma unroll
        for (int d = 0; d < 4; ++d)
#pragma unroll
            for (int i = 0; i < 16; ++i) oacc[d][i] *= alpha;
        }
#pragma unroll
        for (int k2 = 0; k2 < 4; ++k2) { const int kh = k2 >> 1, sb = 8 * (k2 & 1); v4u pk;
            asm volatile("v_cvt_pk_bf16_f32 %0, %4, %5\n\tv_cvt_pk_bf16_f32 %1, %6, %7\n\tv_cvt_pk_bf16_f32 %2, %8, %9\n\tv_cvt_pk_bf16_f32 %3, %10, %11\n\ts_nop 1"
                         : "=&v"(pk.x), "=&v"(pk.y), "=&v"(pk.z), "=&v"(pk.w)
                         : "v"(s[kh][sb]), "v"(s[kh][sb + 1]), "v"(s[kh][sb + 2]), "v"(s[kh][sb + 3]), "v"(s[kh][sb + 4]), "v"(s[kh][sb + 5]), "v"(s[kh][sb + 6]), "v"(s[kh][sb + 7]));
            const bf16x8 pf = __builtin_bit_cast(bf16x8, pk);
#pragma unroll
            for (int d = 0; d < 4; ++d) { const bf16x8 vf = *(const LAS bf16x8*)(vt_ + (32 * d + r) * 144 + (16 * k2 + 8 * hh) * 2); oacc[d] = MFMA32(vf, pf, oacc[d]); } }
        if (more) {
#pragma unroll
            for (int i = 0; i < 2; ++i) { *(LAS v4u*)(lds + (buf ^ 1) * BUFB + kdst[i]) = kr[i]; *(LAS v2u*)(lds + (buf ^ 1) * BUFB + vdst[i]) = (v2u){vr[i].x, vr[i].y}; *(LAS v2u*)(lds + (buf ^ 1) * BUFB + vdst[i] + 16) = (v2u){vr[i].z, vr[i].w}; } }
        __syncthreads();
    }
    lsum += __shfl_xor(lsum, 32);
    const float il = 1.f / lsum;
    LAS float* X = (LAS float*)lds + qs * 4096;
    if (map == 1) {
#pragma unroll
        for (int d = 0; d < 4; ++d)
#pragma unroll
            for (int i = 0; i < 16; ++i) { const int dv = 32 * d + (i & 3) + 8 * (i >> 2) + 4 * hh; X[dv * 32 + r] = oacc[d][i] * il; }
    }
    __syncthreads();
    if (map == 0) {
        const float lam = ((const float*)(P.ws + WS_LAM))[l]; const float lam_init = 0.8f - 0.6f * expf(-0.3f * (float)l);
        float ss = 0.f;
#pragma unroll
        for (int d = 0; d < 4; ++d)
#pragma unroll
            for (int i = 0; i < 16; ++i) { const int dv = 32 * d + (i & 3) + 8 * (i >> 2) + 4 * hh; const float o = oacc[d][i] * il - lam * X[dv * 32 + r]; oacc[d][i] = o; ss += o * o; }
        ss += __shfl_xor(ss, 32);
        const float rstd = rsqrtf(ss * (1.f / 128.f) + 1e-6f) * (1.f - lam_init);
        const float* sg = P.in[23] + l * 128;
        const int b = bh >> 2, h = bh & 3; const int tok = (stream ? NPT + b * 2048 : b * 256) + qb * 128 + qs * 32 + r;
        bf16* yat = (bf16*)(P.ws + WS_ATZ) + (size_t)tok * 512 + h * 128;
#pragma unroll
        for (int d = 0; d < 4; ++d) { f32x4 ggv[4]; v2u zzv[4];
#pragma unroll
            for (int rg = 0; rg < 4; ++rg) { const int dv = 32 * d + 8 * rg + 4 * hh; ggv[rg] = *(const f32x4*)(sg + dv); zzv[rg] = *(const v2u*)(yat + dv); }
#pragma unroll
            for (int rg = 0; rg < 4; ++rg) { const int dv = 32 * d + 8 * rg + 4 * hh; const f32x4 gg = ggv[rg]; const v2u zz = zzv[rg];
                v2u w; w.x = pk2(oacc[d][4 * rg] * rstd * gg[0] * bflo(zz.x), oacc[d][4 * rg + 1] * rstd * gg[1] * bfhi(zz.x));
                w.y = pk2(oacc[d][4 * rg + 2] * rstd * gg[2] * bflo(zz.y), oacc[d][4 * rg + 3] * rstd * gg[3] * bfhi(zz.y));
                *(v2u*)(yat + dv) = w; } }
    }
    __syncthreads();
}

template <int HALF>
DI void pool_means(const bf16* col2, int ts, int t0, int L, LAS bf16* Mt, int cp) {
    unsigned raw[48];
#pragma unroll
    for (int i = 8 - HALF; i < 40 + HALF; ++i) { const int tau = ts - 8 + i; const int tc = tau < 0 ? 0 : (tau >= L ? L - 1 : tau); const unsigned v = *(const unsigned*)(col2 + (size_t)tc * 512); raw[i] = (tau >= 0 && tau < L) ? v : 0u; }
    float s0 = 0.f, s1 = 0.f;
#pragma unroll
    for (int i = 8 - HALF; i < 8 + HALF; ++i) { s0 += bflo(raw[i]); s1 += bfhi(raw[i]); }
#pragma unroll
    for (int k = 0; k < 32; ++k) { const int t = ts + k; const int lo = t - HALF < 0 ? 0 : t - HALF, hi = t + HALF > L ? L : t + HALF; const float rc = 1.f / (float)(hi - lo);
        *(LAS unsigned*)(Mt + (t - t0) * 136 + 2 * cp) = pk2(s0 * rc - bflo(raw[k + 8]), s1 * rc - bfhi(raw[k + 8]));
        s0 += bflo(raw[k + 8 + HALF]) - bflo(raw[k + 8 - HALF]); s1 += bfhi(raw[k + 8 + HALF]) - bfhi(raw[k + 8 - HALF]); }
}
DI void pool_job(const Params& P, LAS unsigned char* lds, int l, int job, int tid, int lane, int wave) {
    const int tile = job >> 2, g = job & 3;
    const int tok0 = tile * 256; int t0, L; if (tile < 32) { t0 = 0; L = 256; } else { t0 = (tok0 - NPT) & 2047; L = 2048; }
    const bf16* plu = (const bf16*)(P.ws + WS_PLU); bf16* plz = (bf16*)(P.ws + WS_PLZ);
    LAS bf16* Mt = (LAS bf16*)lds; LAS bf16* PW = (LAS bf16*)(lds + 69632);
    { const bf16* src = (const bf16*)(P.ws + WS_POOLT) + (size_t)g * 16384;
      v4u t[4];
#pragma unroll
      for (int i = 0; i < 4; ++i) { const int q = tid + 512 * i; t[i] = *(const v4u*)(src + (q >> 4) * 128 + (q & 15) * 8); }
#pragma unroll
      for (int i = 0; i < 4; ++i) { const int q = tid + 512 * i; *(LAS v4u*)(PW + (q >> 4) * 136 + (q & 15) * 8) = t[i]; } }
    { const int cp = tid & 63, seg = tid >> 6; const bf16* col2 = plu + (size_t)(tok0 - t0) * 512 + g * 128 + 2 * cp;
      const int ts = t0 + seg * 32;
      if (g == 0) pool_means<1>(col2, ts, t0, L, Mt, cp); else if (g == 1) pool_means<2>(col2, ts, t0, L, Mt, cp); else if (g == 2) pool_means<4>(col2, ts, t0, L, Mt, cp); else pool_means<8>(col2, ts, t0, L, Mt, cp); }
    __syncthreads();
    const int r = lane & 31, hh = lane >> 5;
    f32x16 acc[4];
#pragma unroll
    for (int mb = 0; mb < 4; ++mb)
#pragma unroll
        for (int i = 0; i < 16; ++i) acc[mb][i] = 0.f;
#pragma unroll
    for (int ks = 0; ks < 8; ++ks) { const bf16x8 bfr = *(const LAS bf16x8*)(Mt + (32 * wave + r) * 136 + 16 * ks + 8 * hh);
#pragma unroll
        for (int mb = 0; mb < 4; ++mb) { const bf16x8 af = *(const LAS bf16x8*)(PW + (32 * mb + r) * 136 + 16 * ks + 8 * hh); acc[mb] = MFMA32(af, bfr, acc[mb]); } }
#pragma unroll
    for (int mb = 0; mb < 4; ++mb)
#pragma unroll
        for (int rg = 0; rg < 4; ++rg) { v2u w; w.x = pk2(acc[mb][4 * rg], acc[mb][4 * rg + 1]); w.y = pk2(acc[mb][4 * rg + 2], acc[mb][4 * rg + 3]);
            *(LAS v2u*)(Mt + (32 * wave + r) * 136 + 32 * mb + 8 * rg + 4 * hh) = w; }
    __syncthreads();
    { const float* psc = P.in[25] + l * 512 + g * 128; const int ch8 = (tid & 15) * 8; const f32x4 sc0 = *(const f32x4*)(psc + ch8), sc1 = *(const f32x4*)(psc + ch8 + 4);
      bf16* gp = plz + (size_t)tok0 * 512 + g * 128 + ch8; v4u zz[8];
#pragma unroll
      for (int i = 0; i < 8; ++i) { const int row = (tid >> 4) + 32 * i; zz[i] = *(const v4u*)(gp + (size_t)row * 512); }
#pragma unroll
      for (int i = 0; i < 8; ++i) { const int row = (tid >> 4) + 32 * i; const v4u d = *(const LAS v4u*)(Mt + row * 136 + ch8); const v4u z = zz[i];
          v4u o; o.x = pk2(bflo(d.x) * sc0[0] * bflo(z.x), bfhi(d.x) * sc0[1] * bfhi(z.x)); o.y = pk2(bflo(d.y) * sc0[2] * bflo(z.y), bfhi(d.y) * sc0[3] * bfhi(z.y));
          o.z = pk2(bflo(d.z) * sc1[0] * bflo(z.z), bfhi(d.z) * sc1[1] * bfhi(z.z)); o.w = pk2(bflo(d.w) * sc1[2] * bflo(z.w), bfhi(d.w) * sc1[3] * bfhi(z.w));
          *(v4u*)(gp + (size_t)row * 512) = o; } }
    __syncthreads();
}

#ifndef GALIGN
#define GALIGN true
#endif
#ifndef GSP2
#define GSP2 true
#endif
#ifndef PROBE_MASK
#define PROBE_MASK 0
#define PROBE_JOB 0
#endif
#define GSYNC() do { if (nts == 1 && P.ws == nullptr) grid.sync();   { XcdBarrier xb_; xb_.bar = (unsigned*)(P.ws + WS_BAR); xb_.x = xb_xcc_id(); xb_.st = (volatile LAS unsigned*)(lds + LDS_BYTES - 64); xcd_barrier(xb_); } if (PROBE_MASK != 0 && blockIdx.x == 0 && threadIdx.x == 0) { ((unsigned long long*)(P.ws + 8192))[nts] = __builtin_amdgcn_s_memrealtime(); } ++nts; } while (0)
__global__ void __launch_bounds__(512, 2) mk_fwd(Params P) {
    extern __shared__ __attribute__((aligned(16))) unsigned char lds_raw[];
    LAS unsigned char* lds = (LAS unsigned char*)lds_raw;
    cg::grid_group grid = cg::this_grid();
#define TLW() int tid_l = threadIdx.x; asm volatile("" : "+v"(tid_l)); const int tid = tid_l, lane = tid & 63, wave = __builtin_amdgcn_readfirstlane(tid >> 6); (void)lane; (void)wave
    const int G = gridDim.x, bid = blockIdx.x;
    unsigned char* ws = P.ws; int nts = 1; unsigned long long jtot = 0;
    volatile LAS unsigned* xst = (volatile LAS unsigned*)(lds + LDS_BYTES - 64);
    if (threadIdx.x < 16) xst[threadIdx.x] = 0u;
    __syncthreads();
    (void)xcd_barrier_post((unsigned*)(P.ws + WS_BAR), xst);
    if (PROBE_MASK != 0 && blockIdx.x == 0 && threadIdx.x == 0) ((unsigned long long*)(P.ws + 8192))[0] = __builtin_amdgcn_s_memrealtime();
#ifndef NO_PA
    { TLW(); phase_a(P, lds, tid, bid, G); }
#endif
    GSYNC();
#pragma unroll 1
    for (int l = 0; l < 2; ++l) {
        const float* xP = l == 0 ? P.in[0] : P.out; const float* xS = l == 0 ? P.in[1] : P.out + (size_t)NPT * 1024;
#ifndef NO_P0
        { TLW(); phase_p0(P, lds, l, xP, xS, tid, lane, wave, bid, G); }
#endif
        GSYNC();
        {
            { pg8::Gemm g{(const pg8::bf16_t*)(ws + WS_WINT), (const pg8::bf16_t*)(ws + WS_H), 2048, NTOK, 1024}; pg8::StaticOrder S; S.init(2048, NTOK, G, bid);
              EpiHyT E{(bf16*)(ws + WS_HYT)};
#ifndef NO_G1
              pg8::gemm_phase<EpiHyT, pg8::StaticOrder, GALIGN, GSP2>(lds, g, S, E);
#endif
 }
            { pg8::Gemm g{(const pg8::bf16_t*)(ws + WS_H), (const pg8::bf16_t*)(ws + WS_WINT) + (size_t)2048 * 1024, NTOK, 3072, 1024}; pg8::StaticOrder S; S.init(NTOK, 3072, G, bid);
              EpiB E{l, P.in[19] + l * 64, P.in[20] + l * 64, (const float*)(ws + WS_ROPE), (const float*)(ws + WS_ROPE) + 2048 * 32, ws, P.out + (size_t)2 * NPT * 1024, P.out + (size_t)3 * NPT * 1024};
#ifndef NO_G2
              pg8::gemm_phase<EpiB, pg8::StaticOrder, GALIGN, GSP2>(lds, g, S, E);
#endif
 }
        }
        GSYNC();
        {
            for (int j = bid; j < 1792; j += G) { TLW();
                const int jtype = j < 256 ? 1 : j < 768 ? 2 : j < 1280 ? 3 : j < 1536 ? 4 : 5; unsigned long long jt0 = 0; if (PROBE_JOB == jtype) jt0 = __builtin_amdgcn_s_memrealtime();
#ifndef NO_MIX
                if (j < 256) attn_job(P, lds, l, 1, j, tid, lane, wave);
                else if (j < 768) hyena_job(P, lds, l, 1, j - 256, tid, lane, wave);
                else if (j < 1280) hyena_job(P, lds, l, 0, j - 768, tid, lane, wave);
                else if (j < 1536) attn_job(P, lds, l, 0, j - 1280, tid, lane, wave);
                else pool_job(P, lds, l, j - 1536, tid, lane, wave);
#endif
                if (PROBE_JOB == jtype) jtot += __builtin_amdgcn_s_memrealtime() - jt0;
            }
        }
        GSYNC();
        { TLW(); yhy_transpose(P, lds, lane, wave, bid, G); }
        GSYNC();
        { pg8::Gemm g{(const pg8::bf16_t*)(ws + WS_YHY), (const pg8::bf16_t*)(ws + WS_WOT), 3 * NTOK, 3072, 512}; BrOrder S{G, bid};
          EpiBr E{(bf16*)(ws + WS_BBUF)};
#ifndef NO_G3
 pg8::gemm_phase<EpiBr, BrOrder, GALIGN, GSP2>(lds, g, S, E);
#endif
 }
        GSYNC();
        { pg8::Gemm g{(const pg8::bf16_t*)(ws + WS_H), (const pg8::bf16_t*)(ws + WS_WINT) + (size_t)5120 * 1024, NTOK, 3072, 1024}; pg8::StaticOrder S; S.init(NTOK, 3072, G, bid);
          EpiGate E{(bf16*)(ws + WS_BBUF)};
#ifndef NO_G4
 pg8::gemm_phase<EpiGate, pg8::StaticOrder, GALIGN, GSP2>(lds, g, S, E);
#endif
 }
        GSYNC();
        { TLW(); merge_sum(P, tid, bid, G); }
        GSYNC();
        { pg8::Gemm g{(const pg8::bf16_t*)(ws + WS_YHY), (const pg8::bf16_t*)(ws + WS_WOUT3), NTOK, 1024, 1024}; pg8::StaticOrder S; S.init(NTOK, 1024, G, bid);
          EpiOut E{xP, xS, P.out, (const float*)(ws + WS_MOD) + l * 5 * 3072}; pg8::gemm_phase<EpiOut, pg8::StaticOrder, GALIGN, GSP2>(lds, g, S, E); }
        if (l == 0 || PROBE_MASK != 0) GSYNC();
    }
    if (PROBE_MASK != 0 && blockIdx.x == 0 && threadIdx.x == 0) {
        const unsigned long long* ts = (const unsigned long long*)(P.ws + 8192); unsigned long long tot = 0;
        for (int i = 0; i < 15; ++i) if ((PROBE_MASK >> i) & 1) tot += ts[i + 1] - ts[i];
        if (PROBE_JOB != 0) tot = jtot;
        P.out[0] += (float)tot * (1e-5f * 4.0f);
    }
}

extern "C" void kernel_launch(void* const* d_in, const int* in_sizes, int n_in, void* d_out, int out_size, void* d_ws, size_t ws_size, hipStream_t stream) {
    static int grid = 0;
    if (grid == 0) {
        if (n_in != 30 || ws_size < WS_END) { fprintf(stderr, "kernel_launch: unexpected n_in %d / ws_size %zu\n", n_in, ws_size); grid = -1; return; }
        int dev = 0, cus = 0, per_cu = 0;
        hipGetDevice(&dev); hipDeviceGetAttribute(&cus, hipDeviceAttributeMultiprocessorCount, dev);
        if (hipFuncSetAttribute((const void*)mk_fwd, hipFuncAttributeMaxDynamicSharedMemorySize, LDS_BYTES) != hipSuccess) { fprintf(stderr, "kernel_launch: hipFuncSetAttribute failed\n"); grid = -1; return; }
        if (hipOccupancyMaxActiveBlocksPerMultiprocessor(&per_cu, (const void*)mk_fwd, 512, LDS_BYTES) != hipSuccess || per_cu < 1) { fprintf(stderr, "kernel_launch: occupancy query says %d\n", per_cu); per_cu = 1; }
        (void)hipGetLastError();
        grid = cus * per_cu;
    }
    if (grid < 0) return;
    if (hipMemsetAsync((char*)d_ws + WS_BAR, 0, 16384, stream) != hipSuccess) { fprintf(stderr, "kernel_launch: hipMemsetAsync failed\n"); return; }
    Params p{};
    for (int i = 0; i < 30; ++i) p.in[i] = (const float*)d_in[i];
    p.out = (float*)d_out; p.ws = (unsigned char*)d_ws;
    void* args[] = {&p};
    hipError_t e = hipLaunchCooperativeKernel((const void*)mk_fwd, dim3(grid), dim3(512), args, LDS_BYTES, stream);
    if (e != hipSuccess) fprintf(stderr, "cooperative launch failed: %s (grid %d)\n", hipGetErrorString(e), grid);
}
```

```cpp
#include <hip/hip_runtime.h>
#include <hip/hip_cooperative_groups.h>
#include <cstdio>
#include <cstdint>
namespace cg = cooperative_groups;
namespace pg8 {
#define PG8_LAS __attribute__((address_space(3)))
typedef unsigned short bf16_t;
typedef short bf16x8 __attribute__((ext_vector_type(8)));
typedef float f32x4 __attribute__((ext_vector_type(4)));
typedef unsigned u32x4 __attribute__((ext_vector_type(4)));
constexpr int BM = 256, BK = 64, HALF = 128, HTB = HALF * BK * 2  , STAGE_BYTES = 8 * HTB, NXCD = 8, WGM = 8;

__host__ __device__ __forceinline__ int lds_byte(int r, int c) { const int st = (r >> 4) * 2 + (c >> 5), rr = r & 15, cc = c & 31, ob = rr * 64 + cc * 2; return st * 1024 + (ob ^ (((ob >> 9) & 1) << 5)); }
__host__ __device__ __forceinline__ void stage_rc(int b, int& R, int& C) { const int st = b / 1024, sb = b % 1024, swz = sb ^ (((sb >> 9) & 1) << 5); R = (st >> 1) * 16 + swz / 64; C = (st & 1) * 32 + (swz % 64) / 2; }
__host__ __device__ __forceinline__ int perm32(int rho) { const int n = rho >> 4, i = rho & 15; return 8 * (i >> 2) + 4 * n + (i & 3); }

struct Unit { int pm, pn; };
struct Gemm { const bf16_t* A; const bf16_t* Bt; int M, N, K; };

struct StaticOrder {
    int nM, nN, nwg, G, c;
    __host__ __device__ void init(int M, int N, int G_, int c_) { nM = M / BM; nN = N / BM; nwg = nM * nN; G = G_; c = c_; }
    __host__ __device__ bool next(int i, Unit& u) const {
        const long L = (long)i * G + c; if (L >= nwg) return false;
        int wgid = (int)L; { const int q = nwg / NXCD, r = nwg % NXCD, xcd = wgid % NXCD, off = wgid / NXCD; wgid = (xcd < r ? xcd * (q + 1) : r * (q + 1) + (xcd - r) * q) + off; }
        const int nig = WGM * nN, gid = wgid / nig, fm = gid * WGM, gsz = (nM - fm) < WGM ? (nM - fm) : WGM;
        u.pm = fm + ((wgid % nig) % gsz); u.pn = (wgid % nig) / gsz; return true;
    }
    __device__ __forceinline__ void a_ready(const Unit&) const {}
    __device__ __forceinline__ void done(const Unit&) const {}
};

__device__ __forceinline__ unsigned cvt_pk_bf16(float lo, float hi) { unsigned r; asm volatile("v_cvt_pk_bf16_f32 %0, %1, %2" : "=v"(r) : "v"(lo), "v"(hi)); return r; }
typedef float f32x2 __attribute__((ext_vector_type(2)));
template <class Epi, class Sched, bool ALIGN_EPI = false, bool SP2 = false>
__device__ __forceinline__ void gemm_phase(PG8_LAS unsigned char* lds, const Gemm g, const Sched& S, const Epi& E) {
    int tid_l = threadIdx.x; asm volatile("" : "+v"(tid_l)); const int tid = tid_l, wid = __builtin_amdgcn_readfirstlane(tid >> 6), lane = tid & 63, wr = wid >> 2, wc = wid & 3, fr = lane & 15, fq = lane >> 4;
    const int K = g.K, nt = K / BK;
    unsigned voffA[2], voffB[2];
#pragma unroll
    for (int i = 0; i < 2; ++i) { int R, C; stage_rc(tid * 16 + i * 8192, R, C); const int Rb = Epi::PERM ? ((R & ~31) + perm32(R & 31)) : R;
        voffA[i] = (unsigned)(R * K + C) * 2u; voffB[i] = (unsigned)(Rb * K + C) * 2u; }
    const size_t kstep = (size_t)(BK * 2);
    const size_t hstep = (size_t)HALF * K * 2;
    const size_t tstep = 2 * hstep;
    const unsigned ldsw = (unsigned)wid * 1024u;
    const int aoff = lds_byte(wr * 64 + fr, fq * 8), boff = lds_byte(wc * 32 + fr, fq * 8);
#define PG8_SA(b, h) (((b) * 2 + (h)) * HTB)
#define PG8_SB(b, h) ((4 + (b) * 2 + (h)) * HTB)
#define PG8_STAGE(bufoff, gbase, voff) do { _Pragma("unroll") for (int _i = 0; _i < 2; ++_i) \
        __builtin_amdgcn_global_load_lds((const unsigned*)((const char*)(gbase) + (voff)[_i]), (PG8_LAS unsigned*)(lds + (bufoff) + ldsw + _i * 8192), 16, 0, 0); } while (0)
#define PG8_LDA(dst, b, h) do { _Pragma("unroll") for (int m = 0; m < 4; ++m) _Pragma("unroll") for (int k = 0; k < 2; ++k) dst[m][k] = *(const PG8_LAS bf16x8*)(lds + PG8_SA(b, h) + aoff + m * 2048 + k * 1024); } while (0)
#define PG8_LDB(dst, b, h) do { _Pragma("unroll") for (int n = 0; n < 2; ++n) _Pragma("unroll") for (int k = 0; k < 2; ++k) dst[n][k] = *(const PG8_LAS bf16x8*)(lds + PG8_SB(b, h) + boff + n * 2048 + k * 1024); } while (0)
#define PG8_MMA(ai, bj, At, Bt) do { __builtin_amdgcn_s_setprio(1); _Pragma("unroll") for (int m = 0; m < 4; ++m) _Pragma("unroll") for (int n = 0; n < 2; ++n) _Pragma("unroll") for (int k = 0; k < 2; ++k) \
        acc[ai][bj][m][n] = __builtin_amdgcn_mfma_f32_16x16x32_bf16(Bt[n][k], At[m][k], acc[ai][bj][m][n], 0, 0, 0); __builtin_amdgcn_s_setprio(0); } while (0)
#define PG8_WAIT_V(n) asm volatile("s_waitcnt vmcnt(" #n ")" ::: "memory")
#define PG8_WAIT_L(n) asm volatile("s_waitcnt lgkmcnt(" #n ")" ::: "memory")
#define PG8_BAR __builtin_amdgcn_s_barrier()
#define PG8_SCHED __builtin_amdgcn_sched_barrier(0)
    Unit cur, nxt; int ui = 0;
    if (!S.next(0, cur)) return;
    f32x4 acc[2][2][4][2];
#pragma unroll
    for (int a = 0; a < 2; ++a)
#pragma unroll
        for (int b = 0; b < 2; ++b)
#pragma unroll
            for (int m = 0; m < 4; ++m)
#pragma unroll
                for (int n = 0; n < 2; ++n) acc[a][b][m][n] = (f32x4){0.f, 0.f, 0.f, 0.f};
    bf16x8 At[4][2], B0[2][2], B1[2][2];
    const char* cA = (const char*)g.A + (size_t)cur.pm * tstep; const char* cB = (const char*)g.Bt + (size_t)cur.pn * tstep;
    S.a_ready(cur);
    if constexpr (SP2) {
        PG8_STAGE(PG8_SB(0, 0), cB, voffB); PG8_STAGE(PG8_SB(0, 1), cB + hstep, voffB); PG8_STAGE(PG8_SA(0, 0), cA, voffA); PG8_STAGE(PG8_SA(0, 1), cA + hstep, voffA);
        if (wr == 1) PG8_BAR;
        PG8_WAIT_V(2); PG8_BAR;
        PG8_STAGE(PG8_SB(1, 0), cB + kstep, voffB); PG8_STAGE(PG8_SA(1, 0), cA + kstep, voffA); PG8_STAGE(PG8_SB(1, 1), cB + hstep + kstep, voffB);
        PG8_WAIT_V(6); PG8_BAR;
    } else {
        PG8_STAGE(PG8_SB(0, 0), cB, voffB); PG8_STAGE(PG8_SA(0, 0), cA, voffA); PG8_STAGE(PG8_SB(0, 1), cB + hstep, voffB); PG8_STAGE(PG8_SA(0, 1), cA + hstep, voffA);
        if (wr == 1) PG8_BAR;
        PG8_WAIT_V(4); PG8_BAR;
        PG8_STAGE(PG8_SB(1, 0), cB + kstep, voffB); PG8_STAGE(PG8_SA(1, 0), cA + kstep, voffA); PG8_STAGE(PG8_SB(1, 1), cB + hstep + kstep, voffB);
        PG8_WAIT_V(6); PG8_BAR;
    }
    for (;;) {
        const bool has_next = S.next(ui + 1, nxt);
        const char* nA = has_next ? (const char*)g.A + (size_t)nxt.pm * tstep : cA; const char* nB = has_next ? (const char*)g.Bt + (size_t)nxt.pn * tstep : cB;
        for (int t = 0; t < nt; t += 2) {
            const bool last = (t == nt - 2);
            const char* a1 = cA + (size_t)(t + 1) * kstep;
            const char* a2 = last ? nA : cA + (size_t)(t + 2) * kstep; const char* b2 = last ? nB : cB + (size_t)(t + 2) * kstep;
            const char* a3 = a2 + kstep; const char* b3 = b2 + kstep;
            if (last && has_next) S.a_ready(nxt);
            if constexpr (SP2) {
            PG8_LDB(B0, 0, 0); PG8_LDB(B1, 0, 1); PG8_SCHED; PG8_LDA(At, 0, 0); PG8_STAGE(PG8_SA(1, 1), a1 + hstep, voffA);
            PG8_WAIT_V(8); PG8_WAIT_L(0); PG8_BAR; PG8_MMA(0, 0, At, B0); PG8_MMA(0, 1, At, B1); PG8_BAR; PG8_SCHED;
            PG8_LDA(At, 0, 1); PG8_STAGE(PG8_SB(0, 0), b2, voffB); PG8_STAGE(PG8_SB(0, 1), b2 + hstep, voffB); PG8_STAGE(PG8_SA(0, 0), a2, voffA);
            PG8_WAIT_V(8); PG8_WAIT_L(0); PG8_BAR; PG8_MMA(1, 0, At, B0); PG8_MMA(1, 1, At, B1); PG8_BAR; PG8_SCHED;
            PG8_LDB(B0, 1, 0); PG8_LDB(B1, 1, 1); PG8_SCHED; PG8_LDA(At, 1, 0); PG8_STAGE(PG8_SA(0, 1), a2 + hstep, voffA);
            PG8_WAIT_V(8); PG8_WAIT_L(0); PG8_BAR; PG8_MMA(0, 0, At, B0); PG8_MMA(0, 1, At, B1); PG8_BAR; PG8_SCHED;
            PG8_LDA(At, 1, 1); PG8_STAGE(PG8_SB(1, 0), b3, voffB); PG8_STAGE(PG8_SB(1, 1), b3 + hstep, voffB); PG8_STAGE(PG8_SA(1, 0), a3, voffA);
            PG8_WAIT_V(8); PG8_WAIT_L(0); PG8_BAR; PG8_MMA(1, 0, At, B0); PG8_MMA(1, 1, At, B1); PG8_BAR; PG8_SCHED;
            } else {
            PG8_LDB(B0, 0, 0); PG8_SCHED; PG8_LDA(At, 0, 0); PG8_STAGE(PG8_SA(1, 1), a1 + hstep, voffA);
            PG8_WAIT_L(8); PG8_BAR; PG8_WAIT_L(0); PG8_MMA(0, 0, At, B0); PG8_BAR; PG8_SCHED;
            PG8_LDB(B1, 0, 1); PG8_STAGE(PG8_SB(0, 0), b2, voffB);
            PG8_BAR; PG8_WAIT_L(0); PG8_MMA(0, 1, At, B1); PG8_BAR;
            PG8_LDA(At, 0, 1); PG8_STAGE(PG8_SA(0, 0), a2, voffA);
            PG8_BAR; PG8_WAIT_L(0); PG8_MMA(1, 0, At, B0); PG8_BAR; PG8_SCHED;
            PG8_STAGE(PG8_SB(0, 1), b2 + hstep, voffB);
            PG8_WAIT_V(6); PG8_BAR; PG8_MMA(1, 1, At, B1); PG8_BAR;
            PG8_LDB(B0, 1, 0); PG8_SCHED; PG8_LDA(At, 1, 0); PG8_STAGE(PG8_SA(0, 1), a2 + hstep, voffA);
            PG8_WAIT_L(8); PG8_BAR; PG8_WAIT_L(0); PG8_MMA(0, 0, At, B0); PG8_BAR; PG8_SCHED;
            PG8_LDB(B1, 1, 1); PG8_STAGE(PG8_SB(1, 0), b3, voffB);
            PG8_BAR; PG8_WAIT_L(0); PG8_MMA(0, 1, At, B1); PG8_BAR;
            PG8_LDA(At, 1, 1); PG8_STAGE(PG8_SA(1, 0), a3, voffA);
            PG8_BAR; PG8_WAIT_L(0); PG8_MMA(1, 0, At, B0); PG8_BAR; PG8_SCHED;
            PG8_STAGE(PG8_SB(1, 1), b3 + hstep, voffB);
            PG8_WAIT_V(6); PG8_BAR; PG8_MMA(1, 1, At, B1); PG8_BAR;
            }
        }
        if constexpr (ALIGN_EPI) { if (wr == 0) PG8_BAR; }
        if constexpr (!Epi::AFTER_DRAIN) { E(acc, cur, wr, wc, fr, fq); S.done(cur); }
        if (!has_next) break;
#pragma unroll
        for (int a = 0; a < 2; ++a)
#pragma unroll
            for (int b = 0; b < 2; ++b)
#pragma unroll
                for (int m = 0; m < 4; ++m)
#pragma unroll
                    for (int n = 0; n < 2; ++n) acc[a][b][m][n] = (f32x4){0.f, 0.f, 0.f, 0.f};
        cur = nxt; cA = nA; cB = nB; ++ui;
        if constexpr (ALIGN_EPI) { if (wr == 1) PG8_BAR; }
    }
    PG8_WAIT_V(0);
    if constexpr (!ALIGN_EPI) { if (wr == 0) PG8_BAR; }
    PG8_BAR;
    if constexpr (Epi::AFTER_DRAIN) { E.fused(acc, cur, wr, wc, fr, fq, lds, wid, lane); S.done(cur); }
#undef PG8_SA
#undef PG8_SB
#undef PG8_STAGE
#undef PG8_LDA
#undef PG8_LDB
#undef PG8_MMA
#undef PG8_WAIT_V
#undef PG8_WAIT_L
#undef PG8_BAR
#undef PG8_SCHED
}
}

#define LAS __attribute__((address_space(3)))
typedef unsigned short bf16;
typedef unsigned v4u __attribute__((ext_vector_type(4)));
typedef unsigned v2u __attribute__((ext_vector_type(2)));
typedef float f32x4 __attribute__((ext_vector_type(4)));
typedef float f32x2 __attribute__((ext_vector_type(2)));
typedef float f32x16 __attribute__((ext_vector_type(16)));
typedef short bf16x8 __attribute__((ext_vector_type(8)));
#define DI __device__ __forceinline__
#define MFMA32(a, b, c) __builtin_amdgcn_mfma_f32_32x32x16_bf16((a), (b), (c), 0, 0, 0)
#define MFMA16(a, b, c) __builtin_amdgcn_mfma_f32_16x16x32_bf16((a), (b), (c), 0, 0, 0)

constexpr int LDS_BYTES = 147456;
constexpr int NTOK = 16384, NPT = 8192, DM = 1024, DIN = 8192;
constexpr size_t MiB = 1u << 20;
constexpr size_t WS_BAR = 65536;
constexpr size_t WS_LAM = 4096;
constexpr size_t WS_MOD = 1 * MiB;
constexpr size_t WS_ROPE = 1 * MiB + 256 * 1024;
constexpr size_t WS_POOLT = 1 * MiB + 768 * 1024;
constexpr size_t WS_WINT = 2 * MiB;
constexpr size_t WS_WOT = 18 * MiB;
constexpr size_t WS_WOUT3 = 21 * MiB;
constexpr size_t WS_HRAW = 27 * MiB;
constexpr size_t WS_H = 36 * MiB;
constexpr size_t WS_YHY = 68 * MiB;
constexpr size_t WS_ATZ = 84 * MiB;
constexpr size_t WS_PLZ = 100 * MiB;
constexpr size_t WS_PLU = 116 * MiB;
constexpr size_t WS_HYT = 132 * MiB;
constexpr size_t WS_Q = 196 * MiB;
constexpr size_t WS_K = 212 * MiB;
constexpr size_t WS_VT = 230 * MiB;
constexpr size_t WS_BBUF = 132 * MiB;
constexpr size_t WS_END = 248 * MiB;

struct Params { const float* in[30]; float* out; unsigned char* ws; };

DI unsigned f2bf(float f) { unsigned u = __builtin_bit_cast(unsigned, f); return (u + 0x7fffu + ((u >> 16) & 1u)) >> 16; }
DI unsigned pk2(float lo, float hi) { return f2bf(lo) | (f2bf(hi) << 16); }
DI float bf2f(unsigned h) { return __builtin_bit_cast(float, h << 16); }
DI float bflo(unsigned w) { return __builtin_bit_cast(float, w << 16); }
DI float bfhi(unsigned w) { return __builtin_bit_cast(float, w & 0xffff0000u); }
DI float siluf(float x) { return x * __builtin_amdgcn_rcpf(1.f + __expf(-x)); }
DI float sigmf(float x) { return __builtin_amdgcn_rcpf(1.f + __expf(-x)); }
#define LDS_WAIT() asm volatile("s_waitcnt lgkmcnt(0)" ::: "memory")

#define XB_TMO      128
#define XB_XCNT(j)  (256  + 64 * (j))
#define XB_XSUB(j)  (1280 + 64 * (j))
#define XB_XGEN(j)  (2304 + 64 * (j))
#define XB_TOP      3328
#define XB_TOPGEN   3392
#define XCD_BAR_WORDS 3456
#define XB_SPIN_CAP (1u << 18)

__device__ __forceinline__ unsigned xb_ld(unsigned* p)              { return __hip_atomic_load(p, __ATOMIC_RELAXED, __HIP_MEMORY_SCOPE_AGENT); }
__device__ __forceinline__ unsigned xb_add(unsigned* p, unsigned v) { return __hip_atomic_fetch_add(p, v, __ATOMIC_RELAXED, __HIP_MEMORY_SCOPE_AGENT); }
__device__ __forceinline__ unsigned xb_xcc_id() { return (unsigned)__builtin_amdgcn_s_getreg((3 << 11) | 20) & 0xFu; }
#define XB_SPIN(cond, bar) do { unsigned _sp = 0; while (cond) { __builtin_amdgcn_s_sleep(1); \
    if ((++_sp & 255u) == 0u) { if (xb_ld(&(bar)[XB_TMO])) break; if (_sp > XB_SPIN_CAP) { atomicAdd(&(bar)[XB_TMO], 1u); break; } } } } while (0)

struct XcdBarrier {
    unsigned* bar; unsigned x;
    volatile LAS unsigned* st;
};

__device__ __forceinline__ XcdBarrier xcd_barrier_post(unsigned* bar, volatile LAS unsigned* st) {
    XcdBarrier b; b.bar = bar; b.x = xb_xcc_id(); b.st = st;
    if (threadIdx.x == 0) (void)xb_add(&bar[XB_XCNT(b.x)], 1u);
    return b;
}
__device__ __forceinline__ void xcd_barrier_complete(unsigned* bar, unsigned x, unsigned& nloc, unsigned& nx) {
    const unsigned G = gridDim.x * gridDim.y * gridDim.z;
    unsigned sum, cnt, mine, sp = 0u;
    for (;;) {
        sum = 0u; cnt = 0u; mine = 0u;
#pragma unroll
        for (unsigned j = 0; j < 16; ++j) { const unsigned c = xb_ld(&bar[XB_XCNT(j)]); sum += c; cnt += (c > 0u) ? 1u : 0u; mine = (j == x) ? c : mine; }
        if (sum == G) break;
        __builtin_amdgcn_s_sleep(1);
        if ((++sp & 255u) == 0u) { if (xb_ld(&bar[XB_TMO])) break; if (sp > XB_SPIN_CAP) { atomicAdd(&bar[XB_TMO], 1u); break; } }
    }
    nloc = mine > 0u ? mine : 1u; nx = cnt > 0u ? cnt : 1u;
}

__device__ __forceinline__ void xcd_barrier(const XcdBarrier& b) {
    asm volatile("s_waitcnt vmcnt(0)" ::: "memory");
    __syncthreads();
    if (threadIdx.x == 0) {
        unsigned* bar = b.bar;
        __builtin_amdgcn_s_waitcnt(0);
        unsigned nloc = b.st[0], nx = b.st[1];
        if (nloc == 0u) { xcd_barrier_complete(bar, b.x, nloc, nx); b.st[0] = nloc; b.st[1] = nx; }
        const unsigned old = xb_add(&bar[XB_XSUB(b.x)], 1u);
        const unsigned gen = old / nloc;
        if (old + 1u == (gen + 1u) * nloc) {
            __builtin_amdgcn_fence(__ATOMIC_RELEASE, "agent");
            asm volatile("s_waitcnt vmcnt(0)" ::: "memory");
            const unsigned og = xb_add(&bar[XB_TOP], 1u);
            const unsigned tg = og / nx;
            if (og + 1u == (tg + 1u) * nx) xb_add(&bar[XB_TOPGEN], 1u);
            else XB_SPIN(xb_ld(&bar[XB_TOPGEN]) == tg, bar);
            __builtin_amdgcn_fence(__ATOMIC_ACQUIRE, "agent");
            xb_add(&bar[XB_XGEN(b.x)], 1u);
            asm volatile("s_waitcnt vmcnt(0)" ::: "memory");
        } else {
            XB_SPIN(xb_ld(&bar[XB_XGEN(b.x)]) == gen, bar);
            __builtin_amdgcn_fence(__ATOMIC_ACQUIRE, "agent");
            asm volatile("s_waitcnt vmcnt(0)" ::: "memory");
        }
    }
    __syncthreads();
}

DI void tr_item(const float* src, size_t lds_, bf16* dst, size_t ldd, LAS float* scr, int lane) {
    float tv[32];
#pragma unroll
    for (int i = 0; i < 32; ++i) { const int kk = 2 * i + (lane >> 5); tv[i] = src[(size_t)kk * lds_ + (lane & 31)]; }
#pragma unroll
    for (int i = 0; i < 32; ++i) { const int kk = 2 * i + (lane >> 5); scr[kk * 33 + (lane & 31)] = tv[i]; }
    LDS_WAIT(); asm volatile("" ::: "memory");
    const int c = lane & 7;
#pragma unroll
    for (int j = 0; j < 4; ++j) { const int n = (lane >> 3) + 8 * j; const LAS float* s = scr + (8 * c) * 33 + n;
        v4u o; o.x = pk2(s[0 * 33], s[1 * 33]); o.y = pk2(s[2 * 33], s[3 * 33]); o.z = pk2(s[4 * 33], s[5 * 33]); o.w = pk2(s[6 * 33], s[7 * 33]);
        *(v4u*)(dst + (size_t)n * ldd + 8 * c) = o; }
    LDS_WAIT(); asm volatile("" ::: "memory");
}

DI void hraw_item(const Params& P, LAS unsigned char* lds, int l, int stream, int t0, int tid);
DI void phase_a(const Params& P, LAS unsigned char* lds, int tid, int bid, int G) {
    const float* c = P.in[4]; const float* cctx = P.in[5]; const float* w_ada = P.in[7]; const float* b_ada = P.in[8];
    float* mod = (float*)(P.ws + WS_MOD);
    LAS float* sc = (LAS float*)lds; LAS float* red = sc + 5 * 1024;
    for (int it = bid; it < 192; it += G) {
        const int l = it / 96, n0 = (it % 96) * 32;
        for (int idx = tid; idx < 5 * 1024; idx += 512) { const int r = idx >> 10, k = idx & 1023; const float cv = r == 0 ? cctx[k] : c[(r - 1) * 1024 + k]; sc[idx] = cv / (1.f + __expf(-cv)); }
        __syncthreads();
        const int cq = tid & 7, kg = tid >> 3; f32x4 acc[5]; f32x4 w[16];
#pragma unroll
        for (int r = 0; r < 5; ++r) acc[r] = (f32x4){0.f, 0.f, 0.f, 0.f};
#pragma unroll
        for (int kk = 0; kk < 16; ++kk) w[kk] = *(const f32x4*)(w_ada + ((size_t)l * 1024 + kg * 16 + kk) * 3072 + n0 + 4 * cq);
#pragma unroll
        for (int kk = 0; kk < 16; ++kk)
#pragma unroll
            for (int r = 0; r < 5; ++r) acc[r] += sc[r * 1024 + kg * 16 + kk] * w[kk];
#pragma unroll
        for (int r = 0; r < 5; ++r) *(LAS f32x4*)(red + (kg * 5 + r) * 32 + 4 * cq) = acc[r];
        __syncthreads();
        if (tid < 160) { const int r = tid >> 5, col = tid & 31; float s = b_ada[l * 3072 + n0 + col];
            for (int g = 0; g < 64; ++g) s += red[(g * 5 + r) * 32 + col];
            mod[(l * 5 + r) * 3072 + n0 + col] = s; }
        __syncthreads();
    }
    if (bid == 0 && tid < 2) {
        const int l = tid; const float* lq = P.in[21] + l * 128; const float* lk = P.in[22] + l * 128; float s0 = 0.f, s1 = 0.f;
        for (int i = 0; i < 64; ++i) { s0 += lq[i] * lk[i]; s1 += lq[64 + i] * lk[64 + i]; }
        const float lam_init = 0.8f - 0.6f * expf(-0.3f * (float)l);
        ((float*)(P.ws + WS_LAM))[l] = expf(s0) - expf(s1) + lam_init;
    }
}

DI void hraw_item(const Params& P, LAS unsigned char* lds, int l, int stream, int t0, int tid) {
    const int L = stream ? 2048 : 256;
    const float* w1 = P.in[12] + l * 33 * 64; const float* b1 = P.in[13] + l * 64; const float* w2 = P.in[14] + l * 64 * 64; const float* b2 = P.in[15] + l * 64;
    const float* w3 = P.in[16] + (size_t)l * 64 * 2048; const float* fq = P.in[17] + l * 128;
    bf16* out = (bf16*)(P.ws + WS_HRAW) + (stream ? 0 : (size_t)2 * 512 * 2 * 2048);
    LAS float* z = (LAS float*)lds; LAS float* h1 = z + 8 * 33 + 8; LAS float* h2 = h1 + 512; LAS float* w1s = h2 + 512; LAS float* w2s = w1s + 33 * 64;
    { const f32x4 a0 = *(const f32x4*)(w2 + 4 * tid), a1 = *(const f32x4*)(w2 + 2048 + 4 * tid);
      f32x4 b0 = (f32x4){0.f, 0.f, 0.f, 0.f}; const f32x4* w1v = (const f32x4*)w1; b0 = w1v[tid < 528 ? tid : 0]; f32x4 b1 = w1v[tid + 512 < 528 ? tid + 512 : 0];
      *(LAS f32x4*)(w2s + 4 * tid) = a0; *(LAS f32x4*)(w2s + 2048 + 4 * tid) = a1;
      *(LAS f32x4*)(w1s + 4 * tid) = b0; if (tid + 512 < 528) *(LAS f32x4*)(w1s + 4 * (tid + 512)) = b1; }
    if (tid < 8 * 33) { const int pos = tid / 33, j = tid % 33; const int t = t0 + pos; float v;
        if (j == 0) v = (float)t / (float)(L - 1);
        else { const int b = (j - 1) & 15; const float f = 1e-4f + (float)b * ((15.f - 1e-4f) / 15.f); const float w = 6.283185307179586f * (float)t / (float)L;
               v = (j <= 16) ? cosf(f * w) : -sinf(f * w); }
        z[pos * 33 + j] = v; }
    __syncthreads();
    { const int pos = tid >> 6, n = tid & 63; float a = b1[n];
#pragma unroll
      for (int j = 0; j < 33; ++j) a += z[pos * 33 + j] * w1s[j * 64 + n];
      h1[pos * 64 + n] = sinf(fq[n] * a); }
    __syncthreads();
    { const int pos = tid >> 6, n = tid & 63; float a = b2[n];
#pragma unroll 16
      for (int j = 0; j < 64; ++j) a += h1[pos * 64 + j] * w2s[j * 64 + n];
      h2[pos * 64 + n] = sinf(fq[64 + n] * a); }
    __syncthreads();
    { f32x4 acc[8];
#pragma unroll
      for (int p = 0; p < 8; ++p) acc[p] = (f32x4){0.f, 0.f, 0.f, 0.f};
#pragma unroll 1
      for (int k0 = 0; k0 < 64; k0 += 4) { f32x4 w[4];
#pragma unroll
          for (int kk = 0; kk < 4; ++kk) w[kk] = *(const f32x4*)(w3 + (size_t)(k0 + kk) * 2048 + 4 * tid);
#pragma unroll
          for (int p = 0; p < 8; ++p) { const f32x4 ha = *(const LAS f32x4*)(h2 + p * 64 + k0);
              acc[p] += ha[0] * w[0] + ha[1] * w[1] + ha[2] * w[2] + ha[3] * w[3]; } }
      const int n0 = 4 * tid, dir = n0 >> 10, o = (n0 >> 9) & 1;
#pragma unroll
      for (int e = 0; e < 4; ++e) { const int cc = (n0 & 511) + e; const float delta = 3.0701134573253944f + (float)cc * (12.280453829301578f / 511.f); float v[8];
#pragma unroll
          for (int p = 0; p < 8; ++p) { const float tn = (float)(t0 + p) / (float)(L - 1); v[p] = acc[p][e] * __expf(-tn * delta); }
          v4u w; w.x = pk2(v[0], v[1]); w.y = pk2(v[2], v[3]); w.z = pk2(v[4], v[5]); w.w = pk2(v[6], v[7]);
          *(v4u*)(out + ((size_t)((o * 512 + cc) * 2 + dir)) * L + t0) = w; } }
    __syncthreads();
}

DI void phase_p0(const Params& P, LAS unsigned char* lds, int l, const float* xsrcP, const float* xsrcS, int tid, int lane, int wave, int bid, int G) {
    const int gw = bid * 8 + wave, NGW = G * 8;
    LAS float* scr = (LAS float*)(lds + wave * 16384);
    bf16* WinT = (bf16*)(P.ws + WS_WINT); bf16* WoT = (bf16*)(P.ws + WS_WOT); bf16* Wout3 = (bf16*)(P.ws + WS_WOUT3); bf16* poolT = (bf16*)(P.ws + WS_POOLT);
    const float* w_in = P.in[9] + (size_t)l * 1024 * 8192;
    constexpr int I_IN = 16 * 256, I_O = 3 * 256, I_OUT = 512, I_PL = 32, I_CV = 512;
    constexpr int NIT = I_IN + I_O + I_OUT + I_PL + I_CV;
    for (int it = gw; it < NIT; it += NGW) {
        int r = it; const float* src; size_t sld; bf16* dst; size_t dld;
        if (r < I_IN) { const int kb = r >> 8, nb = r & 255, n0 = nb * 32; int drow = n0;
            if (n0 >= 2048 && n0 < 3072) { const int tb = n0 & ~255, lb = (n0 >> 5) & 7; drow = tb + 128 * (lb & 1) + 32 * (lb >> 1); }
            src = w_in + (size_t)(64 * kb) * 8192 + n0; sld = 8192; dst = WinT + (size_t)drow * 1024 + 64 * kb; dld = 1024; }
        else if ((r -= I_IN) < I_O) { const int j = r >> 8, q = r & 255, kb = q >> 5, nb = q & 31; const float* W = (j == 0 ? P.in[26] : j == 1 ? P.in[27] : P.in[28]) + (size_t)l * 512 * 1024;
            src = W + (size_t)(64 * kb) * 1024 + 32 * nb; sld = 1024; dst = WoT + (size_t)(j * 1024 + 32 * nb) * 512 + 64 * kb; dld = 512; }
        else if ((r -= I_O) < I_OUT) { const int kb = r >> 5, nb = r & 31; const float* W = P.in[29] + (size_t)l * 1024 * 1024;
            src = W + (size_t)(64 * kb) * 1024 + 32 * nb; sld = 1024; dst = Wout3 + (size_t)(32 * nb) * 1024 + 64 * kb; dld = 1024; }
        else if ((r -= I_OUT) < I_PL) { const int g = r >> 3, q = r & 7, kb = q >> 2, nb = q & 3; const float* W = P.in[24] + (size_t)(l * 4 + g) * 16384;
            src = W + (size_t)(64 * kb) * 128 + 32 * nb; sld = 128; dst = poolT + (size_t)g * 16384 + (size_t)(32 * nb) * 128 + 64 * kb; dld = 128; }
        else { r -= I_PL; const int b = r >> 7, q = r & 127, h = q >> 5, q2 = q & 31, kb = q2 >> 2, nb = q2 & 3;
            src = P.in[3] + ((size_t)(b * 2 + l) * 512 + 64 * kb) * 512 + h * 128 + 32 * nb; sld = 512;
            dst = (bf16*)(P.ws + WS_VT + 8 * MiB) + ((size_t)(b * 4 + h) * 128 + 32 * nb) * 2560 + 2048 + 64 * kb; dld = 2560; }
        tr_item(src, sld, dst, dld, scr, lane);
    }
    __syncthreads();
    { bf16* kS = (bf16*)(P.ws + WS_K + 8 * MiB);
      for (int idx = bid * 512 + tid; idx < 4 * 512 * 4 * 2 * 16; idx += G * 512) {
          const int d4 = idx & 15, map = (idx >> 4) & 1, h = (idx >> 5) & 3, p = (idx >> 7) & 511, b = idx >> 16;
          const f32x4 v = *(const f32x4*)(P.in[2] + ((((size_t)(b * 2 + l) * 512 + p) * 4 + h) * 2 + map) * 64 + d4 * 4);
          v2u w; w.x = pk2(v.x, v.y); w.y = pk2(v.z, v.w);
          *(v2u*)(kS + (((size_t)(b * 4 + h) * 2 + map) * 2560 + 2048 + p) * 64 + d4 * 4) = w; } }
    { const float* g = P.in[6] + l * 1024; const float* mod = (const float*)(P.ws + WS_MOD) + l * 5 * 3072; bf16* H = (bf16*)(P.ws + WS_H);
      f32x4 gg[4];
#pragma unroll
      for (int j = 0; j < 4; ++j) gg[j] = *(const f32x4*)(g + 4 * lane + 256 * j);
      const int HB = G >= 256 ? G - 32 : G; const int NGWH = HB * 8;
      if (bid < HB)
      for (int m0 = gw; m0 < NTOK; m0 += 2 * NGWH) {
          f32x4 v[2][4], sh[2][4], scl[2][4]; float s[2] = {0.f, 0.f};
#pragma unroll
          for (int u = 0; u < 2; ++u) { const int m = m0 + u * NGWH < NTOK ? m0 + u * NGWH : m0; const float* xr = m < NPT ? xsrcP + (size_t)m * 1024 : xsrcS + (size_t)(m - NPT) * 1024;
              const int r = m < NPT ? 0 : 1 + ((m - NPT) >> 11); const float* md = mod + r * 3072;
#pragma unroll
              for (int j = 0; j < 4; ++j) { const int c0 = 4 * lane + 256 * j; v[u][j] = *(const f32x4*)(xr + c0); sh[u][j] = *(const f32x4*)(md + c0); scl[u][j] = *(const f32x4*)(md + 1024 + c0); } }
#pragma unroll
          for (int u = 0; u < 2; ++u) { const int m = m0 + u * NGWH; if (m < NTOK) {
#pragma unroll
              for (int j = 0; j < 4; ++j) s[u] += (v[u][j].x * v[u][j].x + v[u][j].y * v[u][j].y) + (v[u][j].z * v[u][j].z + v[u][j].w * v[u][j].w);
#pragma unroll
              for (int o = 1; o < 64; o <<= 1) s[u] += __shfl_xor(s[u], o);
              const float rstd = rsqrtf(s[u] * (1.f / 1024.f) + 1e-6f);
#pragma unroll
              for (int j = 0; j < 4; ++j) { const int c0 = 4 * lane + 256 * j;
                  const f32x4 o = v[u][j] * rstd * gg[j] * (scl[u][j] + 1.f) + sh[u][j]; v2u w; w.x = pk2(o.x, o.y); w.y = pk2(o.z, o.w);
                  *(v2u*)(H + (size_t)m * 1024 + c0) = w; } } }
      } }
    for (int n = 0; ; ++n) {
        int item;
        if (G >= 256) { if (n >= 2) break; item = n == 0 ? (bid < 256 ? bid : -1) : (bid >= G - 32 ? 256 + bid - (G - 32) : -1); }
        else { item = bid + n * G; if (item >= 288) break; }
        if (item < 0) continue;
        const int stream = item < 256 ? 1 : 0; const int t0 = (stream ? item : item - 256) * 8; hraw_item(P, lds, l, stream, t0, tid);
    }
}

using pg8::Unit; using pg8::cvt_pk_bf16;
DI v4u pack8(f32x4 a, f32x4 b) { v4u w; w.x = cvt_pk_bf16(a[0], a[1]); w.y = cvt_pk_bf16(a[2], a[3]); w.z = cvt_pk_bf16(b[0], b[1]); w.w = cvt_pk_bf16(b[2], b[3]); return w; }
DI f32x4 silu4(f32x4 v) { return (f32x4){siluf(v[0]), siluf(v[1]), siluf(v[2]), siluf(v[3])}; }

struct EpiHyT {
    static constexpr bool PERM = true, AFTER_DRAIN = false; bf16* O;
    DI void operator()(const f32x4 (&acc)[2][2][4][2], const Unit& u, int wr, int wc, int fr, int fq) const {
        const bool act = u.pm >= 6; const int row0 = u.pm * 256 + wr * 64 + fr, col0 = u.pn * 256 + wc * 32 + 8 * fq;
#pragma unroll
        for (int ai = 0; ai < 2; ++ai)
#pragma unroll
            for (int m = 0; m < 4; ++m) { bf16* rowp = O + (size_t)(row0 + ai * 128 + m * 16) * NTOK + col0;
#pragma unroll
                for (int bj = 0; bj < 2; ++bj) { f32x4 v0 = acc[ai][bj][m][0], v1 = acc[ai][bj][m][1]; if (act) { v0 = silu4(v0); v1 = silu4(v1); }
                    *(v4u*)(rowp + bj * 128) = pack8(v0, v1); } }
    }
};

struct EpiB {
    static constexpr bool PERM = true, AFTER_DRAIN = false;
    int l; const float *gq, *gk, *ropec, *ropes; unsigned char* ws; float* newk; float* newv;
    DI void operator()(const f32x4 (&acc)[2][2][4][2], const Unit& u, int wr, int wc, int fr, int fq) const {
        const int pn = u.pn; const bool isS = u.pm >= 32;
        const int tok0 = u.pm * 256 + wr * 64 + fr;
        if (pn < 4) {
            const bool isk = pn >= 2; const int hd = 2 * (pn & 1) + (wc >> 1), map = wc & 1; const float* g = isk ? gk : gq;
            f32x4 gv[2][2];
#pragma unroll
            for (int bj = 0; bj < 2; ++bj)
#pragma unroll
                for (int n = 0; n < 2; ++n) gv[bj][n] = *(const f32x4*)(g + 32 * bj + 8 * fq + 4 * n);
            bf16* base = (bf16*)(ws + (isk ? WS_K : WS_Q) + (isS ? 8 * MiB : 0)); const int Lb = isS ? (isk ? 2560 : 2048) : 256;
            float invv[2][2];
#pragma unroll
            for (int n = 0; n < 2; ++n)
#pragma unroll
                for (int p = 0; p < 2; ++p) invv[n][p] = __expf(-(float)(4 * fq + 2 * n + p) * (9.210340371976184f / 16.f));
#pragma unroll
            for (int ai = 0; ai < 2; ++ai)
#pragma unroll
                for (int m = 0; m < 4; ++m) {
                    const int tok = tok0 + ai * 128 + m * 16; int b, t; if (isS) { const int tt = tok - NPT; b = tt >> 11; t = tt & 2047; } else { b = tok >> 8; t = tok & 255; }
                    float ss = 0.f; f32x4 v[2][2];
#pragma unroll
                    for (int bj = 0; bj < 2; ++bj)
#pragma unroll
                        for (int n = 0; n < 2; ++n) { const f32x4 x = acc[ai][bj][m][n]; ss += (x[0] * x[0] + x[1] * x[1]) + (x[2] * x[2] + x[3] * x[3]); }
                    ss += __shfl_xor(ss, 16); ss += __shfl_xor(ss, 32);
                    const float rstd = rsqrtf(ss * (1.f / 64.f) + 1e-6f);
#pragma unroll
                    for (int bj = 0; bj < 2; ++bj)
#pragma unroll
                        for (int n = 0; n < 2; ++n) v[bj][n] = acc[ai][bj][m][n] * rstd * gv[bj][n];
                    if (isk && !isS) { float* nk = newk + ((size_t)(b * 2 + l) * 256 + t) * 512 + hd * 128 + map * 64 + 8 * fq;
#pragma unroll
                        for (int bj = 0; bj < 2; ++bj)
#pragma unroll
                            for (int n = 0; n < 2; ++n) *(f32x4*)(nk + 32 * bj + 4 * n) = v[bj][n]; }
                    if (isS) {
                        int tl = t; asm volatile("" : "+v"(tl)); const float rowf = (float)(tl >> 6), colf = (float)(tl & 63);
#pragma unroll
                        for (int bj = 0; bj < 2; ++bj)
#pragma unroll
                            for (int n = 0; n < 2; ++n) { const float base = bj == 0 ? rowf : colf; const float a0 = base * invv[n][0], a1 = base * invv[n][1];
                                const float r0 = a0 * 0.15915494309189535f, r1 = a1 * 0.15915494309189535f; const float c0 = __builtin_amdgcn_cosf(r0), s0 = __builtin_amdgcn_sinf(r0), c1 = __builtin_amdgcn_cosf(r1), s1 = __builtin_amdgcn_sinf(r1);
                                const f32x4 x = v[bj][n]; v[bj][n] = (f32x4){x[0] * c0 - x[1] * s0, x[0] * s0 + x[1] * c0, x[2] * c1 - x[3] * s1, x[2] * s1 + x[3] * c1}; }
                    }
                    if (!isk) {
#pragma unroll
                        for (int bj = 0; bj < 2; ++bj)
#pragma unroll
                            for (int n = 0; n < 2; ++n) v[bj][n] = v[bj][n] * 0.18033688011112042f;
                    }
                    bf16* dp = base + ((size_t)((b * 4 + hd) * 2 + map) * Lb + t) * 64 + 8 * fq;
#pragma unroll
                    for (int bj = 0; bj < 2; ++bj) *(v4u*)(dp + 32 * bj) = pack8(v[bj][0], v[bj][1]);
                }
        } else if (pn < 6) {
            bf16* vt = (bf16*)(ws + WS_VT + (isS ? 8 * MiB : 0)); const int Lk = isS ? 2560 : 256;
#pragma unroll
            for (int ai = 0; ai < 2; ++ai)
#pragma unroll
                for (int m = 0; m < 4; ++m) {
                    const int tok = tok0 + ai * 128 + m * 16; int b, t; if (isS) { const int tt = tok - NPT; b = tt >> 11; t = tt & 2047; } else { b = tok >> 8; t = tok & 255; }
#pragma unroll
                    for (int bj = 0; bj < 2; ++bj) { const int hd = 2 * (pn - 4) + bj;
#pragma unroll
                        for (int n = 0; n < 2; ++n) { const int dv = 32 * wc + 8 * fq + 4 * n; const f32x4 x = acc[ai][bj][m][n];
                            if (!isS) *(f32x4*)(newv + ((size_t)(b * 2 + l) * 256 + t) * 512 + hd * 128 + dv) = x;
                            bf16* vp = vt + ((size_t)(b * 4 + hd) * 128 + dv) * Lk + t;
#pragma unroll
                            for (int e = 0; e < 4; ++e) vp[(size_t)e * Lk] = (bf16)f2bf(x[e]); } }
                }
        } else {
            const int which = (pn - 6) >> 1; bf16* dst = (bf16*)(ws + (which == 0 ? WS_ATZ : which == 1 ? WS_PLU : WS_PLZ)); const bool act = which != 1;
            const int col0 = 256 * ((pn - 6) & 1) + 32 * wc + 8 * fq;
#pragma unroll
            for (int ai = 0; ai < 2; ++ai)
#pragma unroll
                for (int m = 0; m < 4; ++m) { bf16* rowp = dst + (size_t)(tok0 + ai * 128 + m * 16) * 512 + col0;
#pragma unroll
                    for (int bj = 0; bj < 2; ++bj) { f32x4 v0 = acc[ai][bj][m][0], v1 = acc[ai][bj][m][1]; if (act) { v0 = silu4(v0); v1 = silu4(v1); }
                        *(v4u*)(rowp + bj * 128) = pack8(v0, v1); } }
        }
    }
};

struct BrOrder {
    int G, c;
    DI bool next(int i, Unit& u) const { const int L = i * G + c; if (L >= 768) return false; const int j = L >> 8, r0 = L & 255; const int r = (r0 & 7) * 32 + (r0 >> 3);
        u.pm = j * 64 + (r >> 2); u.pn = j * 4 + (r & 3); return true; }
    DI void a_ready(const Unit&) const {}
    DI void done(const Unit&) const {}
};
struct EpiBr {
    static constexpr bool PERM = true, AFTER_DRAIN = false; bf16* O;
    DI void operator()(const f32x4 (&acc)[2][2][4][2], const Unit& u, int wr, int wc, int fr, int fq) const {
        const int row0 = (u.pm & 63) * 256 + wr * 64 + fr, col0 = u.pn * 256 + wc * 32 + 8 * fq;
#pragma unroll
        for (int ai = 0; ai < 2; ++ai)
#pragma unroll
            for (int m = 0; m < 4; ++m) { bf16* rowp = O + (size_t)(row0 + ai * 128 + m * 16) * 3072 + col0;
#pragma unroll
                for (int bj = 0; bj < 2; ++bj) *(v4u*)(rowp + bj * 128) = pack8(acc[ai][bj][m][0], acc[ai][bj][m][1]); }
    }
};
struct EpiGate {
    static constexpr bool PERM = true, AFTER_DRAIN = false; const bf16* B; bf16* M;
    DI void operator()(const f32x4 (&acc)[2][2][4][2], const Unit& u, int wr, int wc, int fr, int fq) const {
        const int j = u.pn >> 2; const int row0 = u.pm * 256 + wr * 64 + fr, col0 = u.pn * 256 + wc * 32 + 8 * fq, mc0 = (u.pn & 3) * 256 + wc * 32 + 8 * fq;
        const bf16* bb = B + (size_t)row0 * 3072 + col0; bf16* mb = M + (size_t)row0 * 1024 + mc0;
#pragma unroll
        for (int ai = 0; ai < 2; ++ai) {
            v4u bv[4][2], mv[4][2];
#pragma unroll
            for (int m = 0; m < 4; ++m)
#pragma unroll
                for (int bj = 0; bj < 2; ++bj) { bv[m][bj] = *(const v4u*)(bb + (size_t)(ai * 128 + m * 16) * 3072 + bj * 128);
                    if (j > 0) { const unsigned long long* mq = (const unsigned long long*)(mb + (size_t)(ai * 128 + m * 16) * 1024 + bj * 128);
                        const unsigned long long q0 = __hip_atomic_load(mq, __ATOMIC_RELAXED, __HIP_MEMORY_SCOPE_AGENT), q1 = __hip_atomic_load(mq + 1, __ATOMIC_RELAXED, __HIP_MEMORY_SCOPE_AGENT);
                        mv[m][bj] = (v4u){(unsigned)q0, (unsigned)(q0 >> 32), (unsigned)q1, (unsigned)(q1 >> 32)}; }
                    else mv[m][bj] = (v4u){0u, 0u, 0u, 0u}; }
            asm volatile("s_waitcnt vmcnt(0)" ::: "memory");
#pragma unroll
            for (int m = 0; m < 4; ++m)
#pragma unroll
                for (int bj = 0; bj < 2; ++bj) { const v4u b = bv[m][bj], p = mv[m][bj]; const f32x4 g0 = acc[ai][bj][m][0], g1 = acc[ai][bj][m][1];
                    const f32x4 o0 = (f32x4){sigmf(g0[0]) * bflo(b.x) + bflo(p.x), sigmf(g0[1]) * bfhi(b.x) + bfhi(p.x), sigmf(g0[2]) * bflo(b.y) + bflo(p.y), sigmf(g0[3]) * bfhi(b.y) + bfhi(p.y)};
                    const f32x4 o1 = (f32x4){sigmf(g1[0]) * bflo(b.z) + bflo(p.z), sigmf(g1[1]) * bfhi(b.z) + bfhi(p.z), sigmf(g1[2]) * bflo(b.w) + bflo(p.w), sigmf(g1[3]) * bfhi(b.w) + bfhi(p.w)};
                    *(v4u*)(mb + (size_t)(ai * 128 + m * 16) * 1024 + bj * 128) = pack8(o0, o1); }
        }
    }
};
struct EpiOut {
    static constexpr bool PERM = true, AFTER_DRAIN = false; const float* xP; const float* xS; float* out; const float* mod;
    DI void operator()(const f32x4 (&acc)[2][2][4][2], const Unit& u, int wr, int wc, int fr, int fq) const {
        const int row0 = u.pm * 256 + wr * 64 + fr, col0 = u.pn * 256 + wc * 32 + 8 * fq;
        const int r = u.pm < 32 ? 0 : 1 + ((u.pm - 32) >> 3);
        const float* gt = mod + r * 3072 + 2048 + col0;
        f32x4 gv[2][2];
#pragma unroll
        for (int bj = 0; bj < 2; ++bj)
#pragma unroll
            for (int n = 0; n < 2; ++n) gv[bj][n] = *(const f32x4*)(gt + bj * 128 + 4 * n);
        const float* xb = (u.pm < 32 ? xP + (size_t)row0 * 1024 : xS + (size_t)(row0 - NPT) * 1024) + col0; float* ob = out + (size_t)row0 * 1024 + col0;
#pragma unroll
        for (int ai = 0; ai < 2; ++ai) {
            f32x4 xv[4][2][2];
#pragma unroll
            for (int m = 0; m < 4; ++m)
#pragma unroll
                for (int bj = 0; bj < 2; ++bj)
#pragma unroll
                    for (int n = 0; n < 2; ++n) xv[m][bj][n] = *(const f32x4*)(xb + (size_t)(ai * 128 + m * 16) * 1024 + bj * 128 + 4 * n);
            asm volatile("s_waitcnt vmcnt(0)" ::: "memory");
#pragma unroll
            for (int m = 0; m < 4; ++m)
#pragma unroll
                for (int bj = 0; bj < 2; ++bj)
#pragma unroll
                    for (int n = 0; n < 2; ++n) *(f32x4*)(ob + (size_t)(ai * 128 + m * 16) * 1024 + bj * 128 + 4 * n) = xv[m][bj][n] + gv[bj][n] * acc[ai][bj][m][n];
        }
    }
};

DI f32x4 conv4(const bf16* row, int s0, int t4, int L, float w0, float w1, float w2, float bias) {
    const bf16* p = row + s0 + t4; const v2u raw = *(const v2u*)p;
    const float x0 = bflo(raw.x), x1 = bfhi(raw.x), x2 = bflo(raw.y), x3 = bfhi(raw.y);
    const unsigned short rm = p[t4 > 0 ? -1 : 0], rp = p[(t4 + 4 < L) ? 4 : 3];
    const float xm = t4 > 0 ? bf2f(rm) : 0.f, xp = (t4 + 4 < L) ? bf2f(rp) : 0.f;
    return (f32x4){w0 * xm + w1 * x0 + w2 * x1 + bias, w0 * x0 + w1 * x1 + w2 * x2 + bias, w0 * x1 + w1 * x2 + w2 * x3 + bias, w0 * x2 + w1 * x3 + w2 * xp + bias};
}

#define LBAR() do { asm volatile("s_waitcnt lgkmcnt(0)" ::: "memory"); __builtin_amdgcn_s_barrier(); asm volatile("" ::: "memory"); } while (0)
struct Q4 { v2u raw; unsigned rm, rp; };
DI Q4 ld4(const bf16* row, int s0, int t4, int L) { const bf16* p = row + s0 + t4; Q4 q; q.raw = *(const v2u*)p; q.rm = p[t4 > 0 ? -1 : 0]; q.rp = p[(t4 + 4 < L) ? 4 : 3]; return q; }
DI f32x4 cv4(const Q4& q, int t4, int L, float w0, float w1, float w2, float bias) {
    const float x0 = bflo(q.raw.x), x1 = bfhi(q.raw.x), x2 = bflo(q.raw.y), x3 = bfhi(q.raw.y);
    const float xm = t4 > 0 ? bf2f(q.rm) : 0.f, xp = (t4 + 4 < L) ? bf2f(q.rp) : 0.f;
    return (f32x4){w0 * xm + w1 * x0 + w2 * x1 + bias, w0 * x0 + w1 * x1 + w2 * x2 + bias, w0 * x1 + w1 * x2 + w2 * x3 + bias, w0 * x2 + w1 * x3 + w2 * xp + bias};
}
DI void hyena_job(const Params& P, LAS unsigned char* lds, int l, int stream, int c, int tid, int lane, int wave) {
    const int L = stream ? 2048 : 256, Bn = stream ? 4 : 32, NB = L / 16, tokbase = stream ? NPT : 0;
    const int RCS = 2 * L + 16;
    const int RCB = 8 * RCS * 2, UN = Bn * (L + 256) + 256, UB = UN * 2;
    LAS bf16* RC = (LAS bf16*)lds; LAS bf16* U1 = (LAS bf16*)(lds + RCB); LAS bf16* U2 = (LAS bf16*)(lds + RCB + UB);
    LAS bf16* GR = (LAS bf16*)(lds + RCB + 2 * UB); LAS float* red = (LAS float*)(lds + RCB + 2 * UB + 8 * L);
    LAS bf16* GV = (LAS bf16*)(lds + RCB + 2 * UB + 8 * L + 64);
    const bf16* hyT = (const bf16*)(P.ws + WS_HYT);
    const bf16* rx1 = hyT + (size_t)c * NTOK; const bf16* rx2 = hyT + (size_t)(512 + c) * NTOK; const bf16* rv = hyT + (size_t)(1024 + c) * NTOK; const bf16* rz = hyT + (size_t)(1536 + c) * NTOK;
    const float* cw = P.in[10] + l * 3 * 1536; const float* cb = P.in[11] + l * 1536;
    const bf16* hraw = (const bf16*)(P.ws + WS_HRAW) + (stream ? 0 : (size_t)2 * 512 * 2 * 2048);
    const int a = lane & 15, g = lane >> 4, gb = g & 1, gh = g >> 1;
    const int kap = (16 - a) & 7, A8 = (a + 7) & ~7;
    const int i0 = stream ? 16 * wave : 0, b0 = stream ? 0 : 4 * wave;
    const int mlo = i0 - NB, nks = (NB + 16) / 2;
    const int t4o = 16 * (i0 + a) + 4 * g;
    v4u gr[2]; const int nvec = L / 2;
#pragma unroll
    for (int i = 0; i < 2; ++i) { const int idx = tid + 512 * i; const int e8 = (idx < nvec ? idx : 0) * 8; const int o = e8 / (2 * L), rem = e8 - o * 2 * L;
        gr[i] = *(const v4u*)(hraw + (size_t)((o * 512 + c) * 2) * L + rem); }
    Q4 qv[4], q1[4], q2[4]; v2u qz[4];
#pragma unroll
    for (int i = 0; i < 4; ++i) { const int q = tid + 512 * i; const int b = q / (L / 4), t4 = (q % (L / 4)) * 4; qv[i] = ld4(rv, tokbase + b * L, t4, L); }
#pragma unroll
    for (int b = 0; b < 4; ++b) { const int s0 = tokbase + (b0 + b) * L; q1[b] = ld4(rx1, s0, t4o, L); q2[b] = ld4(rx2, s0, t4o, L); qz[b] = *(const v2u*)(rz + s0 + t4o); }
    for (int i = tid; i < (2 * UB) / 16; i += 512) ((LAS v4u*)U1)[i] = (v4u){0u, 0u, 0u, 0u};
    LBAR();
#pragma unroll
    for (int i = 0; i < 2; ++i) { const int idx = tid + 512 * i; if (idx < nvec) *(LAS v4u*)(GR + idx * 8) = gr[i]; }
    { const float w0 = cw[1024 + c], w1 = cw[1536 + 1024 + c], w2 = cw[3072 + 1024 + c], bb = cb[1024 + c];
#pragma unroll
      for (int i = 0; i < 4; ++i) { const int q = tid + 512 * i; const int b = q / (L / 4), t4 = (q % (L / 4)) * 4; const f32x4 v = cv4(qv[i], t4, L, w0, w1, w2, bb);
          v2u w; w.x = pk2(v[0], v[1]); w.y = pk2(v[2], v[3]); *(LAS v2u*)(U1 + 256 + b * (L + 256) + t4) = w; } }
    LBAR();
    { const int per = (2 * L) / 512;
      float s0 = 0.f, s1 = 0.f;
      for (int k = 0; k < per; ++k) { const int e = tid + 512 * k; const float v0 = fabsf(bf2f(GR[e])), v1 = fabsf(bf2f(GR[2 * L + e])); const bool ok = e != L; s0 += ok ? v0 : 0.f; s1 += ok ? v1 : 0.f; }
#pragma unroll
      for (int of = 1; of < 64; of <<= 1) { s0 += __shfl_xor(s0, of); s1 += __shfl_xor(s1, of); }
      if (lane == 0) { red[wave * 2] = s0; red[wave * 2 + 1] = s1; } }
    LBAR();
    float inv[2];
#pragma unroll
    for (int o = 0; o < 2; ++o) { float sm = 0.f;
#pragma unroll
        for (int w = 0; w < 8; ++w) sm += red[w * 2 + o];
        inv[o] = 1.f / (sm + 1e-6f); }
#pragma unroll 1
    for (int o = 0; o < 2; ++o) {
        { const LAS bf16* G0 = GR + o * 2 * L; const float sc = inv[o];
          for (int x = tid; x < 2 * L + 32; x += 512) { const int d = L - x; const bool ok = d > -L && d < L; int idx = d >= 0 ? d : L - d; idx = idx < 0 ? 0 : (idx > 2 * L - 1 ? 2 * L - 1 : idx);
              const float v = bf2f(G0[idx]) * sc; GV[x] = (bf16)f2bf(ok ? v : 0.f); } }
        LBAR();
        for (int yq = tid; yq < RCS / 4; yq += 512) { const int y = 4 * yq; const LAS v2u* gp = (const LAS v2u*)(GV + y);
            const v2u a0 = gp[0], a1 = gp[1], a2 = gp[2]; const unsigned w[6] = {a0.x, a0.y, a1.x, a1.y, a2.x, a2.y};
#pragma unroll
            for (int k = 0; k < 8; ++k) { const int jd = k >> 1; v2u o2;
                if ((k & 1) == 0) { o2.x = w[jd]; o2.y = w[jd + 1]; }
                else { o2.x = __builtin_amdgcn_alignbit(w[jd + 1], w[jd], 16); o2.y = __builtin_amdgcn_alignbit(w[jd + 2], w[jd + 1], 16); }
                *(LAS v2u*)(RC + k * RCS + y) = o2; } }
        LBAR();
        LAS bf16* U = o == 0 ? U1 : U2;
        f32x4 acc[4];
#pragma unroll
        for (int b = 0; b < 4; ++b) acc[b] = (f32x4){0.f, 0.f, 0.f, 0.f};
        const LAS bf16* ap = RC + kap * RCS + L - 16 * (mlo + gh) - A8 + 8 * gb;
        const LAS bf16* bp = U + 256 + b0 * (L + 256) + 16 * (i0 + a - mlo - gh) + 8 * gb;
        bf16x8 af = *(const LAS bf16x8*)ap; bf16x8 bfr[4];
#pragma unroll
        for (int b = 0; b < 4; ++b) bfr[b] = *(const LAS bf16x8*)(bp + b * (L + 256));
#pragma unroll 4
        for (int ks = 0; ks < nks; ++ks) {
            const int kn = ks + 1 < nks ? ks + 1 : ks;
            const bf16x8 naf = *(const LAS bf16x8*)(ap - 32 * kn); bf16x8 nb[4];
#pragma unroll
            for (int b = 0; b < 4; ++b) nb[b] = *(const LAS bf16x8*)(bp - 32 * kn + b * (L + 256));
#pragma unroll
            for (int b = 0; b < 4; ++b) acc[b] = MFMA16(af, bfr[b], acc[b]);
            af = naf;
#pragma unroll
            for (int b = 0; b < 4; ++b) bfr[b] = nb[b];
        }
        const float bias = P.in[18][(l * 2 + o) * 512 + c];
        if (o == 0) {
            const float w0 = cw[c], w1 = cw[1536 + c], w2 = cw[3072 + c], bb = cb[c];
#pragma unroll
            for (int b = 0; b < 4; ++b) { const int bq = b0 + b; const f32x4 x1 = cv4(q1[b], t4o, L, w0, w1, w2, bb);
                const v2u uv = *(const LAS v2u*)(U1 + 256 + bq * (L + 256) + t4o);
                const f32x4 y = (f32x4){x1[0] * (acc[b][0] + bias * bflo(uv.x)), x1[1] * (acc[b][1] + bias * bfhi(uv.x)), x1[2] * (acc[b][2] + bias * bflo(uv.y)), x1[3] * (acc[b][3] + bias * bfhi(uv.y))};
                v2u w; w.x = pk2(y[0], y[1]); w.y = pk2(y[2], y[3]); *(LAS v2u*)(U2 + 256 + bq * (L + 256) + t4o) = w; }
        } else {
            const float w0 = cw[512 + c], w1 = cw[1536 + 512 + c], w2 = cw[3072 + 512 + c], bb = cb[512 + c];
            bf16* yh = (bf16*)(P.ws + WS_HYT) + (size_t)(1536 + c) * NTOK;
#pragma unroll
            for (int b = 0; b < 4; ++b) { const int bq = b0 + b; const int tok = tokbase + bq * L + t4o; const f32x4 x2 = cv4(q2[b], t4o, L, w0, w1, w2, bb);
                const v2u uv = *(const LAS v2u*)(U2 + 256 + bq * (L + 256) + t4o); const v2u zz = qz[b];
                const f32x4 y = (f32x4){x2[0] * (acc[b][0] + bias * bflo(uv.x)) * bflo(zz.x), x2[1] * (acc[b][1] + bias * bfhi(uv.x)) * bfhi(zz.x),
                                        x2[2] * (acc[b][2] + bias * bflo(uv.y)) * bflo(zz.y), x2[3] * (acc[b][3] + bias * bfhi(uv.y)) * bfhi(zz.y)};
                v2u w; w.x = pk2(y[0], y[1]); w.y = pk2(y[2], y[3]); *(v2u*)(yh + tok) = w; }
        }
        LBAR();
    }
    __syncthreads();
}

DI void yhy_transpose(const Params& P, LAS unsigned char* lds, int lane, int wave, int bid, int G) {
    const bf16* src0 = (const bf16*)(P.ws + WS_HYT) + (size_t)1536 * NTOK; bf16* dst0 = (bf16*)(P.ws + WS_YHY);
    LAS unsigned char* scr = lds + wave * 9216;
    for (int it = bid * 8 + wave; it < 2048; it += G * 8) {
        const int ch0 = (it >> 8) * 64, tok0 = (it & 255) * 64;
        v4u v[8];
#pragma unroll
        for (int i = 0; i < 8; ++i) { const int idx = lane + 64 * i, ch = idx >> 3, chunk = idx & 7; v[i] = *(const v4u*)(src0 + (size_t)(ch0 + ch) * NTOK + tok0 + chunk * 8); }
#pragma unroll
        for (int i = 0; i < 8; ++i) { const int idx = lane + 64 * i, ch = idx >> 3, chunk = idx & 7; *(LAS v4u*)(scr + ch * 144 + chunk * 16) = v[i]; }
        LDS_WAIT(); asm volatile("" ::: "memory");
#pragma unroll
        for (int i = 0; i < 8; ++i) { const int idx = lane + 64 * i, tok = idx >> 3, cc = idx & 7; const LAS bf16* p = (const LAS bf16*)(scr + (cc * 8) * 144) + tok;
            v4u o; o.x = (unsigned)p[0] | ((unsigned)p[72] << 16); o.y = (unsigned)p[144] | ((unsigned)p[216] << 16); o.z = (unsigned)p[288] | ((unsigned)p[360] << 16); o.w = (unsigned)p[432] | ((unsigned)p[504] << 16);
            *(v4u*)(dst0 + (size_t)(tok0 + tok) * 512 + ch0 + cc * 8) = o; }
        LDS_WAIT(); asm volatile("" ::: "memory");
    }
}

DI void merge_sum(const Params& P, int tid, int bid, int G) {
    const bf16* B = (const bf16*)(P.ws + WS_BBUF); bf16* M = (bf16*)(P.ws + WS_YHY);
    for (int idx0 = bid * 512 + tid; idx0 < NTOK * 128; idx0 += 4 * G * 512) {
        v4u a[4], b[4], c[4];
#pragma unroll
        for (int u = 0; u < 4; ++u) { const int idx = idx0 + u * G * 512 < NTOK * 128 ? idx0 + u * G * 512 : idx0; const int row = idx >> 7, c8 = (idx & 127) * 8; const bf16* p = B + (size_t)row * 3072 + c8;
            a[u] = *(const v4u*)p; b[u] = *(const v4u*)(p + 1024); c[u] = *(const v4u*)(p + 2048); }
#pragma unroll
        for (int u = 0; u < 4; ++u) { const int idx = idx0 + u * G * 512; if (idx < NTOK * 128) { const int row = idx >> 7, c8 = (idx & 127) * 8;
            const f32x4 lo = (f32x4){bflo(a[u].x) + bflo(b[u].x) + bflo(c[u].x), bfhi(a[u].x) + bfhi(b[u].x) + bfhi(c[u].x), bflo(a[u].y) + bflo(b[u].y) + bflo(c[u].y), bfhi(a[u].y) + bfhi(b[u].y) + bfhi(c[u].y)};
            const f32x4 hi = (f32x4){bflo(a[u].z) + bflo(b[u].z) + bflo(c[u].z), bfhi(a[u].z) + bfhi(b[u].z) + bfhi(c[u].z), bflo(a[u].w) + bflo(b[u].w) + bflo(c[u].w), bfhi(a[u].w) + bfhi(b[u].w) + bfhi(c[u].w)};
            v4u o; o.x = pk2(lo[0], lo[1]); o.y = pk2(lo[2], lo[3]); o.z = pk2(hi[0], hi[1]); o.w = pk2(hi[2], hi[3]);
            *(v4u*)(M + (size_t)row * 1024 + c8) = o; } }
    }
}

DI void attn_job(const Params& P, LAS unsigned char* lds, int l, int stream, int job, int tid, int lane, int wave) {
    const int Lq = stream ? 2048 : 256, Lk = stream ? 2560 : 256, nqb = Lq / 128;
    int jr = job; if ((256 % 8) == 0) { const int xcd = job & 7, idx = job >> 3; jr = xcd * 32 + idx; }
    const int qb = jr % nqb, bh = jr / nqb;
    const int qs = wave >> 1, map = wave & 1, r = lane & 31, hh = lane >> 5;
    const bf16* Q = (const bf16*)(P.ws + WS_Q + (stream ? 8 * MiB : 0)) + ((size_t)(bh * 2 + map) * Lq + qb * 128 + qs * 32 + r) * 64;
    const bf16* K = (const bf16*)(P.ws + WS_K + (stream ? 8 * MiB : 0)) + (size_t)(bh * 2) * Lk * 64;
    const bf16* VT = (const bf16*)(P.ws + WS_VT + (stream ? 8 * MiB : 0)) + (size_t)bh * 128 * Lk;
    bf16x8 qf[4];
#pragma unroll
    for (int ks = 0; ks < 4; ++ks) qf[ks] = *(const bf16x8*)(Q + 16 * ks + 8 * hh);
    constexpr int KTB = 18432, BUFB = 36864, PWOFF = 2 * BUFB;
    LAS unsigned char* pw = lds + PWOFF + wave * 4608;
    const bf16* ksrc[2]; int kdst[2]; const bf16* vsrc[2]; int vdst[2];
#pragma unroll
    for (int i = 0; i < 2; ++i) { const int idx = tid + 512 * i; const int mp = idx >> 9, key = (idx >> 3) & 63, ch = idx & 7;
        ksrc[i] = K + ((size_t)mp * Lk + key) * 64 + ch * 8; kdst[i] = mp * 9216 + key * 144 + ch * 16;
        const int dv = idx >> 3; vsrc[i] = VT + (size_t)dv * Lk + ch * 8; vdst[i] = KTB + dv * 144 + (16 * (ch >> 1) + 4 * (ch & 1)) * 2; }
    const int nkt = Lk / 64;
    v4u kr[2], vr[2];
#pragma unroll
    for (int i = 0; i < 2; ++i) { kr[i] = *(const v4u*)ksrc[i]; vr[i] = *(const v4u*)vsrc[i]; }
#pragma unroll
    for (int i = 0; i < 2; ++i) { *(LAS v4u*)(lds + kdst[i]) = kr[i]; *(LAS v2u*)(lds + vdst[i]) = (v2u){vr[i].x, vr[i].y}; *(LAS v2u*)(lds + vdst[i] + 16) = (v2u){vr[i].z, vr[i].w}; }
    __syncthreads();
    f32x16 oacc[4];
#pragma unroll
    for (int d = 0; d < 4; ++d)
#pragma unroll
        for (int i = 0; i < 16; ++i) oacc[d][i] = 0.f;
    float mrun = -1e30f, lsum = 0.f;
#pragma unroll 1
    for (int kt = 0; kt < nkt; ++kt) {
        const int buf = kt & 1; const bool more = kt + 1 < nkt;
        if (more) {
#pragma unroll
            for (int i = 0; i < 2; ++i) { kr[i] = *(const v4u*)(ksrc[i] + (size_t)(kt + 1) * 64 * 64); vr[i] = *(const v4u*)(vsrc[i] + (kt + 1) * 64); } }
        const LAS unsigned char* kt_ = lds + buf * BUFB + map * 9216; const LAS unsigned char* vt_ = lds + buf * BUFB + KTB;
        f32x16 s[2];
#pragma unroll
        for (int kh = 0; kh < 2; ++kh) {
#pragma unroll
            for (int i = 0; i < 16; ++i) s[kh][i] = 0.f;
#pragma unroll
            for (int ks = 0; ks < 4; ++ks) { const bf16x8 kf = *(const LAS bf16x8*)(kt_ + (32 * kh + r) * 144 + (16 * ks + 8 * hh) * 2); s[kh] = MFMA32(kf, qf[ks], s[kh]); }
        }
        float mx = s[0][0];
#pragma unroll
        for (int kh = 0; kh < 2; ++kh)
#pragma unroll
            for (int i = 0; i < 16; ++i) mx = fmaxf(mx, s[kh][i]);
        mx = fmaxf(mx, __shfl_xor(mx, 32));
        const float mnew = fmaxf(mrun, mx); const float alpha = __builtin_amdgcn_exp2f(mrun - mnew); mrun = mnew;
        float ps = 0.f;
#pragma unroll
        for (int kh = 0; kh < 2; ++kh)
#pragma unroll
            for (int i = 0; i < 16; ++i) { const float p = __builtin_amdgcn_exp2f(s[kh][i] - mnew); s[kh][i] = p; ps += p; }
        lsum = lsum * alpha + ps;
        if (!__all(alpha == 1.0f)) {
#pragma unroll
        for (int d = 0; d < 4; ++d)
#pragma unroll
            for (int i = 0; i < 16; ++i) oacc[d][i] *= alpha;
        }
#pragma unroll
        for (int k2 = 0; k2 < 4; ++k2) { const int kh = k2 >> 1, sb = 8 * (k2 & 1); v4u pk;
            asm volatile("v_cvt_pk_bf16_f32 %0, %4, %5\n\tv_cvt_pk_bf16_f32 %1, %6, %7\n\tv_cvt_pk_bf16_f32 %2, %8, %9\n\tv_cvt_pk_bf16_f32 %3, %10, %11\n\ts_nop 1"
                         : "=&v"(pk.x), "=&v"(pk.y), "=&v"(pk.z), "=&v"(pk.w)
                         : "v"(s[kh][sb]), "v"(s[kh][sb + 1]), "v"(s[kh][sb + 2]), "v"(s[kh][sb + 3]), "v"(s[kh][sb + 4]), "v"(s[kh][sb + 5]), "v"(s[kh][sb + 6]), "v"(s[kh][sb + 7]));
            const bf16x8 pf = __builtin_bit_cast(bf16x8, pk);
#pragma unroll
            for (int d = 0; d < 4; ++d) { const bf16x8 vf = *(const LAS bf16x8*)(vt_ + (32 * d + r) * 144 + (16 * k2 + 8 * hh) * 2); oacc[d] = MFMA32(vf, pf, oacc[d]); } }
        if (more) {
#pragma unroll
            for (int i = 0; i < 2; ++i) { *(LAS v4u*)(lds + (buf ^ 1) * BUFB + kdst[i]) = kr[i]; *(LAS v2u*)(lds + (buf ^ 1) * BUFB + vdst[i]) = (v2u){vr[i].x, vr[i].y}; *(LAS v2u*)(lds + (buf ^ 1) * BUFB + vdst[i] + 16) = (v2u){vr[i].z, vr[i].w}; } }
        __syncthreads();
    }
    lsum += __shfl_xor(lsum, 32);
    const float il = 1.f / lsum;
    LAS float* X = (LAS float*)lds + qs * 4096;
    if (map == 1) {
#pragma unroll
        for (int d = 0; d < 4; ++d)
#pragma unroll
            for (int i = 0; i < 16; ++i) { const int dv = 32 * d + (i & 3) + 8 * (i >> 2) + 4 * hh; X[dv * 32 + r] = oacc[d][i] * il; }
    }
    __syncthreads();
    if (map == 0) {
        const float lam = ((const float*)(P.ws + WS_LAM))[l]; const float lam_init = 0.8f - 0.6f * expf(-0.3f * (float)l);
        float ss = 0.f;
#pragma unroll
        for (int d = 0; d < 4; ++d)
#pragma unroll
            for (int i = 0; i < 16; ++i) { const int dv = 32 * d + (i & 3) + 8 * (i >> 2) + 4 * hh; const float o = oacc[d][i] * il - lam * X[dv * 32 + r]; oacc[d][i] = o; ss += o * o; }
        ss += __shfl_xor(ss, 32);
        const float rstd = rsqrtf(ss * (1.f / 128.f) + 1e-6f) * (1.f - lam_init);
        const float* sg = P.in[23] + l * 128;
        const int b = bh >> 2, h = bh & 3; const int tok = (stream ? NPT + b * 2048 : b * 256) + qb * 128 + qs * 32 + r;
        bf16* yat = (bf16*)(P.ws + WS_ATZ) + (size_t)tok * 512 + h * 128;
#pragma unroll
        for (int d = 0; d < 4; ++d) { f32x4 ggv[4]; v2u zzv[4];
#pragma unroll
            for (int rg = 0; rg < 4; ++rg) { const int dv = 32 * d + 8 * rg + 4 * hh; ggv[rg] = *(const f32x4*)(sg + dv); zzv[rg] = *(const v2u*)(yat + dv); }
#pragma unroll
            for (int rg = 0; rg < 4; ++rg) { const int dv = 32 * d + 8 * rg + 4 * hh; const f32x4 gg = ggv[rg]; const v2u zz = zzv[rg];
                v2u w; w.x = pk2(oacc[d][4 * rg] * rstd * gg[0] * bflo(zz.x), oacc[d][4 * rg + 1] * rstd * gg[1] * bfhi(zz.x));
                w.y = pk2(oacc[d][4 * rg + 2] * rstd * gg[2] * bflo(zz.y), oacc[d][4 * rg + 3] * rstd * gg[3] * bfhi(zz.y));
                *(v2u*)(yat + dv) = w; } }
    }
    __syncthreads();
}

template <int HALF>
DI void pool_means(const bf16* col2, int ts, int t0, int L, LAS bf16* Mt, int cp) {
    unsigned raw[48];
#pragma unroll
    for (int i = 8 - HALF; i < 40 + HALF; ++i) { const int tau = ts - 8 + i; const int tc = tau < 0 ? 0 : (tau >= L ? L - 1 : tau); const unsigned v = *(const unsigned*)(col2 + (size_t)tc * 512); raw[i] = (tau >= 0 && tau < L) ? v : 0u; }
    float s0 = 0.f, s1 = 0.f;
#pragma unroll
    for (int i = 8 - HALF; i < 8 + HALF; ++i) { s0 += bflo(raw[i]); s1 += bfhi(raw[i]); }
#pragma unroll
    for (int k = 0; k < 32; ++k) { const int t = ts + k; const int lo = t - HALF < 0 ? 0 : t - HALF, hi = t + HALF > L ? L : t + HALF; const float rc = 1.f / (float)(hi - lo);
        *(LAS unsigned*)(Mt + (t - t0) * 136 + 2 * cp) = pk2(s0 * rc - bflo(raw[k + 8]), s1 * rc - bfhi(raw[k + 8]));
        s0 += bflo(raw[k + 8 + HALF]) - bflo(raw[k + 8 - HALF]); s1 += bfhi(raw[k + 8 + HALF]) - bfhi(raw[k + 8 - HALF]); }
}
DI void pool_job(const Params& P, LAS unsigned char* lds, int l, int job, int tid, int lane, int wave) {
    const int tile = job >> 2, g = job & 3;
    const int tok0 = tile * 256; int t0, L; if (tile < 32) { t0 = 0; L = 256; } else { t0 = (tok0 - NPT) & 2047; L = 2048; }
    const bf16* plu = (const bf16*)(P.ws + WS_PLU); bf16* plz = (bf16*)(P.ws + WS_PLZ);
    LAS bf16* Mt = (LAS bf16*)lds; LAS bf16* PW = (LAS bf16*)(lds + 69632);
    { const bf16* src = (const bf16*)(P.ws + WS_POOLT) + (size_t)g * 16384;
      v4u t[4];
#pragma unroll
      for (int i = 0; i < 4; ++i) { const int q = tid + 512 * i; t[i] = *(const v4u*)(src + (q >> 4) * 128 + (q & 15) * 8); }
#pragma unroll
      for (int i = 0; i < 4; ++i) { const int q = tid + 512 * i; *(LAS v4u*)(PW + (q >> 4) * 136 + (q & 15) * 8) = t[i]; } }
    { const int cp = tid & 63, seg = tid >> 6; const bf16* col2 = plu + (size_t)(tok0 - t0) * 512 + g * 128 + 2 * cp;
      const int ts = t0 + seg * 32;
      if (g == 0) pool_means<1>(col2, ts, t0, L, Mt, cp); else if (g == 1) pool_means<2>(col2, ts, t0, L, Mt, cp); else if (g == 2) pool_means<4>(col2, ts, t0, L, Mt, cp); else pool_means<8>(col2, ts, t0, L, Mt, cp); }
    __syncthreads();
    const int r = lane & 31, hh = lane >> 5;
    f32x16 acc[4];
#pragma unroll
    for (int mb = 0; mb < 4; ++mb)
#pragma unroll
        for (int i = 0; i < 16; ++i) acc[mb][i] = 0.f;
#pragma unroll
    for (int ks = 0; ks < 8; ++ks) { const bf16x8 bfr = *(const LAS bf16x8*)(Mt + (32 * wave + r) * 136 + 16 * ks + 8 * hh);
#pragma unroll
        for (int mb = 0; mb < 4; ++mb) { const bf16x8 af = *(const LAS bf16x8*)(PW + (32 * mb + r) * 136 + 16 * ks + 8 * hh); acc[mb] = MFMA32(af, bfr, acc[mb]); } }
#pragma unroll
    for (int mb = 0; mb < 4; ++mb)
#pragma unroll
        for (int rg = 0; rg < 4; ++rg) { v2u w; w.x = pk2(acc[mb][4 * rg], acc[mb][4 * rg + 1]); w.y = pk2(acc[mb][4 * rg + 2], acc[mb][4 * rg + 3]);
            *(LAS v2u*)(Mt + (32 * wave + r) * 136 + 32 * mb + 8 * rg + 4 * hh) = w; }
    __syncthreads();
    { const float* psc = P.in[25] + l * 512 + g * 128; const int ch8 = (tid & 15) * 8; const f32x4 sc0 = *(const f32x4*)(psc + ch8), sc1 = *(const f32x4*)(psc + ch8 + 4);
      bf16* gp = plz + (size_t)tok0 * 512 + g * 128 + ch8; v4u zz[8];
#pragma unroll
      for (int i = 0; i < 8; ++i) { const int row = (tid >> 4) + 32 * i; zz[i] = *(const v4u*)(gp + (size_t)row * 512); }
#pragma unroll
      for (int i = 0; i < 8; ++i) { const int row = (tid >> 4) + 32 * i; const v4u d = *(const LAS v4u*)(Mt + row * 136 + ch8); const v4u z = zz[i];
          v4u o; o.x = pk2(bflo(d.x) * sc0[0] * bflo(z.x), bfhi(d.x) * sc0[1] * bfhi(z.x)); o.y = pk2(bflo(d.y) * sc0[2] * bflo(z.y), bfhi(d.y) * sc0[3] * bfhi(z.y));
          o.z = pk2(bflo(d.z) * sc1[0] * bflo(z.z), bfhi(d.z) * sc1[1] * bfhi(z.z)); o.w = pk2(bflo(d.w) * sc1[2] * bflo(z.w), bfhi(d.w) * sc1[3] * bfhi(z.w));
          *(v4u*)(gp + (size_t)row * 512) = o; } }
    __syncthreads();
}

#ifndef GALIGN
#define GALIGN true
#endif
#ifndef GSP2
#define GSP2 true
#endif
#ifndef PROBE_MASK
#define PROBE_MASK 0
#define PROBE_JOB 0
#endif
#define GSYNC() do { if (nts == 1 && P.ws == nullptr) grid.sync();   { XcdBarrier xb_; xb_.bar = (unsigned*)(P.ws + WS_BAR); xb_.x = xb_xcc_id(); xb_.st = (volatile LAS unsigned*)(lds + LDS_BYTES - 64); xcd_barrier(xb_); } if (PROBE_MASK != 0 && blockIdx.x == 0 && threadIdx.x == 0) { ((unsigned long long*)(P.ws + 8192))[nts] = __builtin_amdgcn_s_memrealtime(); } ++nts; } while (0)
__global__ void __launch_bounds__(512, 2) mk_fwd(Params P) {
    extern __shared__ __attribute__((aligned(16))) unsigned char lds_raw[];
    LAS unsigned char* lds = (LAS unsigned char*)lds_raw;
    cg::grid_group grid = cg::this_grid();
#define TLW() int tid_l = threadIdx.x; asm volatile("" : "+v"(tid_l)); const int tid = tid_l, lane = tid & 63, wave = __builtin_amdgcn_readfirstlane(tid >> 6); (void)lane; (void)wave
    const int G = gridDim.x, bid = blockIdx.x;
    unsigned char* ws = P.ws; int nts = 1; unsigned long long jtot = 0;
    volatile LAS unsigned* xst = (volatile LAS unsigned*)(lds + LDS_BYTES - 64);
    if (threadIdx.x < 16) xst[threadIdx.x] = 0u;
    __syncthreads();
    (void)xcd_barrier_post((unsigned*)(P.ws + WS_BAR), xst);
    if (PROBE_MASK != 0 && blockIdx.x == 0 && threadIdx.x == 0) ((unsigned long long*)(P.ws + 8192))[0] = __builtin_amdgcn_s_memrealtime();
#ifndef NO_PA
    { TLW(); phase_a(P, lds, tid, bid, G); }
#endif
    GSYNC();
#pragma unroll 1
    for (int l = 0; l < 2; ++l) {
        const float* xP = l == 0 ? P.in[0] : P.out; const float* xS = l == 0 ? P.in[1] : P.out + (size_t)NPT * 1024;
#ifndef NO_P0
        { TLW(); phase_p0(P, lds, l, xP, xS, tid, lane, wave, bid, G); }
#endif
        GSYNC();
        {
            { pg8::Gemm g{(const pg8::bf16_t*)(ws + WS_WINT), (const pg8::bf16_t*)(ws + WS_H), 2048, NTOK, 1024}; pg8::StaticOrder S; S.init(2048, NTOK, G, bid);
              EpiHyT E{(bf16*)(ws + WS_HYT)};
#ifndef NO_G1
              pg8::gemm_phase<EpiHyT, pg8::StaticOrder, GALIGN, GSP2>(lds, g, S, E);
#endif
 }
            { pg8::Gemm g{(const pg8::bf16_t*)(ws + WS_H), (const pg8::bf16_t*)(ws + WS_WINT) + (size_t)2048 * 1024, NTOK, 3072, 1024}; pg8::StaticOrder S; S.init(NTOK, 3072, G, bid);
              EpiB E{l, P.in[19] + l * 64, P.in[20] + l * 64, (const float*)(ws + WS_ROPE), (const float*)(ws + WS_ROPE) + 2048 * 32, ws, P.out + (size_t)2 * NPT * 1024, P.out + (size_t)3 * NPT * 1024};
#ifndef NO_G2
              pg8::gemm_phase<EpiB, pg8::StaticOrder, GALIGN, GSP2>(lds, g, S, E);
#endif
 }
        }
        GSYNC();
        {
            for (int j = bid; j < 1792; j += G) { TLW();
                const int jtype = j < 256 ? 1 : j < 768 ? 2 : j < 1280 ? 3 : j < 1536 ? 4 : 5; unsigned long long jt0 = 0; if (PROBE_JOB == jtype) jt0 = __builtin_amdgcn_s_memrealtime();
#ifndef NO_MIX
                if (j < 256) attn_job(P, lds, l, 1, j, tid, lane, wave);
                else if (j < 768) hyena_job(P, lds, l, 1, j - 256, tid, lane, wave);
                else if (j < 1280) hyena_job(P, lds, l, 0, j - 768, tid, lane, wave);
                else if (j < 1536) attn_job(P, lds, l, 0, j - 1280, tid, lane, wave);
                else pool_job(P, lds, l, j - 1536, tid, lane, wave);
#endif
                if (PROBE_JOB == jtype) jtot += __builtin_amdgcn_s_memrealtime() - jt0;
            }
        }
        GSYNC();
        { TLW(); yhy_transpose(P, lds, lane, wave, bid, G); }
        GSYNC();
        { pg8::Gemm g{(const pg8::bf16_t*)(ws + WS_YHY), (const pg8::bf16_t*)(ws + WS_WOT), 3 * NTOK, 3072, 512}; BrOrder S{G, bid};
          EpiBr E{(bf16*)(ws + WS_BBUF)};
#ifndef NO_G3
 pg8::gemm_phase<EpiBr, BrOrder, GALIGN, GSP2>(lds, g, S, E);
#endif
 }
        GSYNC();
        { pg8::Gemm g{(const pg8::bf16_t*)(ws + WS_H), (const pg8::bf16_t*)(ws + WS_WINT) + (size_t)5120 * 1024, NTOK, 3072, 1024}; pg8::StaticOrder S; S.init(NTOK, 3072, G, bid);
          EpiGate E{(const bf16*)(ws + WS_BBUF), (bf16*)(ws + WS_YHY)};
#ifndef NO_G4
 pg8::gemm_phase<EpiGate, pg8::StaticOrder, GALIGN, GSP2>(lds, g, S, E);
#endif
 }
        GSYNC();
        { pg8::Gemm g{(const pg8::bf16_t*)(ws + WS_YHY), (const pg8::bf16_t*)(ws + WS_WOUT3), NTOK, 1024, 1024}; pg8::StaticOrder S; S.init(NTOK, 1024, G, bid);
          EpiOut E{xP, xS, P.out, (const float*)(ws + WS_MOD) + l * 5 * 3072}; pg8::gemm_phase<EpiOut, pg8::StaticOrder, GALIGN, GSP2>(lds, g, S, E); }
        if (l == 0 || PROBE_MASK != 0) GSYNC();
    }
    if (PROBE_MASK != 0 && blockIdx.x == 0 && threadIdx.x == 0) {
        const unsigned long long* ts = (const unsigned long long*)(P.ws + 8192); unsigned long long tot = 0;
        for (int i = 0; i < 15; ++i) if ((PROBE_MASK >> i) & 1) tot += ts[i + 1] - ts[i];
        if (PROBE_JOB != 0) tot = jtot;
        P.out[0] += (float)tot * (1e-5f * 4.0f);
    }
}

extern "C" void kernel_launch(void* const* d_in, const int* in_sizes, int n_in, void* d_out, int out_size, void* d_ws, size_t ws_size, hipStream_t stream) {
    static int grid = 0;
    if (grid == 0) {
        if (n_in != 30 || ws_size < WS_END) { fprintf(stderr, "kernel_launch: unexpected n_in %d / ws_size %zu\n", n_in, ws_size); grid = -1; return; }
        int dev = 0, cus = 0, per_cu = 0;
        hipGetDevice(&dev); hipDeviceGetAttribute(&cus, hipDeviceAttributeMultiprocessorCount, dev);
        if (hipFuncSetAttribute((const void*)mk_fwd, hipFuncAttributeMaxDynamicSharedMemorySize, LDS_BYTES) != hipSuccess) { fprintf(stderr, "kernel_launch: hipFuncSetAttribute failed\n"); grid = -1; return; }
        if (hipOccupancyMaxActiveBlocksPerMultiprocessor(&per_cu, (const void*)mk_fwd, 512, LDS_BYTES) != hipSuccess || per_cu < 1) { fprintf(stderr, "kernel_launch: occupancy query says %d\n", per_cu); per_cu = 1; }
        (void)hipGetLastError();
        grid = cus * per_cu;
    }
    if (grid < 0) return;
    if (hipMemsetAsync((char*)d_ws + WS_BAR, 0, 16384, stream) != hipSuccess) { fprintf(stderr, "kernel_launch: hipMemsetAsync failed\n"); return; }
    Params p{};
    for (int i = 0; i < 30; ++i) p.in[i] = (const float*)d_in[i];
    p.out = (float*)d_out; p.ws = (unsigned char*)d_ws;
    void* args[] = {&p};
    hipError_t e = hipLaunchCooperativeKernel((const void*)mk_fwd, dim3(grid), dim3(512), args, LDS_BYTES, stream);
    if (e != hipSuccess) fprintf(stderr, "cooperative launch failed: %s (grid %d)\n", hipGetErrorString(e), grid);
}
```

```cpp
#include <hip/hip_runtime.h>
#include <hip/hip_cooperative_groups.h>
#include <cstdio>
#include <cstdint>
namespace cg = cooperative_groups;
namespace pg8 {
#define PG8_LAS __attribute__((address_space(3)))
typedef unsigned short bf16_t;
typedef short bf16x8 __attribute__((ext_vector_type(8)));
typedef float f32x4 __attribute__((ext_vector_type(4)));
typedef unsigned u32x4 __attribute__((ext_vector_type(4)));
constexpr int BM = 256, BK = 64, HALF = 128, HTB = HALF * BK * 2  , STAGE_BYTES = 8 * HTB, NXCD = 8, WGM = 8;

__host__ __device__ __forceinline__ int lds_byte(int r, int c) { const int st = (r >> 4) * 2 + (c >> 5), rr = r & 15, cc = c & 31, ob = rr * 64 + cc * 2; return st * 1024 + (ob ^ (((ob >> 9) & 1) << 5)); }
__host__ __device__ __forceinline__ void stage_rc(int b, int& R, int& C) { const int st = b / 1024, sb = b % 1024, swz = sb ^ (((sb >> 9) & 1) << 5); R = (st >> 1) * 16 + swz / 64; C = (st & 1) * 32 + (swz % 64) / 2; }
__host__ __device__ __forceinline__ int perm32(int rho) { const int n = rho >> 4, i = rho & 15; return 8 * (i >> 2) + 4 * n + (i & 3); }

struct Unit { int pm, pn; };
struct Gemm { const bf16_t* A; const bf16_t* Bt; int M, N, K; };

struct StaticOrder {
    int nM, nN, nwg, G, c;
    __host__ __device__ void init(int M, int N, int G_, int c_) { nM = M / BM; nN = N / BM; nwg = nM * nN; G = G_; c = c_; }
    __host__ __device__ bool next(int i, Unit& u) const {
        const long L = (long)i * G + c; if (L >= nwg) return false;
        int wgid = (int)L; { const int q = nwg / NXCD, r = nwg % NXCD, xcd = wgid % NXCD, off = wgid / NXCD; wgid = (xcd < r ? xcd * (q + 1) : r * (q + 1) + (xcd - r) * q) + off; }
        const int nig = WGM * nN, gid = wgid / nig, fm = gid * WGM, gsz = (nM - fm) < WGM ? (nM - fm) : WGM;
        u.pm = fm + ((wgid % nig) % gsz); u.pn = (wgid % nig) / gsz; return true;
    }
    __device__ __forceinline__ void a_ready(const Unit&) const {}
    __device__ __forceinline__ void done(const Unit&) const {}
};

__device__ __forceinline__ unsigned cvt_pk_bf16(float lo, float hi) { unsigned r; asm volatile("v_cvt_pk_bf16_f32 %0, %1, %2" : "=v"(r) : "v"(lo), "v"(hi)); return r; }
typedef float f32x2 __attribute__((ext_vector_type(2)));
template <class Epi, class Sched, bool ALIGN_EPI = false, bool SP2 = false>
__device__ __forceinline__ void gemm_phase(PG8_LAS unsigned char* lds, const Gemm g, const Sched& S, const Epi& E) {
    int tid_l = threadIdx.x; asm volatile("" : "+v"(tid_l)); const int tid = tid_l, wid = __builtin_amdgcn_readfirstlane(tid >> 6), lane = tid & 63, wr = wid >> 2, wc = wid & 3, fr = lane & 15, fq = lane >> 4;
    const int K = g.K, nt = K / BK;
    unsigned voffA[2], voffB[2];
#pragma unroll
    for (int i = 0; i < 2; ++i) { int R, C; stage_rc(tid * 16 + i * 8192, R, C); const int Rb = Epi::PERM ? ((R & ~31) + perm32(R & 31)) : R;
        voffA[i] = (unsigned)(R * K + C) * 2u; voffB[i] = (unsigned)(Rb * K + C) * 2u; }
    const size_t kstep = (size_t)(BK * 2);
    const size_t hstep = (size_t)HALF * K * 2;
    const size_t tstep = 2 * hstep;
    const unsigned ldsw = (unsigned)wid * 1024u;
    const int aoff = lds_byte(wr * 64 + fr, fq * 8), boff = lds_byte(wc * 32 + fr, fq * 8);
#define PG8_SA(b, h) (((b) * 2 + (h)) * HTB)
#define PG8_SB(b, h) ((4 + (b) * 2 + (h)) * HTB)
#define PG8_STAGE(bufoff, gbase, voff) do { _Pragma("unroll") for (int _i = 0; _i < 2; ++_i) \
        __builtin_amdgcn_global_load_lds((const unsigned*)((const char*)(gbase) + (voff)[_i]), (PG8_LAS unsigned*)(lds + (bufoff) + ldsw + _i * 8192), 16, 0, 0); } while (0)
#define PG8_LDA(dst, b, h) do { _Pragma("unroll") for (int m = 0; m < 4; ++m) _Pragma("unroll") for (int k = 0; k < 2; ++k) dst[m][k] = *(const PG8_LAS bf16x8*)(lds + PG8_SA(b, h) + aoff + m * 2048 + k * 1024); } while (0)
#define PG8_LDB(dst, b, h) do { _Pragma("unroll") for (int n = 0; n < 2; ++n) _Pragma("unroll") for (int k = 0; k < 2; ++k) dst[n][k] = *(const PG8_LAS bf16x8*)(lds + PG8_SB(b, h) + boff + n * 2048 + k * 1024); } while (0)
#define PG8_MMA(ai, bj, At, Bt) do { __builtin_amdgcn_s_setprio(1); _Pragma("unroll") for (int m = 0; m < 4; ++m) _Pragma("unroll") for (int n = 0; n < 2; ++n) _Pragma("unroll") for (int k = 0; k < 2; ++k) \
        acc[ai][bj][m][n] = __builtin_amdgcn_mfma_f32_16x16x32_bf16(Bt[n][k], At[m][k], acc[ai][bj][m][n], 0, 0, 0); __builtin_amdgcn_s_setprio(0); } while (0)
#define PG8_WAIT_V(n) asm volatile("s_waitcnt vmcnt(" #n ")" ::: "memory")
#define PG8_WAIT_L(n) asm volatile("s_waitcnt lgkmcnt(" #n ")" ::: "memory")
#define PG8_BAR __builtin_amdgcn_s_barrier()
#define PG8_SCHED __builtin_amdgcn_sched_barrier(0)
    Unit cur, nxt; int ui = 0;
    if (!S.next(0, cur)) return;
    f32x4 acc[2][2][4][2];
#pragma unroll
    for (int a = 0; a < 2; ++a)
#pragma unroll
        for (int b = 0; b < 2; ++b)
#pragma unroll
            for (int m = 0; m < 4; ++m)
#pragma unroll
                for (int n = 0; n < 2; ++n) acc[a][b][m][n] = (f32x4){0.f, 0.f, 0.f, 0.f};
    bf16x8 At[4][2], B0[2][2], B1[2][2];
    const char* cA = (const char*)g.A + (size_t)cur.pm * tstep; const char* cB = (const char*)g.Bt + (size_t)cur.pn * tstep;
    S.a_ready(cur);
    if constexpr (SP2) {
        PG8_STAGE(PG8_SB(0, 0), cB, voffB); PG8_STAGE(PG8_SB(0, 1), cB + hstep, voffB); PG8_STAGE(PG8_SA(0, 0), cA, voffA); PG8_STAGE(PG8_SA(0, 1), cA + hstep, voffA);
        if (wr == 1) PG8_BAR;
        PG8_WAIT_V(2); PG8_BAR;
        PG8_STAGE(PG8_SB(1, 0), cB + kstep, voffB); PG8_STAGE(PG8_SA(1, 0), cA + kstep, voffA); PG8_STAGE(PG8_SB(1, 1), cB + hstep + kstep, voffB);
        PG8_WAIT_V(6); PG8_BAR;
    } else {
        PG8_STAGE(PG8_SB(0, 0), cB, voffB); PG8_STAGE(PG8_SA(0, 0), cA, voffA); PG8_STAGE(PG8_SB(0, 1), cB + hstep, voffB); PG8_STAGE(PG8_SA(0, 1), cA + hstep, voffA);
        if (wr == 1) PG8_BAR;
        PG8_WAIT_V(4); PG8_BAR;
        PG8_STAGE(PG8_SB(1, 0), cB + kstep, voffB); PG8_STAGE(PG8_SA(1, 0), cA + kstep, voffA); PG8_STAGE(PG8_SB(1, 1), cB + hstep + kstep, voffB);
        PG8_WAIT_V(6); PG8_BAR;
    }
    for (;;) {
        const bool has_next = S.next(ui + 1, nxt);
        const char* nA = has_next ? (const char*)g.A + (size_t)nxt.pm * tstep : cA; const char* nB = has_next ? (const char*)g.Bt + (size_t)nxt.pn * tstep : cB;
        for (int t = 0; t < nt; t += 2) {
            const bool last = (t == nt - 2);
            const char* a1 = cA + (size_t)(t + 1) * kstep;
            const char* a2 = last ? nA : cA + (size_t)(t + 2) * kstep; const char* b2 = last ? nB : cB + (size_t)(t + 2) * kstep;
            const char* a3 = a2 + kstep; const char* b3 = b2 + kstep;
            if (last && has_next) S.a_ready(nxt);
            if constexpr (SP2) {
            PG8_LDB(B0, 0, 0); PG8_LDB(B1, 0, 1); PG8_SCHED; PG8_LDA(At, 0, 0); PG8_STAGE(PG8_SA(1, 1), a1 + hstep, voffA);
            PG8_WAIT_V(8); PG8_WAIT_L(0); PG8_BAR; PG8_MMA(0, 0, At, B0); PG8_MMA(0, 1, At, B1); PG8_BAR; PG8_SCHED;
            PG8_LDA(At, 0, 1); PG8_STAGE(PG8_SB(0, 0), b2, voffB); PG8_STAGE(PG8_SB(0, 1), b2 + hstep, voffB); PG8_STAGE(PG8_SA(0, 0), a2, voffA);
            PG8_WAIT_V(8); PG8_WAIT_L(0); PG8_BAR; PG8_MMA(1, 0, At, B0); PG8_MMA(1, 1, At, B1); PG8_BAR; PG8_SCHED;
            PG8_LDB(B0, 1, 0); PG8_LDB(B1, 1, 1); PG8_SCHED; PG8_LDA(At, 1, 0); PG8_STAGE(PG8_SA(0, 1), a2 + hstep, voffA);
            PG8_WAIT_V(8); PG8_WAIT_L(0); PG8_BAR; PG8_MMA(0, 0, At, B0); PG8_MMA(0, 1, At, B1); PG8_BAR; PG8_SCHED;
            PG8_LDA(At, 1, 1); PG8_STAGE(PG8_SB(1, 0), b3, voffB); PG8_STAGE(PG8_SB(1, 1), b3 + hstep, voffB); PG8_STAGE(PG8_SA(1, 0), a3, voffA);
            PG8_WAIT_V(8); PG8_WAIT_L(0); PG8_BAR; PG8_MMA(1, 0, At, B0); PG8_MMA(1, 1, At, B1); PG8_BAR; PG8_SCHED;
            } else {
            PG8_LDB(B0, 0, 0); PG8_SCHED; PG8_LDA(At, 0, 0); PG8_STAGE(PG8_SA(1, 1), a1 + hstep, voffA);
            PG8_WAIT_L(8); PG8_BAR; PG8_WAIT_L(0); PG8_MMA(0, 0, At, B0); PG8_BAR; PG8_SCHED;
            PG8_LDB(B1, 0, 1); PG8_STAGE(PG8_SB(0, 0), b2, voffB);
            PG8_BAR; PG8_WAIT_L(0); PG8_MMA(0, 1, At, B1); PG8_BAR;
            PG8_LDA(At, 0, 1); PG8_STAGE(PG8_SA(0, 0), a2, voffA);
            PG8_BAR; PG8_WAIT_L(0); PG8_MMA(1, 0, At, B0); PG8_BAR; PG8_SCHED;
            PG8_STAGE(PG8_SB(0, 1), b2 + hstep, voffB);
            PG8_WAIT_V(6); PG8_BAR; PG8_MMA(1, 1, At, B1); PG8_BAR;
            PG8_LDB(B0, 1, 0); PG8_SCHED; PG8_LDA(At, 1, 0); PG8_STAGE(PG8_SA(0, 1), a2 + hstep, voffA);
            PG8_WAIT_L(8); PG8_BAR; PG8_WAIT_L(0); PG8_MMA(0, 0, At, B0); PG8_BAR; PG8_SCHED;
            PG8_LDB(B1, 1, 1); PG8_STAGE(PG8_SB(1, 0), b3, voffB);
            PG8_BAR; PG8_WAIT_L(0); PG8_MMA(0, 1, At, B1); PG8_BAR;
            PG8_LDA(At, 1, 1); PG8_STAGE(PG8_SA(1, 0), a3, voffA);
            PG8_BAR; PG8_WAIT_L(0); PG8_MMA(1, 0, At, B0); PG8_BAR; PG8_SCHED;
            PG8_STAGE(PG8_SB(1, 1), b3 + hstep, voffB);
            PG8_WAIT_V(6); PG8_BAR; PG8_MMA(1, 1, At, B1); PG8_BAR;
            }
        }
        if constexpr (ALIGN_EPI) { if (wr == 0) PG8_BAR; }
        if constexpr (!Epi::AFTER_DRAIN) { E(acc, cur, wr, wc, fr, fq); S.done(cur); }
        if (!has_next) break;
#pragma unroll
        for (int a = 0; a < 2; ++a)
#pragma unroll
            for (int b = 0; b < 2; ++b)
#pragma unroll
                for (int m = 0; m < 4; ++m)
#pragma unroll
                    for (int n = 0; n < 2; ++n) acc[a][b][m][n] = (f32x4){0.f, 0.f, 0.f, 0.f};
        cur = nxt; cA = nA; cB = nB; ++ui;
        if constexpr (ALIGN_EPI) { if (wr == 1) PG8_BAR; }
    }
    PG8_WAIT_V(0);
    if constexpr (!ALIGN_EPI) { if (wr == 0) PG8_BAR; }
    PG8_BAR;
    if constexpr (Epi::AFTER_DRAIN) { E.fused(acc, cur, wr, wc, fr, fq, lds, wid, lane); S.done(cur); }
#undef PG8_SA
#undef PG8_SB
#undef PG8_STAGE
#undef PG8_LDA
#undef PG8_LDB
#undef PG8_MMA
#undef PG8_WAIT_V
#undef PG8_WAIT_L
#undef PG8_BAR
#undef PG8_SCHED
}
}

#define LAS __attribute__((address_space(3)))
typedef unsigned short bf16;
typedef unsigned v4u __attribute__((ext_vector_type(4)));
typedef unsigned v2u __attribute__((ext_vector_type(2)));
typedef float f32x4 __attribute__((ext_vector_type(4)));
typedef float f32x2 __attribute__((ext_vector_type(2)));
typedef float f32x16 __attribute__((ext_vector_type(16)));
typedef short bf16x8 __attribute__((ext_vector_type(8)));
#define DI __device__ __forceinline__
#define MFMA32(a, b, c) __builtin_amdgcn_mfma_f32_32x32x16_bf16((a), (b), (c), 0, 0, 0)
#define MFMA16(a, b, c) __builtin_amdgcn_mfma_f32_16x16x32_bf16((a), (b), (c), 0, 0, 0)

constexpr int LDS_BYTES = 147456;
constexpr int NTOK = 16384, NPT = 8192, DM = 1024, DIN = 8192;
constexpr size_t MiB = 1u << 20;
constexpr size_t WS_BAR = 65536;
constexpr size_t WS_LAM = 4096;
constexpr size_t WS_MOD = 1 * MiB;
constexpr size_t WS_ROPE = 1 * MiB + 256 * 1024;
constexpr size_t WS_POOLT = 1 * MiB + 768 * 1024;
constexpr size_t WS_WINT = 2 * MiB;
constexpr size_t WS_WOT = 18 * MiB;
constexpr size_t WS_WOUT3 = 21 * MiB;
constexpr size_t WS_HRAW = 27 * MiB;
constexpr size_t WS_H = 36 * MiB;
constexpr size_t WS_YHY = 68 * MiB;
constexpr size_t WS_ATZ = 84 * MiB;
constexpr size_t WS_PLZ = 100 * MiB;
constexpr size_t WS_PLU = 116 * MiB;
constexpr size_t WS_HYT = 132 * MiB;
constexpr size_t WS_Q = 196 * MiB;
constexpr size_t WS_K = 212 * MiB;
constexpr size_t WS_VT = 230 * MiB;
constexpr size_t WS_BBUF = 148 * MiB;
constexpr size_t WS_MERGED = 116 * MiB;
constexpr size_t WS_END = 248 * MiB;

struct Params { const float* in[30]; float* out; unsigned char* ws; };

DI unsigned f2bf(float f) { unsigned u = __builtin_bit_cast(unsigned, f); return (u + 0x7fffu + ((u >> 16) & 1u)) >> 16; }
DI unsigned pk2(float lo, float hi) { return f2bf(lo) | (f2bf(hi) << 16); }
DI float bf2f(unsigned h) { return __builtin_bit_cast(float, h << 16); }
DI float bflo(unsigned w) { return __builtin_bit_cast(float, w << 16); }
DI float bfhi(unsigned w) { return __builtin_bit_cast(float, w & 0xffff0000u); }
DI float siluf(float x) { return x * __builtin_amdgcn_rcpf(1.f + __expf(-x)); }
DI float sigmf(float x) { return __builtin_amdgcn_rcpf(1.f + __expf(-x)); }
#define LDS_WAIT() asm volatile("s_waitcnt lgkmcnt(0)" ::: "memory")

#define XB_TMO      128
#define XB_XCNT(j)  (256  + 64 * (j))
#define XB_XSUB(j)  (1280 + 64 * (j))
#define XB_XGEN(j)  (2304 + 64 * (j))
#define XB_TOP      3328
#define XB_TOPGEN   3392
#define XCD_BAR_WORDS 3456
#define XB_SPIN_CAP (1u << 18)

__device__ __forceinline__ unsigned xb_ld(unsigned* p)              { return __hip_atomic_load(p, __ATOMIC_RELAXED, __HIP_MEMORY_SCOPE_AGENT); }
__device__ __forceinline__ unsigned xb_add(unsigned* p, unsigned v) { return __hip_atomic_fetch_add(p, v, __ATOMIC_RELAXED, __HIP_MEMORY_SCOPE_AGENT); }
__device__ __forceinline__ unsigned xb_xcc_id() { return (unsigned)__builtin_amdgcn_s_getreg((3 << 11) | 20) & 0xFu; }
#define XB_SPIN(cond, bar) do { unsigned _sp = 0; while (cond) { __builtin_amdgcn_s_sleep(1); \
    if ((++_sp & 255u) == 0u) { if (xb_ld(&(bar)[XB_TMO])) break; if (_sp > XB_SPIN_CAP) { atomicAdd(&(bar)[XB_TMO], 1u); break; } } } } while (0)

struct XcdBarrier {
    unsigned* bar; unsigned x;
    volatile LAS unsigned* st;
};

__device__ __forceinline__ XcdBarrier xcd_barrier_post(unsigned* bar, volatile LAS unsigned* st) {
    XcdBarrier b; b.bar = bar; b.x = xb_xcc_id(); b.st = st;
    if (threadIdx.x == 0) (void)xb_add(&bar[XB_XCNT(b.x)], 1u);
    return b;
}
__device__ __forceinline__ void xcd_barrier_complete(unsigned* bar, unsigned x, unsigned& nloc, unsigned& nx) {
    const unsigned G = gridDim.x * gridDim.y * gridDim.z;
    unsigned sum, cnt, mine, sp = 0u;
    for (;;) {
        sum = 0u; cnt = 0u; mine = 0u;
#pragma unroll
        for (unsigned j = 0; j < 16; ++j) { const unsigned c = xb_ld(&bar[XB_XCNT(j)]); sum += c; cnt += (c > 0u) ? 1u : 0u; mine = (j == x) ? c : mine; }
        if (sum == G) break;
        __builtin_amdgcn_s_sleep(1);
        if ((++sp & 255u) == 0u) { if (xb_ld(&bar[XB_TMO])) break; if (sp > XB_SPIN_CAP) { atomicAdd(&bar[XB_TMO], 1u); break; } }
    }
    nloc = mine > 0u ? mine : 1u; nx = cnt > 0u ? cnt : 1u;
}

__device__ __forceinline__ void xcd_barrier(const XcdBarrier& b) {
    asm volatile("s_waitcnt vmcnt(0)" ::: "memory");
    __syncthreads();
    if (threadIdx.x == 0) {
        unsigned* bar = b.bar;
        __builtin_amdgcn_s_waitcnt(0);
        unsigned nloc = b.st[0], nx = b.st[1];
        if (nloc == 0u) { xcd_barrier_complete(bar, b.x, nloc, nx); b.st[0] = nloc; b.st[1] = nx; }
        const unsigned old = xb_add(&bar[XB_XSUB(b.x)], 1u);
        const unsigned gen = old / nloc;
        if (old + 1u == (gen + 1u) * nloc) {
            __builtin_amdgcn_fence(__ATOMIC_RELEASE, "agent");
            asm volatile("s_waitcnt vmcnt(0)" ::: "memory");
            const unsigned og = xb_add(&bar[XB_TOP], 1u);
            const unsigned tg = og / nx;
            if (og + 1u == (tg + 1u) * nx) xb_add(&bar[XB_TOPGEN], 1u);
            else XB_SPIN(xb_ld(&bar[XB_TOPGEN]) == tg, bar);
            __builtin_amdgcn_fence(__ATOMIC_ACQUIRE, "agent");
            xb_add(&bar[XB_XGEN(b.x)], 1u);
            asm volatile("s_waitcnt vmcnt(0)" ::: "memory");
        } else {
            XB_SPIN(xb_ld(&bar[XB_XGEN(b.x)]) == gen, bar);
            __builtin_amdgcn_fence(__ATOMIC_ACQUIRE, "agent");
            asm volatile("s_waitcnt vmcnt(0)" ::: "memory");
        }
    }
    __syncthreads();
}

DI void tr_item(const float* src, size_t lds_, bf16* dst, size_t ldd, LAS float* scr, int lane) {
    float tv[32];
#pragma unroll
    for (int i = 0; i < 32; ++i) { const int kk = 2 * i + (lane >> 5); tv[i] = src[(size_t)kk * lds_ + (lane & 31)]; }
#pragma unroll
    for (int i = 0; i < 32; ++i) { const int kk = 2 * i + (lane >> 5); scr[kk * 33 + (lane & 31)] = tv[i]; }
    LDS_WAIT(); asm volatile("" ::: "memory");
    const int c = lane & 7;
#pragma unroll
    for (int j = 0; j < 4; ++j) { const int n = (lane >> 3) + 8 * j; const LAS float* s = scr + (8 * c) * 33 + n;
        v4u o; o.x = pk2(s[0 * 33], s[1 * 33]); o.y = pk2(s[2 * 33], s[3 * 33]); o.z = pk2(s[4 * 33], s[5 * 33]); o.w = pk2(s[6 * 33], s[7 * 33]);
        *(v4u*)(dst + (size_t)n * ldd + 8 * c) = o; }
    LDS_WAIT(); asm volatile("" ::: "memory");
}

DI void hraw_item(const Params& P, LAS unsigned char* lds, int l, int stream, int t0, int tid);
DI void phase_a(const Params& P, LAS unsigned char* lds, int tid, int bid, int G) {
    const float* c = P.in[4]; const float* cctx = P.in[5]; const float* w_ada = P.in[7]; const float* b_ada = P.in[8];
    float* mod = (float*)(P.ws + WS_MOD);
    LAS float* sc = (LAS float*)lds; LAS float* red = sc + 5 * 1024;
    for (int it = bid; it < 192; it += G) {
        const int l = it / 96, n0 = (it % 96) * 32;
        for (int idx = tid; idx < 5 * 1024; idx += 512) { const int r = idx >> 10, k = idx & 1023; const float cv = r == 0 ? cctx[k] : c[(r - 1) * 1024 + k]; sc[idx] = cv / (1.f + __expf(-cv)); }
        __syncthreads();
        const int cq = tid & 7, kg = tid >> 3; f32x4 acc[5]; f32x4 w[16];
#pragma unroll
        for (int r = 0; r < 5; ++r) acc[r] = (f32x4){0.f, 0.f, 0.f, 0.f};
#pragma unroll
        for (int kk = 0; kk < 16; ++kk) w[kk] = *(const f32x4*)(w_ada + ((size_t)l * 1024 + kg * 16 + kk) * 3072 + n0 + 4 * cq);
#pragma unroll
        for (int kk = 0; kk < 16; ++kk)
#pragma unroll
            for (int r = 0; r < 5; ++r) acc[r] += sc[r * 1024 + kg * 16 + kk] * w[kk];
#pragma unroll
        for (int r = 0; r < 5; ++r) *(LAS f32x4*)(red + (kg * 5 + r) * 32 + 4 * cq) = acc[r];
        __syncthreads();
        if (tid < 160) { const int r = tid >> 5, col = tid & 31; float s = b_ada[l * 3072 + n0 + col];
            for (int g = 0; g < 64; ++g) s += red[(g * 5 + r) * 32 + col];
            mod[(l * 5 + r) * 3072 + n0 + col] = s; }
        __syncthreads();
    }
    if (bid == 0 && tid < 2) {
        const int l = tid; const float* lq = P.in[21] + l * 128; const float* lk = P.in[22] + l * 128; float s0 = 0.f, s1 = 0.f;
        for (int i = 0; i < 64; ++i) { s0 += lq[i] * lk[i]; s1 += lq[64 + i] * lk[64 + i]; }
        const float lam_init = 0.8f - 0.6f * expf(-0.3f * (float)l);
        ((float*)(P.ws + WS_LAM))[l] = expf(s0) - expf(s1) + lam_init;
    }
}

DI void hraw_item(const Params& P, LAS unsigned char* lds, int l, int stream, int t0, int tid) {
    const int L = stream ? 2048 : 256;
    const float* w1 = P.in[12] + l * 33 * 64; const float* b1 = P.in[13] + l * 64; const float* w2 = P.in[14] + l * 64 * 64; const float* b2 = P.in[15] + l * 64;
    const float* w3 = P.in[16] + (size_t)l * 64 * 2048; const float* fq = P.in[17] + l * 128;
    bf16* out = (bf16*)(P.ws + WS_HRAW) + (stream ? 0 : (size_t)2 * 512 * 2 * 2048);
    LAS float* z = (LAS float*)lds; LAS float* h1 = z + 8 * 33 + 8; LAS float* h2 = h1 + 512; LAS float* w1s = h2 + 512; LAS float* w2s = w1s + 33 * 64;
    { const f32x4 a0 = *(const f32x4*)(w2 + 4 * tid), a1 = *(const f32x4*)(w2 + 2048 + 4 * tid);
      f32x4 b0 = (f32x4){0.f, 0.f, 0.f, 0.f}; const f32x4* w1v = (const f32x4*)w1; b0 = w1v[tid < 528 ? tid : 0]; f32x4 b1 = w1v[tid + 512 < 528 ? tid + 512 : 0];
      *(LAS f32x4*)(w2s + 4 * tid) = a0; *(LAS f32x4*)(w2s + 2048 + 4 * tid) = a1;
      *(LAS f32x4*)(w1s + 4 * tid) = b0; if (tid + 512 < 528) *(LAS f32x4*)(w1s + 4 * (tid + 512)) = b1; }
    if (tid < 8 * 33) { const int pos = tid / 33, j = tid % 33; const int t = t0 + pos; float v;
        if (j == 0) v = (float)t / (float)(L - 1);
        else { const int b = (j - 1) & 15; const float f = 1e-4f + (float)b * ((15.f - 1e-4f) / 15.f); const float w = 6.283185307179586f * (float)t / (float)L;
               v = (j <= 16) ? cosf(f * w) : -sinf(f * w); }
        z[pos * 33 + j] = v; }
    __syncthreads();
    { const int pos = tid >> 6, n = tid & 63; float a = b1[n];
#pragma unroll
      for (int j = 0; j < 33; ++j) a += z[pos * 33 + j] * w1s[j * 64 + n];
      h1[pos * 64 + n] = sinf(fq[n] * a); }
    __syncthreads();
    { const int pos = tid >> 6, n = tid & 63; float a = b2[n];
#pragma unroll 16
      for (int j = 0; j < 64; ++j) a += h1[pos * 64 + j] * w2s[j * 64 + n];
      h2[pos * 64 + n] = sinf(fq[64 + n] * a); }
    __syncthreads();
    { f32x4 acc[8];
#pragma unroll
      for (int p = 0; p < 8; ++p) acc[p] = (f32x4){0.f, 0.f, 0.f, 0.f};
#pragma unroll 1
      for (int k0 = 0; k0 < 64; k0 += 4) { f32x4 w[4];
#pragma unroll
          for (int kk = 0; kk < 4; ++kk) w[kk] = *(const f32x4*)(w3 + (size_t)(k0 + kk) * 2048 + 4 * tid);
#pragma unroll
          for (int p = 0; p < 8; ++p) { const f32x4 ha = *(const LAS f32x4*)(h2 + p * 64 + k0);
              acc[p] += ha[0] * w[0] + ha[1] * w[1] + ha[2] * w[2] + ha[3] * w[3]; } }
      const int n0 = 4 * tid, dir = n0 >> 10, o = (n0 >> 9) & 1;
#pragma unroll
      for (int e = 0; e < 4; ++e) { const int cc = (n0 & 511) + e; const float delta = 3.0701134573253944f + (float)cc * (12.280453829301578f / 511.f); float v[8];
#pragma unroll
          for (int p = 0; p < 8; ++p) { const float tn = (float)(t0 + p) / (float)(L - 1); v[p] = acc[p][e] * __expf(-tn * delta); }
          v4u w; w.x = pk2(v[0], v[1]); w.y = pk2(v[2], v[3]); w.z = pk2(v[4], v[5]); w.w = pk2(v[6], v[7]);
          *(v4u*)(out + ((size_t)((o * 512 + cc) * 2 + dir)) * L + t0) = w; } }
    __syncthreads();
}

DI void phase_p0(const Params& P, LAS unsigned char* lds, int l, const float* xsrcP, const float* xsrcS, int tid, int lane, int wave, int bid, int G) {
    const int gw = bid * 8 + wave, NGW = G * 8;
    LAS float* scr = (LAS float*)(lds + wave * 16384);
    bf16* WinT = (bf16*)(P.ws + WS_WINT); bf16* WoT = (bf16*)(P.ws + WS_WOT); bf16* Wout3 = (bf16*)(P.ws + WS_WOUT3); bf16* poolT = (bf16*)(P.ws + WS_POOLT);
    const float* w_in = P.in[9] + (size_t)l * 1024 * 8192;
    constexpr int I_IN = 16 * 256, I_O = 3 * 256, I_OUT = 512, I_PL = 32, I_CV = 512;
    constexpr int NIT = I_IN + I_O + I_OUT + I_PL + I_CV;
    for (int it = gw; it < NIT; it += NGW) {
        int r = it; const float* src; size_t sld; bf16* dst; size_t dld;
        if (r < I_IN) { const int kb = r >> 8, nb = r & 255, n0 = nb * 32; int drow = n0;
            if (n0 >= 2048 && n0 < 3072) { const int tb = n0 & ~255, lb = (n0 >> 5) & 7; drow = tb + 128 * (lb & 1) + 32 * (lb >> 1); }
            src = w_in + (size_t)(64 * kb) * 8192 + n0; sld = 8192; dst = WinT + (size_t)drow * 1024 + 64 * kb; dld = 1024; }
        else if ((r -= I_IN) < I_O) { const int j = r >> 8, q = r & 255, kb = q >> 5, nb = q & 31; const float* W = (j == 0 ? P.in[26] : j == 1 ? P.in[27] : P.in[28]) + (size_t)l * 512 * 1024;
            src = W + (size_t)(64 * kb) * 1024 + 32 * nb; sld = 1024; dst = WoT + (size_t)(j * 1024 + 32 * nb) * 512 + 64 * kb; dld = 512; }
        else if ((r -= I_O) < I_OUT) { const int kb = r >> 5, nb = r & 31; const float* W = P.in[29] + (size_t)l * 1024 * 1024;
            src = W + (size_t)(64 * kb) * 1024 + 32 * nb; sld = 1024; dst = Wout3 + (size_t)(32 * nb) * 1024 + 64 * kb; dld = 1024; }
        else if ((r -= I_OUT) < I_PL) { const int g = r >> 3, q = r & 7, kb = q >> 2, nb = q & 3; const float* W = P.in[24] + (size_t)(l * 4 + g) * 16384;
            src = W + (size_t)(64 * kb) * 128 + 32 * nb; sld = 128; dst = poolT + (size_t)g * 16384 + (size_t)(32 * nb) * 128 + 64 * kb; dld = 128; }
        else { r -= I_PL; const int b = r >> 7, q = r & 127, h = q >> 5, q2 = q & 31, kb = q2 >> 2, nb = q2 & 3;
            src = P.in[3] + ((size_t)(b * 2 + l) * 512 + 64 * kb) * 512 + h * 128 + 32 * nb; sld = 512;
            dst = (bf16*)(P.ws + WS_VT + 8 * MiB) + ((size_t)(b * 4 + h) * 128 + 32 * nb) * 2560 + 2048 + 64 * kb; dld = 2560; }
        tr_item(src, sld, dst, dld, scr, lane);
    }
    __syncthreads();
    { bf16* kS = (bf16*)(P.ws + WS_K + 8 * MiB);
      for (int idx = bid * 512 + tid; idx < 4 * 512 * 4 * 2 * 16; idx += G * 512) {
          const int d4 = idx & 15, map = (idx >> 4) & 1, h = (idx >> 5) & 3, p = (idx >> 7) & 511, b = idx >> 16;
          const f32x4 v = *(const f32x4*)(P.in[2] + ((((size_t)(b * 2 + l) * 512 + p) * 4 + h) * 2 + map) * 64 + d4 * 4);
          v2u w; w.x = pk2(v.x, v.y); w.y = pk2(v.z, v.w);
          *(v2u*)(kS + (((size_t)(b * 4 + h) * 2 + map) * 2560 + 2048 + p) * 64 + d4 * 4) = w; } }
    { const float* g = P.in[6] + l * 1024; const float* mod = (const float*)(P.ws + WS_MOD) + l * 5 * 3072; bf16* H = (bf16*)(P.ws + WS_H);
      f32x4 gg[4];
#pragma unroll
      for (int j = 0; j < 4; ++j) gg[j] = *(const f32x4*)(g + 4 * lane + 256 * j);
      const int HB = G >= 256 ? G - 32 : G; const int NGWH = HB * 8;
      if (bid < HB)
      for (int m0 = gw; m0 < NTOK; m0 += 2 * NGWH) {
          f32x4 v[2][4], sh[2][4], scl[2][4]; float s[2] = {0.f, 0.f};
#pragma unroll
          for (int u = 0; u < 2; ++u) { const int m = m0 + u * NGWH < NTOK ? m0 + u * NGWH : m0; const float* xr = m < NPT ? xsrcP + (size_t)m * 1024 : xsrcS + (size_t)(m - NPT) * 1024;
              const int r = m < NPT ? 0 : 1 + ((m - NPT) >> 11); const float* md = mod + r * 3072;
#pragma unroll
              for (int j = 0; j < 4; ++j) { const int c0 = 4 * lane + 256 * j; v[u][j] = *(const f32x4*)(xr + c0); sh[u][j] = *(const f32x4*)(md + c0); scl[u][j] = *(const f32x4*)(md + 1024 + c0); } }
#pragma unroll
          for (int u = 0; u < 2; ++u) { const int m = m0 + u * NGWH; if (m < NTOK) {
#pragma unroll
              for (int j = 0; j < 4; ++j) s[u] += (v[u][j].x * v[u][j].x + v[u][j].y * v[u][j].y) + (v[u][j].z * v[u][j].z + v[u][j].w * v[u][j].w);
#pragma unroll
              for (int o = 1; o < 64; o <<= 1) s[u] += __shfl_xor(s[u], o);
              const float rstd = rsqrtf(s[u] * (1.f / 1024.f) + 1e-6f);
#pragma unroll
              for (int j = 0; j < 4; ++j) { const int c0 = 4 * lane + 256 * j;
                  const f32x4 o = v[u][j] * rstd * gg[j] * (scl[u][j] + 1.f) + sh[u][j]; v2u w; w.x = pk2(o.x, o.y); w.y = pk2(o.z, o.w);
                  *(v2u*)(H + (size_t)m * 1024 + c0) = w; } } }
      } }
    for (int n = 0; ; ++n) {
        int item;
        if (G >= 256) { if (n >= 2) break; item = n == 0 ? (bid < 256 ? bid : -1) : (bid >= G - 32 ? 256 + bid - (G - 32) : -1); }
        else { item = bid + n * G; if (item >= 288) break; }
        if (item < 0) continue;
        const int stream = item < 256 ? 1 : 0; const int t0 = (stream ? item : item - 256) * 8; hraw_item(P, lds, l, stream, t0, tid);
    }
}

using pg8::Unit; using pg8::cvt_pk_bf16;
DI v4u pack8(f32x4 a, f32x4 b) { v4u w; w.x = cvt_pk_bf16(a[0], a[1]); w.y = cvt_pk_bf16(a[2], a[3]); w.z = cvt_pk_bf16(b[0], b[1]); w.w = cvt_pk_bf16(b[2], b[3]); return w; }
DI f32x4 silu4(f32x4 v) { return (f32x4){siluf(v[0]), siluf(v[1]), siluf(v[2]), siluf(v[3])}; }

struct EpiHyT {
    static constexpr bool PERM = true, AFTER_DRAIN = false; bf16* O;
    DI void operator()(const f32x4 (&acc)[2][2][4][2], const Unit& u, int wr, int wc, int fr, int fq) const {
        const bool act = u.pm >= 6; const int row0 = u.pm * 256 + wr * 64 + fr, col0 = u.pn * 256 + wc * 32 + 8 * fq;
#pragma unroll
        for (int ai = 0; ai < 2; ++ai)
#pragma unroll
            for (int m = 0; m < 4; ++m) { bf16* rowp = O + (size_t)(row0 + ai * 128 + m * 16) * NTOK + col0;
#pragma unroll
                for (int bj = 0; bj < 2; ++bj) { f32x4 v0 = acc[ai][bj][m][0], v1 = acc[ai][bj][m][1]; if (act) { v0 = silu4(v0); v1 = silu4(v1); }
                    *(v4u*)(rowp + bj * 128) = pack8(v0, v1); } }
    }
};

struct EpiB {
    static constexpr bool PERM = true, AFTER_DRAIN = false;
    int l; const float *gq, *gk, *ropec, *ropes; unsigned char* ws; float* newk; float* newv;
    DI void operator()(const f32x4 (&acc)[2][2][4][2], const Unit& u, int wr, int wc, int fr, int fq) const {
        const int pn = u.pn; const bool isS = u.pm >= 32;
        const int tok0 = u.pm * 256 + wr * 64 + fr;
        if (pn < 4) {
            const bool isk = pn >= 2; const int hd = 2 * (pn & 1) + (wc >> 1), map = wc & 1; const float* g = isk ? gk : gq;
            f32x4 gv[2][2];
#pragma unroll
            for (int bj = 0; bj < 2; ++bj)
#pragma unroll
                for (int n = 0; n < 2; ++n) gv[bj][n] = *(const f32x4*)(g + 32 * bj + 8 * fq + 4 * n);
            bf16* base = (bf16*)(ws + (isk ? WS_K : WS_Q) + (isS ? 8 * MiB : 0)); const int Lb = isS ? (isk ? 2560 : 2048) : 256;
            float invv[2][2];
#pragma unroll
            for (int n = 0; n < 2; ++n)
#pragma unroll
                for (int p = 0; p < 2; ++p) invv[n][p] = __expf(-(float)(4 * fq + 2 * n + p) * (9.210340371976184f / 16.f));
#pragma unroll
            for (int ai = 0; ai < 2; ++ai)
#pragma unroll
                for (int m = 0; m < 4; ++m) {
                    const int tok = tok0 + ai * 128 + m * 16; int b, t; if (isS) { const int tt = tok - NPT; b = tt >> 11; t = tt & 2047; } else { b = tok >> 8; t = tok & 255; }
                    float ss = 0.f; f32x4 v[2][2];
#pragma unroll
                    for (int bj = 0; bj < 2; ++bj)
#pragma unroll
                        for (int n = 0; n < 2; ++n) { const f32x4 x = acc[ai][bj][m][n]; ss += (x[0] * x[0] + x[1] * x[1]) + (x[2] * x[2] + x[3] * x[3]); }
                    ss += __shfl_xor(ss, 16); ss += __shfl_xor(ss, 32);
                    const float rstd = rsqrtf(ss * (1.f / 64.f) + 1e-6f);
#pragma unroll
                    for (int bj = 0; bj < 2; ++bj)
#pragma unroll
                        for (int n = 0; n < 2; ++n) v[bj][n] = acc[ai][bj][m][n] * rstd * gv[bj][n];
                    if (isk && !isS) { float* nk = newk + ((size_t)(b * 2 + l) * 256 + t) * 512 + hd * 128 + map * 64 + 8 * fq;
#pragma unroll
                        for (int bj = 0; bj < 2; ++bj)
#pragma unroll
                            for (int n = 0; n < 2; ++n) *(f32x4*)(nk + 32 * bj + 4 * n) = v[bj][n]; }
                    if (isS) {
                        int tl = t; asm volatile("" : "+v"(tl)); const float rowf = (float)(tl >> 6), colf = (float)(tl & 63);
#pragma unroll
                        for (int bj = 0; bj < 2; ++bj)
#pragma unroll
                            for (int n = 0; n < 2; ++n) { const float base = bj == 0 ? rowf : colf; const float a0 = base * invv[n][0], a1 = base * invv[n][1];
                                const float r0 = a0 * 0.15915494309189535f, r1 = a1 * 0.15915494309189535f; const float c0 = __builtin_amdgcn_cosf(r0), s0 = __builtin_amdgcn_sinf(r0), c1 = __builtin_amdgcn_cosf(r1), s1 = __builtin_amdgcn_sinf(r1);
                                const f32x4 x = v[bj][n]; v[bj][n] = (f32x4){x[0] * c0 - x[1] * s0, x[0] * s0 + x[1] * c0, x[2] * c1 - x[3] * s1, x[2] * s1 + x[3] * c1}; }
                    }
                    if (!isk) {
#pragma unroll
                        for (int bj = 0; bj < 2; ++bj)
#pragma unroll
                            for (int n = 0; n < 2; ++n) v[bj][n] = v[bj][n] * 0.18033688011112042f;
                    }
                    bf16* dp = base + ((size_t)((b * 4 + hd) * 2 + map) * Lb + t) * 64 + 8 * fq;
#pragma unroll
                    for (int bj = 0; bj < 2; ++bj) *(v4u*)(dp + 32 * bj) = pack8(v[bj][0], v[bj][1]);
                }
        } else if (pn < 6) {
            bf16* vt = (bf16*)(ws + WS_VT + (isS ? 8 * MiB : 0)); const int Lk = isS ? 2560 : 256;
#pragma unroll
            for (int ai = 0; ai < 2; ++ai)
#pragma unroll
                for (int m = 0; m < 4; ++m) {
                    const int tok = tok0 + ai * 128 + m * 16; int b, t; if (isS) { const int tt = tok - NPT; b = tt >> 11; t = tt & 2047; } else { b = tok >> 8; t = tok & 255; }
#pragma unroll
                    for (int bj = 0; bj < 2; ++bj) { const int hd = 2 * (pn - 4) + bj;
#pragma unroll
                        for (int n = 0; n < 2; ++n) { const int dv = 32 * wc + 8 * fq + 4 * n; const f32x4 x = acc[ai][bj][m][n];
                            if (!isS) *(f32x4*)(newv + ((size_t)(b * 2 + l) * 256 + t) * 512 + hd * 128 + dv) = x;
                            bf16* vp = vt + ((size_t)(b * 4 + hd) * 128 + dv) * Lk + t;
#pragma unroll
                            for (int e = 0; e < 4; ++e) vp[(size_t)e * Lk] = (bf16)f2bf(x[e]); } }
                }
        } else {
            const int which = (pn - 6) >> 1; bf16* dst = (bf16*)(ws + (which == 0 ? WS_ATZ : which == 1 ? WS_PLU : WS_PLZ)); const bool act = which != 1;
            const int col0 = 256 * ((pn - 6) & 1) + 32 * wc + 8 * fq;
#pragma unroll
            for (int ai = 0; ai < 2; ++ai)
#pragma unroll
                for (int m = 0; m < 4; ++m) { bf16* rowp = dst + (size_t)(tok0 + ai * 128 + m * 16) * 512 + col0;
#pragma unroll
                    for (int bj = 0; bj < 2; ++bj) { f32x4 v0 = acc[ai][bj][m][0], v1 = acc[ai][bj][m][1]; if (act) { v0 = silu4(v0); v1 = silu4(v1); }
                        *(v4u*)(rowp + bj * 128) = pack8(v0, v1); } }
        }
    }
};

struct BrOrder {
    int G, c;
    DI bool next(int i, Unit& u) const { const int L = i * G + c; if (L >= 768) return false; const int j = L >> 8, r0 = L & 255;
        int tm, tn; if (G == 256) { tm = 8 * (r0 & 7) + ((r0 >> 3) & 7); tn = r0 >> 6; } else { const int r = (r0 & 7) * 32 + (r0 >> 3); tm = r >> 2; tn = r & 3; }
        u.pm = j * 64 + tm; u.pn = j * 4 + tn; return true; }
    DI void a_ready(const Unit&) const {}
    DI void done(const Unit&) const {}
};
struct EpiBr {
    static constexpr bool PERM = true, AFTER_DRAIN = false; bf16* O;
    DI void operator()(const f32x4 (&acc)[2][2][4][2], const Unit& u, int wr, int wc, int fr, int fq) const {
        const int row0 = (u.pm & 63) * 256 + wr * 64 + fr, col0 = u.pn * 256 + wc * 32 + 8 * fq;
#pragma unroll
        for (int ai = 0; ai < 2; ++ai)
#pragma unroll
            for (int m = 0; m < 4; ++m) { bf16* rowp = O + (size_t)(row0 + ai * 128 + m * 16) * 3072 + col0;
#pragma unroll
                for (int bj = 0; bj < 2; ++bj) *(v4u*)(rowp + bj * 128) = pack8(acc[ai][bj][m][0], acc[ai][bj][m][1]); }
    }
};
struct EpiGate {
    static constexpr bool PERM = true, AFTER_DRAIN = false; const bf16* B; bf16* M;
    DI void operator()(const f32x4 (&acc)[2][2][4][2], const Unit& u, int wr, int wc, int fr, int fq) const {
        const int j = u.pn >> 2; const int row0 = u.pm * 256 + wr * 64 + fr, col0 = u.pn * 256 + wc * 32 + 8 * fq, mc0 = (u.pn & 3) * 256 + wc * 32 + 8 * fq;
        const bf16* bb = B + (size_t)row0 * 3072 + col0; bf16* mb = M + (size_t)row0 * 1024 + mc0;
#pragma unroll
        for (int ai = 0; ai < 2; ++ai) {
            v4u bv[4][2], mv[4][2];
#pragma unroll
            for (int m = 0; m < 4; ++m)
#pragma unroll
                for (int bj = 0; bj < 2; ++bj) { bv[m][bj] = *(const v4u*)(bb + (size_t)(ai * 128 + m * 16) * 3072 + bj * 128);
                    if (j > 0) { const unsigned long long* mq = (const unsigned long long*)(mb + (size_t)(ai * 128 + m * 16) * 1024 + bj * 128);
                        const unsigned long long q0 = __hip_atomic_load(mq, __ATOMIC_RELAXED, __HIP_MEMORY_SCOPE_AGENT), q1 = __hip_atomic_load(mq + 1, __ATOMIC_RELAXED, __HIP_MEMORY_SCOPE_AGENT);
                        mv[m][bj] = (v4u){(unsigned)q0, (unsigned)(q0 >> 32), (unsigned)q1, (unsigned)(q1 >> 32)}; }
                    else mv[m][bj] = (v4u){0u, 0u, 0u, 0u}; }
            asm volatile("s_waitcnt vmcnt(0)" ::: "memory");
#pragma unroll
            for (int m = 0; m < 4; ++m)
#pragma unroll
                for (int bj = 0; bj < 2; ++bj) { const v4u b = bv[m][bj], p = mv[m][bj]; const f32x4 g0 = acc[ai][bj][m][0], g1 = acc[ai][bj][m][1];
                    const f32x4 o0 = (f32x4){sigmf(g0[0]) * bflo(b.x) + bflo(p.x), sigmf(g0[1]) * bfhi(b.x) + bfhi(p.x), sigmf(g0[2]) * bflo(b.y) + bflo(p.y), sigmf(g0[3]) * bfhi(b.y) + bfhi(p.y)};
                    const f32x4 o1 = (f32x4){sigmf(g1[0]) * bflo(b.z) + bflo(p.z), sigmf(g1[1]) * bfhi(b.z) + bfhi(p.z), sigmf(g1[2]) * bflo(b.w) + bflo(p.w), sigmf(g1[3]) * bfhi(b.w) + bfhi(p.w)};
                    *(v4u*)(mb + (size_t)(ai * 128 + m * 16) * 1024 + bj * 128) = pack8(o0, o1); }
        }
    }
};
struct EpiOut {
    static constexpr bool PERM = true, AFTER_DRAIN = false; const float* xP; const float* xS; float* out; const float* mod;
    DI void operator()(const f32x4 (&acc)[2][2][4][2], const Unit& u, int wr, int wc, int fr, int fq) const {
        const int row0 = u.pm * 256 + wr * 64 + fr, col0 = u.pn * 256 + wc * 32 + 8 * fq;
        const int r = u.pm < 32 ? 0 : 1 + ((u.pm - 32) >> 3);
        const float* gt = mod + r * 3072 + 2048 + col0;
        f32x4 gv[2][2];
#pragma unroll
        for (int bj = 0; bj < 2; ++bj)
#pragma unroll
            for (int n = 0; n < 2; ++n) gv[bj][n] = *(const f32x4*)(gt + bj * 128 + 4 * n);
        const float* xb = (u.pm < 32 ? xP + (size_t)row0 * 1024 : xS + (size_t)(row0 - NPT) * 1024) + col0; float* ob = out + (size_t)row0 * 1024 + col0;
#pragma unroll
        for (int ai = 0; ai < 2; ++ai) {
            f32x4 xv[4][2][2];
#pragma unroll
            for (int m = 0; m < 4; ++m)
#pragma unroll
                for (int bj = 0; bj < 2; ++bj)
#pragma unroll
                    for (int n = 0; n < 2; ++n) xv[m][bj][n] = *(const f32x4*)(xb + (size_t)(ai * 128 + m * 16) * 1024 + bj * 128 + 4 * n);
            asm volatile("s_waitcnt vmcnt(0)" ::: "memory");
#pragma unroll
            for (int m = 0; m < 4; ++m)
#pragma unroll
                for (int bj = 0; bj < 2; ++bj)
#pragma unroll
                    for (int n = 0; n < 2; ++n) *(f32x4*)(ob + (size_t)(ai * 128 + m * 16) * 1024 + bj * 128 + 4 * n) = xv[m][bj][n] + gv[bj][n] * acc[ai][bj][m][n];
        }
    }
};

DI f32x4 conv4(const bf16* row, int s0, int t4, int L, float w0, float w1, float w2, float bias) {
    const bf16* p = row + s0 + t4; const v2u raw = *(const v2u*)p;
    const float x0 = bflo(raw.x), x1 = bfhi(raw.x), x2 = bflo(raw.y), x3 = bfhi(raw.y);
    const unsigned short rm = p[t4 > 0 ? -1 : 0], rp = p[(t4 + 4 < L) ? 4 : 3];
    const float xm = t4 > 0 ? bf2f(rm) : 0.f, xp = (t4 + 4 < L) ? bf2f(rp) : 0.f;
    return (f32x4){w0 * xm + w1 * x0 + w2 * x1 + bias, w0 * x0 + w1 * x1 + w2 * x2 + bias, w0 * x1 + w1 * x2 + w2 * x3 + bias, w0 * x2 + w1 * x3 + w2 * xp + bias};
}

#define LBAR() do { asm volatile("s_waitcnt lgkmcnt(0)" ::: "memory"); __builtin_amdgcn_s_barrier(); asm volatile("" ::: "memory"); } while (0)
struct Q4 { v2u raw; unsigned rm, rp; };
DI Q4 ld4(const bf16* row, int s0, int t4, int L) { const bf16* p = row + s0 + t4; Q4 q; q.raw = *(const v2u*)p; q.rm = p[t4 > 0 ? -1 : 0]; q.rp = p[(t4 + 4 < L) ? 4 : 3]; return q; }
DI f32x4 cv4(const Q4& q, int t4, int L, float w0, float w1, float w2, float bias) {
    const float x0 = bflo(q.raw.x), x1 = bfhi(q.raw.x), x2 = bflo(q.raw.y), x3 = bfhi(q.raw.y);
    const float xm = t4 > 0 ? bf2f(q.rm) : 0.f, xp = (t4 + 4 < L) ? bf2f(q.rp) : 0.f;
    return (f32x4){w0 * xm + w1 * x0 + w2 * x1 + bias, w0 * x0 + w1 * x1 + w2 * x2 + bias, w0 * x1 + w1 * x2 + w2 * x3 + bias, w0 * x2 + w1 * x3 + w2 * xp + bias};
}
DI void hyena_job(const Params& P, LAS unsigned char* lds, int l, int stream, int c, int tid, int lane, int wave) {
    const int L = stream ? 2048 : 256, Bn = stream ? 4 : 32, NB = L / 16, tokbase = stream ? NPT : 0;
    const int RCS = 2 * L + 16;
    const int RCB = 8 * RCS * 2, UN = Bn * (L + 256) + 256, UB = UN * 2;
    LAS bf16* RC = (LAS bf16*)lds; LAS bf16* U1 = (LAS bf16*)(lds + RCB); LAS bf16* U2 = (LAS bf16*)(lds + RCB + UB);
    LAS bf16* GR = (LAS bf16*)(lds + RCB + 2 * UB); LAS float* red = (LAS float*)(lds + RCB + 2 * UB + 8 * L);
    LAS bf16* GV = (LAS bf16*)(lds + RCB + 2 * UB + 8 * L + 64);
    const bf16* hyT = (const bf16*)(P.ws + WS_HYT);
    const bf16* rx1 = hyT + (size_t)c * NTOK; const bf16* rx2 = hyT + (size_t)(512 + c) * NTOK; const bf16* rv = hyT + (size_t)(1024 + c) * NTOK; const bf16* rz = hyT + (size_t)(1536 + c) * NTOK;
    const float* cw = P.in[10] + l * 3 * 1536; const float* cb = P.in[11] + l * 1536;
    const bf16* hraw = (const bf16*)(P.ws + WS_HRAW) + (stream ? 0 : (size_t)2 * 512 * 2 * 2048);
    const int a = lane & 15, g = lane >> 4, gb = g & 1, gh = g >> 1;
    const int kap = (16 - a) & 7, A8 = (a + 7) & ~7;
    const int i0 = stream ? 16 * wave : 0, b0 = stream ? 0 : 4 * wave;
    const int mlo = i0 - NB, nks = (NB + 16) / 2;
    const int t4o = 16 * (i0 + a) + 4 * g;
    v4u gr[2]; const int nvec = L / 2;
#pragma unroll
    for (int i = 0; i < 2; ++i) { const int idx = tid + 512 * i; const int e8 = (idx < nvec ? idx : 0) * 8; const int o = e8 / (2 * L), rem = e8 - o * 2 * L;
        gr[i] = *(const v4u*)(hraw + (size_t)((o * 512 + c) * 2) * L + rem); }
    Q4 qv[4], q1[4], q2[4]; v2u qz[4];
#pragma unroll
    for (int i = 0; i < 4; ++i) { const int q = tid + 512 * i; const int b = q / (L / 4), t4 = (q % (L / 4)) * 4; qv[i] = ld4(rv, tokbase + b * L, t4, L); }
#pragma unroll
    for (int b = 0; b < 4; ++b) { const int s0 = tokbase + (b0 + b) * L; q1[b] = ld4(rx1, s0, t4o, L); q2[b] = ld4(rx2, s0, t4o, L); qz[b] = *(const v2u*)(rz + s0 + t4o); }
    for (int i = tid; i < (2 * UB) / 16; i += 512) ((LAS v4u*)U1)[i] = (v4u){0u, 0u, 0u, 0u};
    LBAR();
#pragma unroll
    for (int i = 0; i < 2; ++i) { const int idx = tid + 512 * i; if (idx < nvec) *(LAS v4u*)(GR + idx * 8) = gr[i]; }
    { const float w0 = cw[1024 + c], w1 = cw[1536 + 1024 + c], w2 = cw[3072 + 1024 + c], bb = cb[1024 + c];
#pragma unroll
      for (int i = 0; i < 4; ++i) { const int q = tid + 512 * i; const int b = q / (L / 4), t4 = (q % (L / 4)) * 4; const f32x4 v = cv4(qv[i], t4, L, w0, w1, w2, bb);
          v2u w; w.x = pk2(v[0], v[1]); w.y = pk2(v[2], v[3]); *(LAS v2u*)(U1 + 256 + b * (L + 256) + t4) = w; } }
    LBAR();
    { const int per = (2 * L) / 512;
      float s0 = 0.f, s1 = 0.f;
      for (int k = 0; k < per; ++k) { const int e = tid + 512 * k; const float v0 = fabsf(bf2f(GR[e])), v1 = fabsf(bf2f(GR[2 * L + e])); const bool ok = e != L; s0 += ok ? v0 : 0.f; s1 += ok ? v1 : 0.f; }
#pragma unroll
      for (int of = 1; of < 64; of <<= 1) { s0 += __shfl_xor(s0, of); s1 += __shfl_xor(s1, of); }
      if (lane == 0) { red[wave * 2] = s0; red[wave * 2 + 1] = s1; } }
    LBAR();
    float inv[2];
#pragma unroll
    for (int o = 0; o < 2; ++o) { float sm = 0.f;
#pragma unroll
        for (int w = 0; w < 8; ++w) sm += red[w * 2 + o];
        inv[o] = 1.f / (sm + 1e-6f); }
#pragma unroll 1
    for (int o = 0; o < 2; ++o) {
        { const LAS bf16* G0 = GR + o * 2 * L; const float sc = inv[o];
          for (int x = tid; x < 2 * L + 32; x += 512) { const int d = L - x; const bool ok = d > -L && d < L; int idx = d >= 0 ? d : L - d; idx = idx < 0 ? 0 : (idx > 2 * L - 1 ? 2 * L - 1 : idx);
              const float v = bf2f(G0[idx]) * sc; GV[x] = (bf16)f2bf(ok ? v : 0.f); } }
        LBAR();
        for (int yq = tid; yq < RCS / 4; yq += 512) { const int y = 4 * yq; const LAS v2u* gp = (const LAS v2u*)(GV + y);
            const v2u a0 = gp[0], a1 = gp[1], a2 = gp[2]; const unsigned w[6] = {a0.x, a0.y, a1.x, a1.y, a2.x, a2.y};
#pragma unroll
            for (int k = 0; k < 8; ++k) { const int jd = k >> 1; v2u o2;
                if ((k & 1) == 0) { o2.x = w[jd]; o2.y = w[jd + 1]; }
                else { o2.x = __builtin_amdgcn_alignbit(w[jd + 1], w[jd], 16); o2.y = __builtin_amdgcn_alignbit(w[jd + 2], w[jd + 1], 16); }
                *(LAS v2u*)(RC + k * RCS + y) = o2; } }
        LBAR();
        LAS bf16* U = o == 0 ? U1 : U2;
        f32x4 acc[4];
#pragma unroll
        for (int b = 0; b < 4; ++b) acc[b] = (f32x4){0.f, 0.f, 0.f, 0.f};
        const LAS bf16* ap = RC + kap * RCS + L - 16 * (mlo + gh) - A8 + 8 * gb;
        const LAS bf16* bp = U + 256 + b0 * (L + 256) + 16 * (i0 + a - mlo - gh) + 8 * gb;
        bf16x8 af = *(const LAS bf16x8*)ap; bf16x8 bfr[4];
#pragma unroll
        for (int b = 0; b < 4; ++b) bfr[b] = *(const LAS bf16x8*)(bp + b * (L + 256));
#pragma unroll 4
        for (int ks = 0; ks < nks; ++ks) {
            const int kn = ks + 1 < nks ? ks + 1 : ks;
            const bf16x8 naf = *(const LAS bf16x8*)(ap - 32 * kn); bf16x8 nb[4];
#pragma unroll
            for (int b = 0; b < 4; ++b) nb[b] = *(const LAS bf16x8*)(bp - 32 * kn + b * (L + 256));
#pragma unroll
            for (int b = 0; b < 4; ++b) acc[b] = MFMA16(af, bfr[b], acc[b]);
            af = naf;
#pragma unroll
            for (int b = 0; b < 4; ++b) bfr[b] = nb[b];
        }
        const float bias = P.in[18][(l * 2 + o) * 512 + c];
        if (o == 0) {
            const float w0 = cw[c], w1 = cw[1536 + c], w2 = cw[3072 + c], bb = cb[c];
#pragma unroll
            for (int b = 0; b < 4; ++b) { const int bq = b0 + b; const f32x4 x1 = cv4(q1[b], t4o, L, w0, w1, w2, bb);
                const v2u uv = *(const LAS v2u*)(U1 + 256 + bq * (L + 256) + t4o);
                const f32x4 y = (f32x4){x1[0] * (acc[b][0] + bias * bflo(uv.x)), x1[1] * (acc[b][1] + bias * bfhi(uv.x)), x1[2] * (acc[b][2] + bias * bflo(uv.y)), x1[3] * (acc[b][3] + bias * bfhi(uv.y))};
                v2u w; w.x = pk2(y[0], y[1]); w.y = pk2(y[2], y[3]); *(LAS v2u*)(U2 + 256 + bq * (L + 256) + t4o) = w; }
        } else {
            const float w0 = cw[512 + c], w1 = cw[1536 + 512 + c], w2 = cw[3072 + 512 + c], bb = cb[512 + c];
            bf16* yh = (bf16*)(P.ws + WS_HYT) + (size_t)(1536 + c) * NTOK;
#pragma unroll
            for (int b = 0; b < 4; ++b) { const int bq = b0 + b; const int tok = tokbase + bq * L + t4o; const f32x4 x2 = cv4(q2[b], t4o, L, w0, w1, w2, bb);
                const v2u uv = *(const LAS v2u*)(U2 + 256 + bq * (L + 256) + t4o); const v2u zz = qz[b];
                const f32x4 y = (f32x4){x2[0] * (acc[b][0] + bias * bflo(uv.x)) * bflo(zz.x), x2[1] * (acc[b][1] + bias * bfhi(uv.x)) * bfhi(zz.x),
                                        x2[2] * (acc[b][2] + bias * bflo(uv.y)) * bflo(zz.y), x2[3] * (acc[b][3] + bias * bfhi(uv.y)) * bfhi(zz.y)};
                v2u w; w.x = pk2(y[0], y[1]); w.y = pk2(y[2], y[3]); *(v2u*)(yh + tok) = w; }
        }
        LBAR();
    }
    __syncthreads();
}

DI void yhy_transpose(const Params& P, LAS unsigned char* lds, int lane, int wave, int bid, int G) {
    const bf16* src0 = (const bf16*)(P.ws + WS_HYT) + (size_t)1536 * NTOK; bf16* dst0 = (bf16*)(P.ws + WS_YHY);
    LAS unsigned char* scr = lds + wave * 9216;
    for (int it = bid * 8 + wave; it < 2048; it += G * 8) {
        const int ch0 = (it >> 8) * 64, tok0 = (it & 255) * 64;
        v4u v[8];
#pragma unroll
        for (int i = 0; i < 8; ++i) { const int idx = lane + 64 * i, ch = idx >> 3, chunk = idx & 7; v[i] = *(const v4u*)(src0 + (size_t)(ch0 + ch) * NTOK + tok0 + chunk * 8); }
#pragma unroll
        for (int i = 0; i < 8; ++i) { const int idx = lane + 64 * i, ch = idx >> 3, chunk = idx & 7; *(LAS v4u*)(scr + ch * 144 + chunk * 16) = v[i]; }
        LDS_WAIT(); asm volatile("" ::: "memory");
#pragma unroll
        for (int i = 0; i < 8; ++i) { const int idx = lane + 64 * i, tok = idx >> 3, cc = idx & 7; const LAS bf16* p = (const LAS bf16*)(scr + (cc * 8) * 144) + tok;
            v4u o; o.x = (unsigned)p[0] | ((unsigned)p[72] << 16); o.y = (unsigned)p[144] | ((unsigned)p[216] << 16); o.z = (unsigned)p[288] | ((unsigned)p[360] << 16); o.w = (unsigned)p[432] | ((unsigned)p[504] << 16);
            *(v4u*)(dst0 + (size_t)(tok0 + tok) * 512 + ch0 + cc * 8) = o; }
        LDS_WAIT(); asm volatile("" ::: "memory");
    }
}

DI void merge_sum(const Params& P, int tid, int bid, int G) {
    const bf16* B = (const bf16*)(P.ws + WS_BBUF); bf16* M = (bf16*)(P.ws + WS_YHY);
    for (int idx0 = bid * 512 + tid; idx0 < NTOK * 128; idx0 += 4 * G * 512) {
        v4u a[4], b[4], c[4];
#pragma unroll
        for (int u = 0; u < 4; ++u) { const int idx = idx0 + u * G * 512 < NTOK * 128 ? idx0 + u * G * 512 : idx0; const int row = idx >> 7, c8 = (idx & 127) * 8; const bf16* p = B + (size_t)row * 3072 + c8;
            a[u] = *(const v4u*)p; b[u] = *(const v4u*)(p + 1024); c[u] = *(const v4u*)(p + 2048); }
#pragma unroll
        for (int u = 0; u < 4; ++u) { const int idx = idx0 + u * G * 512; if (idx < NTOK * 128) { const int row = idx >> 7, c8 = (idx & 127) * 8;
            const f32x4 lo = (f32x4){bflo(a[u].x) + bflo(b[u].x) + bflo(c[u].x), bfhi(a[u].x) + bfhi(b[u].x) + bfhi(c[u].x), bflo(a[u].y) + bflo(b[u].y) + bflo(c[u].y), bfhi(a[u].y) + bfhi(b[u].y) + bfhi(c[u].y)};
            const f32x4 hi = (f32x4){bflo(a[u].z) + bflo(b[u].z) + bflo(c[u].z), bfhi(a[u].z) + bfhi(b[u].z) + bfhi(c[u].z), bflo(a[u].w) + bflo(b[u].w) + bflo(c[u].w), bfhi(a[u].w) + bfhi(b[u].w) + bfhi(c[u].w)};
            v4u o; o.x = pk2(lo[0], lo[1]); o.y = pk2(lo[2], lo[3]); o.z = pk2(hi[0], hi[1]); o.w = pk2(hi[2], hi[3]);
            *(v4u*)(M + (size_t)row * 1024 + c8) = o; } }
    }
}

DI void attn_job(const Params& P, LAS unsigned char* lds, int l, int stream, int job, int tid, int lane, int wave) {
    const int Lq = stream ? 2048 : 256, Lk = stream ? 2560 : 256, nqb = Lq / 128;
    int jr = job; if ((256 % 8) == 0) { const int xcd = job & 7, idx = job >> 3; jr = xcd * 32 + idx; }
    const int qb = jr % nqb, bh = jr / nqb;
    const int qs = wave >> 1, map = wave & 1, r = lane & 31, hh = lane >> 5;
    const bf16* Q = (const bf16*)(P.ws + WS_Q + (stream ? 8 * MiB : 0)) + ((size_t)(bh * 2 + map) * Lq + qb * 128 + qs * 32 + r) * 64;
    const bf16* K = (const bf16*)(P.ws + WS_K + (stream ? 8 * MiB : 0)) + (size_t)(bh * 2) * Lk * 64;
    const bf16* VT = (const bf16*)(P.ws + WS_VT + (stream ? 8 * MiB : 0)) + (size_t)bh * 128 * Lk;
    bf16x8 qf[4];
#pragma unroll
    for (int ks = 0; ks < 4; ++ks) qf[ks] = *(const bf16x8*)(Q + 16 * ks + 8 * hh);
    constexpr int KTB = 18432, BUFB = 36864, PWOFF = 2 * BUFB;
    LAS unsigned char* pw = lds + PWOFF + wave * 4608;
    const bf16* ksrc[2]; int kdst[2]; const bf16* vsrc[2]; int vdst[2];
#pragma unroll
    for (int i = 0; i < 2; ++i) { const int idx = tid + 512 * i; const int mp = idx >> 9, key = (idx >> 3) & 63, ch = idx & 7;
        ksrc[i] = K + ((size_t)mp * Lk + key) * 64 + ch * 8; kdst[i] = mp * 9216 + key * 144 + ch * 16;
        const int dv = idx >> 3; vsrc[i] = VT + (size_t)dv * Lk + ch * 8; vdst[i] = KTB + dv * 144 + (16 * (ch >> 1) + 4 * (ch & 1)) * 2; }
    const int nkt = Lk / 64;
    v4u kr[2], vr[2];
#pragma unroll
    for (int i = 0; i < 2; ++i) { kr[i] = *(const v4u*)ksrc[i]; vr[i] = *(const v4u*)vsrc[i]; }
#pragma unroll
    for (int i = 0; i < 2; ++i) { *(LAS v4u*)(lds + kdst[i]) = kr[i]; *(LAS v2u*)(lds + vdst[i]) = (v2u){vr[i].x, vr[i].y}; *(LAS v2u*)(lds + vdst[i] + 16) = (v2u){vr[i].z, vr[i].w}; }
    __syncthreads();
    f32x16 oacc[4];
#pragma unroll
    for (int d = 0; d < 4; ++d)
#pragma unroll
        for (int i = 0; i < 16; ++i) oacc[d][i] = 0.f;
    float mrun = -1e30f, lsum = 0.f;
#pragma unroll 1
    for (int kt = 0; kt < nkt; ++kt) {
        const int buf = kt & 1; const bool more = kt + 1 < nkt;
        if (more) {
#pragma unroll
            for (int i = 0; i < 2; ++i) { kr[i] = *(const v4u*)(ksrc[i] + (size_t)(kt + 1) * 64 * 64); vr[i] = *(const v4u*)(vsrc[i] + (kt + 1) * 64); } }
        const LAS unsigned char* kt_ = lds + buf * BUFB + map * 9216; const LAS unsigned char* vt_ = lds + buf * BUFB + KTB;
        f32x16 s[2];
#pragma unroll
        for (int kh = 0; kh < 2; ++kh) {
#pragma unroll
            for (int i = 0; i < 16; ++i) s[kh][i] = 0.f;
#pragma unroll
            for (int ks = 0; ks < 4; ++ks) { const bf16x8 kf = *(const LAS bf16x8*)(kt_ + (32 * kh + r) * 144 + (16 * ks + 8 * hh) * 2); s[kh] = MFMA32(kf, qf[ks], s[kh]); }
        }
        float mx = s[0][0];
#pragma unroll
        for (int kh = 0; kh < 2; ++kh)
#pragma unroll
            for (int i = 0; i < 16; ++i) mx = fmaxf(mx, s[kh][i]);
        mx = fmaxf(mx, __shfl_xor(mx, 32));
        const float mnew = fmaxf(mrun, mx); const float alpha = __builtin_amdgcn_exp2f(mrun - mnew); mrun = mnew;
        float ps = 0.f;
#pragma unroll
        for (int kh = 0; kh < 2; ++kh)
#pragma unroll
            for (int i = 0; i < 16; ++i) { const float p = __builtin_amdgcn_exp2f(s[kh][i] - mnew); s[kh][i] = p; ps += p; }
        lsum = lsum * alpha + ps;
        if (!__all(alpha == 1.0f)) {
#pragma unroll
        for (int d = 0; d < 4; ++d)
#pragma unroll
            for (int i = 0; i < 16; ++i) oacc[d][i] *= alpha;
        }
#pragma unroll
        for (int k2 = 0; k2 < 4; ++k2) { const int kh = k2 >> 1, sb = 8 * (k2 & 1); v4u pk;
            asm volatile("v_cvt_pk_bf16_f32 %0, %4, %5\n\tv_cvt_pk_bf16_f32 %1, %6, %7\n\tv_cvt_pk_bf16_f32 %2, %8, %9\n\tv_cvt_pk_bf16_f32 %3, %10, %11\n\ts_nop 1"
                         : "=&v"(pk.x), "=&v"(pk.y), "=&v"(pk.z), "=&v"(pk.w)
                         : "v"(s[kh][sb]), "v"(s[kh][sb + 1]), "v"(s[kh][sb + 2]), "v"(s[kh][sb + 3]), "v"(s[kh][sb + 4]), "v"(s[kh][sb + 5]), "v"(s[kh][sb + 6]), "v"(s[kh][sb + 7]));
            const bf16x8 pf = __builtin_bit_cast(bf16x8, pk);
#pragma unroll
            for (int d = 0; d < 4; ++d) { const bf16x8 vf = *(const LAS bf16x8*)(vt_ + (32 * d + r) * 144 + (16 * k2 + 8 * hh) * 2); oacc[d] = MFMA32(vf, pf, oacc[d]); } }
        if (more) {
#pragma unroll
            for (int i = 0; i < 2; ++i) { *(LAS v4u*)(lds + (buf ^ 1) * BUFB + kdst[i]) = kr[i]; *(LAS v2u*)(lds + (buf ^ 1) * BUFB + vdst[i]) = (v2u){vr[i].x, vr[i].y}; *(LAS v2u*)(lds + (buf ^ 1) * BUFB + vdst[i] + 16) = (v2u){vr[i].z, vr[i].w}; } }
        __syncthreads();
    }
    lsum += __shfl_xor(lsum, 32);
    const float il = 1.f / lsum;
    LAS float* X = (LAS float*)lds + qs * 4096;
    if (map == 1) {
#pragma unroll
        for (int d = 0; d < 4; ++d)
#pragma unroll
            for (int i = 0; i < 16; ++i) { const int dv = 32 * d + (i & 3) + 8 * (i >> 2) + 4 * hh; X[dv * 32 + r] = oacc[d][i] * il; }
    }
    __syncthreads();
    if (map == 0) {
        const float lam = ((const float*)(P.ws + WS_LAM))[l]; const float lam_init = 0.8f - 0.6f * expf(-0.3f * (float)l);
        float ss = 0.f;
#pragma unroll
        for (int d = 0; d < 4; ++d)
#pragma unroll
            for (int i = 0; i < 16; ++i) { const int dv = 32 * d + (i & 3) + 8 * (i >> 2) + 4 * hh; const float o = oacc[d][i] * il - lam * X[dv * 32 + r]; oacc[d][i] = o; ss += o * o; }
        ss += __shfl_xor(ss, 32);
        const float rstd = rsqrtf(ss * (1.f / 128.f) + 1e-6f) * (1.f - lam_init);
        const float* sg = P.in[23] + l * 128;
        const int b = bh >> 2, h = bh & 3; const int tok = (stream ? NPT + b * 2048 : b * 256) + qb * 128 + qs * 32 + r;
        bf16* yat = (bf16*)(P.ws + WS_ATZ) + (size_t)tok * 512 + h * 128;
#pragma unroll
        for (int d = 0; d < 4; ++d) { f32x4 ggv[4]; v2u zzv[4];
#pragma unroll
            for (int rg = 0; rg < 4; ++rg) { const int dv = 32 * d + 8 * rg + 4 * hh; ggv[rg] = *(const f32x4*)(sg + dv); zzv[rg] = *(const v2u*)(yat + dv); }
#pragma unroll
            for (int rg = 0; rg < 4; ++rg) { const int dv = 32 * d + 8 * rg + 4 * hh; const f32x4 gg = ggv[rg]; const v2u zz = zzv[rg];
                v2u w; w.x = pk2(oacc[d][4 * rg] * rstd * gg[0] * bflo(zz.x), oacc[d][4 * rg + 1] * rstd * gg[1] * bfhi(zz.x));
                w.y = pk2(oacc[d][4 * rg + 2] * rstd * gg[2] * bflo(zz.y), oacc[d][4 * rg + 3] * rstd * gg[3] * bfhi(zz.y));
                *(v2u*)(yat + dv) = w; } }
    }
    __syncthreads();
}

template <int HALF>
DI void pool_means(const bf16* col2, int ts, int t0, int L, LAS bf16* Mt, int cp) {
    unsigned raw[48];
#pragma unroll
    for (int i = 8 - HALF; i < 40 + HALF; ++i) { const int tau = ts - 8 + i; const int tc = tau < 0 ? 0 : (tau >= L ? L - 1 : tau); const unsigned v = *(const unsigned*)(col2 + (size_t)tc * 512); raw[i] = (tau >= 0 && tau < L) ? v : 0u; }
    float s0 = 0.f, s1 = 0.f;
#pragma unroll
    for (int i = 8 - HALF; i < 8 + HALF; ++i) { s0 += bflo(raw[i]); s1 += bfhi(raw[i]); }
#pragma unroll
    for (int k = 0; k < 32; ++k) { const int t = ts + k; const int lo = t - HALF < 0 ? 0 : t - HALF, hi = t + HALF > L ? L : t + HALF; const float rc = 1.f / (float)(hi - lo);
        *(LAS unsigned*)(Mt + (t - t0) * 136 + 2 * cp) = pk2(s0 * rc - bflo(raw[k + 8]), s1 * rc - bfhi(raw[k + 8]));
        s0 += bflo(raw[k + 8 + HALF]) - bflo(raw[k + 8 - HALF]); s1 += bfhi(raw[k + 8 + HALF]) - bfhi(raw[k + 8 - HALF]); }
}
DI void pool_job(const Params& P, LAS unsigned char* lds, int l, int job, int tid, int lane, int wave) {
    const int tile = job >> 2, g = job & 3;
    const int tok0 = tile * 256; int t0, L; if (tile < 32) { t0 = 0; L = 256; } else { t0 = (tok0 - NPT) & 2047; L = 2048; }
    const bf16* plu = (const bf16*)(P.ws + WS_PLU); bf16* plz = (bf16*)(P.ws + WS_PLZ);
    LAS bf16* Mt = (LAS bf16*)lds; LAS bf16* PW = (LAS bf16*)(lds + 69632);
    { const bf16* src = (const bf16*)(P.ws + WS_POOLT) + (size_t)g * 16384;
      v4u t[4];
#pragma unroll
      for (int i = 0; i < 4; ++i) { const int q = tid + 512 * i; t[i] = *(const v4u*)(src + (q >> 4) * 128 + (q & 15) * 8); }
#pragma unroll
      for (int i = 0; i < 4; ++i) { const int q = tid + 512 * i; *(LAS v4u*)(PW + (q >> 4) * 136 + (q & 15) * 8) = t[i]; } }
    { const int cp = tid & 63, seg = tid >> 6; const bf16* col2 = plu + (size_t)(tok0 - t0) * 512 + g * 128 + 2 * cp;
      const int ts = t0 + seg * 32;
      if (g == 0) pool_means<1>(col2, ts, t0, L, Mt, cp); else if (g == 1) pool_means<2>(col2, ts, t0, L, Mt, cp); else if (g == 2) pool_means<4>(col2, ts, t0, L, Mt, cp); else pool_means<8>(col2, ts, t0, L, Mt, cp); }
    __syncthreads();
    const int r = lane & 31, hh = lane >> 5;
    f32x16 acc[4];
#pragma unroll
    for (int mb = 0; mb < 4; ++mb)
#pragma unroll
        for (int i = 0; i < 16; ++i) acc[mb][i] = 0.f;
#pragma unroll
    for (int ks = 0; ks < 8; ++ks) { const bf16x8 bfr = *(const LAS bf16x8*)(Mt + (32 * wave + r) * 136 + 16 * ks + 8 * hh);
#pragma unroll
        for (int mb = 0; mb < 4; ++mb) { const bf16x8 af = *(const LAS bf16x8*)(PW + (32 * mb + r) * 136 + 16 * ks + 8 * hh); acc[mb] = MFMA32(af, bfr, acc[mb]); } }
#pragma unroll
    for (int mb = 0; mb < 4; ++mb)
#pragma unroll
        for (int rg = 0; rg < 4; ++rg) { v2u w; w.x = pk2(acc[mb][4 * rg], acc[mb][4 * rg + 1]); w.y = pk2(acc[mb][4 * rg + 2], acc[mb][4 * rg + 3]);
            *(LAS v2u*)(Mt + (32 * wave + r) * 136 + 32 * mb + 8 * rg + 4 * hh) = w; }
    __syncthreads();
    { const float* psc = P.in[25] + l * 512 + g * 128; const int ch8 = (tid & 15) * 8; const f32x4 sc0 = *(const f32x4*)(psc + ch8), sc1 = *(const f32x4*)(psc + ch8 + 4);
      bf16* gp = plz + (size_t)tok0 * 512 + g * 128 + ch8; v4u zz[8];
#pragma unroll
      for (int i = 0; i < 8; ++i) { const int row = (tid >> 4) + 32 * i; zz[i] = *(const v4u*)(gp + (size_t)row * 512); }
#pragma unroll
      for (int i = 0; i < 8; ++i) { const int row = (tid >> 4) + 32 * i; const v4u d = *(const LAS v4u*)(Mt + row * 136 + ch8); const v4u z = zz[i];
          v4u o; o.x = pk2(bflo(d.x) * sc0[0] * bflo(z.x), bfhi(d.x) * sc0[1] * bfhi(z.x)); o.y = pk2(bflo(d.y) * sc0[2] * bflo(z.y), bfhi(d.y) * sc0[3] * bfhi(z.y));
          o.z = pk2(bflo(d.z) * sc1[0] * bflo(z.z), bfhi(d.z) * sc1[1] * bfhi(z.z)); o.w = pk2(bflo(d.w) * sc1[2] * bflo(z.w), bfhi(d.w) * sc1[3] * bfhi(z.w));
          *(v4u*)(gp + (size_t)row * 512) = o; } }
    __syncthreads();
}

#ifndef GALIGN
#define GALIGN true
#endif
#ifndef GSP2
#define GSP2 true
#endif
#ifndef PROBE_MASK
#define PROBE_MASK 0
#define PROBE_JOB 0
#endif
#define GSYNC() do { if (nts == 1 && P.ws == nullptr) grid.sync();   { XcdBarrier xb_; xb_.bar = (unsigned*)(P.ws + WS_BAR); xb_.x = xb_xcc_id(); xb_.st = (volatile LAS unsigned*)(lds + LDS_BYTES - 64); xcd_barrier(xb_); } if (PROBE_MASK != 0 && blockIdx.x == 0 && threadIdx.x == 0) { ((unsigned long long*)(P.ws + 8192))[nts] = __builtin_amdgcn_s_memrealtime(); } ++nts; } while (0)
__global__ void __launch_bounds__(512, 2) mk_fwd(Params P) {
    extern __shared__ __attribute__((aligned(16))) unsigned char lds_raw[];
    LAS unsigned char* lds = (LAS unsigned char*)lds_raw;
    cg::grid_group grid = cg::this_grid();
#define TLW() int tid_l = threadIdx.x; asm volatile("" : "+v"(tid_l)); const int tid = tid_l, lane = tid & 63, wave = __builtin_amdgcn_readfirstlane(tid >> 6); (void)lane; (void)wave
    const int G = gridDim.x, bid = blockIdx.x;
    unsigned char* ws = P.ws; int nts = 1; unsigned long long jtot = 0;
    volatile LAS unsigned* xst = (volatile LAS unsigned*)(lds + LDS_BYTES - 64);
    if (threadIdx.x < 16) xst[threadIdx.x] = 0u;
    __syncthreads();
    (void)xcd_barrier_post((unsigned*)(P.ws + WS_BAR), xst);
    if (PROBE_MASK != 0 && blockIdx.x == 0 && threadIdx.x == 0) ((unsigned long long*)(P.ws + 8192))[0] = __builtin_amdgcn_s_memrealtime();
#ifndef NO_PA
    { TLW(); phase_a(P, lds, tid, bid, G); }
#endif
    GSYNC();
#pragma unroll 1
    for (int l = 0; l < 2; ++l) {
        const float* xP = l == 0 ? P.in[0] : P.out; const float* xS = l == 0 ? P.in[1] : P.out + (size_t)NPT * 1024;
#ifndef NO_P0
        { TLW(); phase_p0(P, lds, l, xP, xS, tid, lane, wave, bid, G); }
#endif
        GSYNC();
        {
            { pg8::Gemm g{(const pg8::bf16_t*)(ws + WS_WINT), (const pg8::bf16_t*)(ws + WS_H), 2048, NTOK, 1024}; pg8::StaticOrder S; S.init(2048, NTOK, G, bid);
              EpiHyT E{(bf16*)(ws + WS_HYT)};
#ifndef NO_G1
              pg8::gemm_phase<EpiHyT, pg8::StaticOrder, GALIGN, GSP2>(lds, g, S, E);
#endif
 }
            { pg8::Gemm g{(const pg8::bf16_t*)(ws + WS_H), (const pg8::bf16_t*)(ws + WS_WINT) + (size_t)2048 * 1024, NTOK, 3072, 1024}; pg8::StaticOrder S; S.init(NTOK, 3072, G, bid);
              EpiB E{l, P.in[19] + l * 64, P.in[20] + l * 64, (const float*)(ws + WS_ROPE), (const float*)(ws + WS_ROPE) + 2048 * 32, ws, P.out + (size_t)2 * NPT * 1024, P.out + (size_t)3 * NPT * 1024};
#ifndef NO_G2
              pg8::gemm_phase<EpiB, pg8::StaticOrder, GALIGN, GSP2>(lds, g, S, E);
#endif
 }
        }
        GSYNC();
        {
            for (int j = bid; j < 1792; j += G) { TLW();
                const int jtype = j < 256 ? 1 : j < 768 ? 2 : j < 1280 ? 3 : j < 1536 ? 4 : 5; unsigned long long jt0 = 0; if (PROBE_JOB == jtype) jt0 = __builtin_amdgcn_s_memrealtime();
#ifndef NO_MIX
                if (j < 256) attn_job(P, lds, l, 1, j, tid, lane, wave);
                else if (j < 768) hyena_job(P, lds, l, 1, j - 256, tid, lane, wave);
                else if (j < 1280) hyena_job(P, lds, l, 0, j - 768, tid, lane, wave);
                else if (j < 1536) attn_job(P, lds, l, 0, j - 1280, tid, lane, wave);
                else pool_job(P, lds, l, j - 1536, tid, lane, wave);
#endif
                if (PROBE_JOB == jtype) jtot += __builtin_amdgcn_s_memrealtime() - jt0;
            }
        }
        GSYNC();
        { TLW(); yhy_transpose(P, lds, lane, wave, bid, G); }
        GSYNC();
        { pg8::Gemm g{(const pg8::bf16_t*)(ws + WS_YHY), (const pg8::bf16_t*)(ws + WS_WOT), 3 * NTOK, 3072, 512}; BrOrder S{G, bid};
          EpiBr E{(bf16*)(ws + WS_BBUF)};
#ifndef NO_G3
 pg8::gemm_phase<EpiBr, BrOrder, GALIGN, GSP2>(lds, g, S, E);
#endif
 }
        if (G != 256) GSYNC(); else { asm volatile("s_waitcnt vmcnt(0)" ::: "memory"); __syncthreads(); }
        { pg8::Gemm g{(const pg8::bf16_t*)(ws + WS_H), (const pg8::bf16_t*)(ws + WS_WINT) + (size_t)5120 * 1024, NTOK, 3072, 1024}; pg8::StaticOrder S; S.init(NTOK, 3072, G, bid);
          EpiGate E{(const bf16*)(ws + WS_BBUF), (bf16*)(ws + WS_MERGED)};
#ifndef NO_G4
 pg8::gemm_phase<EpiGate, pg8::StaticOrder, GALIGN, GSP2>(lds, g, S, E);
#endif
 }
        GSYNC();
        { pg8::Gemm g{(const pg8::bf16_t*)(ws + WS_MERGED), (const pg8::bf16_t*)(ws + WS_WOUT3), NTOK, 1024, 1024}; pg8::StaticOrder S; S.init(NTOK, 1024, G, bid);
          EpiOut E{xP, xS, P.out, (const float*)(ws + WS_MOD) + l * 5 * 3072}; pg8::gemm_phase<EpiOut, pg8::StaticOrder, GALIGN, GSP2>(lds, g, S, E); }
        if (l == 0 || PROBE_MASK != 0) GSYNC();
    }
    if (PROBE_MASK != 0 && blockIdx.x == 0 && threadIdx.x == 0) {
        const unsigned long long* ts = (const unsigned long long*)(P.ws + 8192); unsigned long long tot = 0;
        for (int i = 0; i < 15; ++i) if ((PROBE_MASK >> i) & 1) tot += ts[i + 1] - ts[i];
        if (PROBE_JOB != 0) tot = jtot;
        P.out[0] += (float)tot * (1e-5f * 4.0f);
    }
}

extern "C" void kernel_launch(void* const* d_in, const int* in_sizes, int n_in, void* d_out, int out_size, void* d_ws, size_t ws_size, hipStream_t stream) {
    static int grid = 0;
    if (grid == 0) {
        if (n_in != 30 || ws_size < WS_END) { fprintf(stderr, "kernel_launch: unexpected n_in %d / ws_size %zu\n", n_in, ws_size); grid = -1; return; }
        int dev = 0, cus = 0, per_cu = 0;
        hipGetDevice(&dev); hipDeviceGetAttribute(&cus, hipDeviceAttributeMultiprocessorCount, dev);
        if (hipFuncSetAttribute((const void*)mk_fwd, hipFuncAttributeMaxDynamicSharedMemorySize, LDS_BYTES) != hipSuccess) { fprintf(stderr, "kernel_launch: hipFuncSetAttribute failed\n"); grid = -1; return; }
        if (hipOccupancyMaxActiveBlocksPerMultiprocessor(&per_cu, (const void*)mk_fwd, 512, LDS_BYTES) != hipSuccess || per_cu < 1) { fprintf(stderr, "kernel_launch: occupancy query says %d\n", per_cu); per_cu = 1; }
        (void)hipGetLastError();
        grid = cus * per_cu;
    }
    if (grid < 0) return;
    if (hipMemsetAsync((char*)d_ws + WS_BAR, 0, 16384, stream) != hipSuccess) { fprintf(stderr, "kernel_launch: hipMemsetAsync failed\n"); return; }
    Params p{};
    for (int i = 0; i < 30; ++i) p.in[i] = (const float*)d_in[i];
    p.out = (float*)d_out; p.ws = (unsigned char*)d_ws;
    void* args[] = {&p};
    hipError_t e = hipLaunchCooperativeKernel((const void*)mk_fwd, dim3(grid), dim3(512), args, LDS_BYTES, stream);
    if (e != hipSuccess) fprintf(stderr, "cooperative launch failed: %s (grid %d)\n", hipGetErrorString(e), grid);
}
```

```cpp
#include <hip/hip_runtime.h>
#include <hip/hip_cooperative_groups.h>
#include <cstdio>
#include <cstdint>
namespace cg = cooperative_groups;
namespace pg8 {
#define PG8_LAS __attribute__((address_space(3)))
typedef unsigned short bf16_t;
typedef short bf16x8 __attribute__((ext_vector_type(8)));
typedef float f32x4 __attribute__((ext_vector_type(4)));
typedef unsigned u32x4 __attribute__((ext_vector_type(4)));
constexpr int BM = 256, BK = 64, HALF = 128, HTB = HALF * BK * 2  , STAGE_BYTES = 8 * HTB, NXCD = 8, WGM = 8;

__host__ __device__ __forceinline__ int lds_byte(int r, int c) { const int st = (r >> 4) * 2 + (c >> 5), rr = r & 15, cc = c & 31, ob = rr * 64 + cc * 2; return st * 1024 + (ob ^ (((ob >> 9) & 1) << 5)); }
__host__ __device__ __forceinline__ void stage_rc(int b, int& R, int& C) { const int st = b / 1024, sb = b % 1024, swz = sb ^ (((sb >> 9) & 1) << 5); R = (st >> 1) * 16 + swz / 64; C = (st & 1) * 32 + (swz % 64) / 2; }
__host__ __device__ __forceinline__ int perm32(int rho) { const int n = rho >> 4, i = rho & 15; return 8 * (i >> 2) + 4 * n + (i & 3); }

struct Unit { int pm, pn; };
struct Gemm { const bf16_t* A; const bf16_t* Bt; int M, N, K; };

struct StaticOrder {
    int nM, nN, nwg, G, c;
    __host__ __device__ void init(int M, int N, int G_, int c_) { nM = M / BM; nN = N / BM; nwg = nM * nN; G = G_; c = c_; }
    __host__ __device__ bool next(int i, Unit& u) const {
        const long L = (long)i * G + c; if (L >= nwg) return false;
        int wgid = (int)L; { const int q = nwg / NXCD, r = nwg % NXCD, xcd = wgid % NXCD, off = wgid / NXCD; wgid = (xcd < r ? xcd * (q + 1) : r * (q + 1) + (xcd - r) * q) + off; }
        const int nig = WGM * nN, gid = wgid / nig, fm = gid * WGM, gsz = (nM - fm) < WGM ? (nM - fm) : WGM;
        u.pm = fm + ((wgid % nig) % gsz); u.pn = (wgid % nig) / gsz; return true;
    }
    __device__ __forceinline__ void a_ready(const Unit&) const {}
    __device__ __forceinline__ void done(const Unit&) const {}
};

__device__ __forceinline__ unsigned cvt_pk_bf16(float lo, float hi) { unsigned r; asm volatile("v_cvt_pk_bf16_f32 %0, %1, %2" : "=v"(r) : "v"(lo), "v"(hi)); return r; }
typedef float f32x2 __attribute__((ext_vector_type(2)));
template <class Epi, class Sched, bool ALIGN_EPI = false, bool SP2 = false>
__device__ __forceinline__ void gemm_phase(PG8_LAS unsigned char* lds, const Gemm g, const Sched& S, const Epi& E) {
    int tid_l = threadIdx.x; asm volatile("" : "+v"(tid_l)); const int tid = tid_l, wid = __builtin_amdgcn_readfirstlane(tid >> 6), lane = tid & 63, wr = wid >> 2, wc = wid & 3, fr = lane & 15, fq = lane >> 4;
    const int K = g.K, nt = K / BK;
    unsigned voffA[2], voffB[2];
#pragma unroll
    for (int i = 0; i < 2; ++i) { int R, C; stage_rc(tid * 16 + i * 8192, R, C); const int Rb = Epi::PERM ? ((R & ~31) + perm32(R & 31)) : R;
        voffA[i] = (unsigned)(R * K + C) * 2u; voffB[i] = (unsigned)(Rb * K + C) * 2u; }
    const size_t kstep = (size_t)(BK * 2);
    const size_t hstep = (size_t)HALF * K * 2;
    const size_t tstep = 2 * hstep;
    const unsigned ldsw = (unsigned)wid * 1024u;
    const int aoff = lds_byte(wr * 64 + fr, fq * 8), boff = lds_byte(wc * 32 + fr, fq * 8);
#define PG8_SA(b, h) (((b) * 2 + (h)) * HTB)
#define PG8_SB(b, h) ((4 + (b) * 2 + (h)) * HTB)
#define PG8_STAGE(bufoff, gbase, voff) do { _Pragma("unroll") for (int _i = 0; _i < 2; ++_i) \
        __builtin_amdgcn_global_load_lds((const unsigned*)((const char*)(gbase) + (voff)[_i]), (PG8_LAS unsigned*)(lds + (bufoff) + ldsw + _i * 8192), 16, 0, 0); } while (0)
#define PG8_LDA(dst, b, h) do { _Pragma("unroll") for (int m = 0; m < 4; ++m) _Pragma("unroll") for (int k = 0; k < 2; ++k) dst[m][k] = *(const PG8_LAS bf16x8*)(lds + PG8_SA(b, h) + aoff + m * 2048 + k * 1024); } while (0)
#define PG8_LDB(dst, b, h) do { _Pragma("unroll") for (int n = 0; n < 2; ++n) _Pragma("unroll") for (int k = 0; k < 2; ++k) dst[n][k] = *(const PG8_LAS bf16x8*)(lds + PG8_SB(b, h) + boff + n * 2048 + k * 1024); } while (0)
#define PG8_MMA(ai, bj, At, Bt) do { __builtin_amdgcn_s_setprio(1); _Pragma("unroll") for (int m = 0; m < 4; ++m) _Pragma("unroll") for (int n = 0; n < 2; ++n) _Pragma("unroll") for (int k = 0; k < 2; ++k) \
        acc[ai][bj][m][n] = __builtin_amdgcn_mfma_f32_16x16x32_bf16(Bt[n][k], At[m][k], acc[ai][bj][m][n], 0, 0, 0); __builtin_amdgcn_s_setprio(0); } while (0)
#define PG8_WAIT_V(n) asm volatile("s_waitcnt vmcnt(" #n ")" ::: "memory")
#define PG8_WAIT_L(n) asm volatile("s_waitcnt lgkmcnt(" #n ")" ::: "memory")
#define PG8_BAR __builtin_amdgcn_s_barrier()
#define PG8_SCHED __builtin_amdgcn_sched_barrier(0)
    Unit cur, nxt; int ui = 0;
    if (!S.next(0, cur)) return;
    f32x4 acc[2][2][4][2];
#pragma unroll
    for (int a = 0; a < 2; ++a)
#pragma unroll
        for (int b = 0; b < 2; ++b)
#pragma unroll
            for (int m = 0; m < 4; ++m)
#pragma unroll
                for (int n = 0; n < 2; ++n) acc[a][b][m][n] = (f32x4){0.f, 0.f, 0.f, 0.f};
    bf16x8 At[4][2], B0[2][2], B1[2][2];
    const char* cA = (const char*)g.A + (size_t)cur.pm * tstep; const char* cB = (const char*)g.Bt + (size_t)cur.pn * tstep;
    S.a_ready(cur);
    if constexpr (SP2) {
        PG8_STAGE(PG8_SB(0, 0), cB, voffB); PG8_STAGE(PG8_SB(0, 1), cB + hstep, voffB); PG8_STAGE(PG8_SA(0, 0), cA, voffA); PG8_STAGE(PG8_SA(0, 1), cA + hstep, voffA);
        if (wr == 1) PG8_BAR;
        PG8_WAIT_V(2); PG8_BAR;
        PG8_STAGE(PG8_SB(1, 0), cB + kstep, voffB); PG8_STAGE(PG8_SA(1, 0), cA + kstep, voffA); PG8_STAGE(PG8_SB(1, 1), cB + hstep + kstep, voffB);
        PG8_WAIT_V(6); PG8_BAR;
    } else {
        PG8_STAGE(PG8_SB(0, 0), cB, voffB); PG8_STAGE(PG8_SA(0, 0), cA, voffA); PG8_STAGE(PG8_SB(0, 1), cB + hstep, voffB); PG8_STAGE(PG8_SA(0, 1), cA + hstep, voffA);
        if (wr == 1) PG8_BAR;
        PG8_WAIT_V(4); PG8_BAR;
        PG8_STAGE(PG8_SB(1, 0), cB + kstep, voffB); PG8_STAGE(PG8_SA(1, 0), cA + kstep, voffA); PG8_STAGE(PG8_SB(1, 1), cB + hstep + kstep, voffB);
        PG8_WAIT_V(6); PG8_BAR;
    }
    for (;;) {
        const bool has_next = S.next(ui + 1, nxt);
        const char* nA = has_next ? (const char*)g.A + (size_t)nxt.pm * tstep : cA; const char* nB = has_next ? (const char*)g.Bt + (size_t)nxt.pn * tstep : cB;
        for (int t = 0; t < nt; t += 2) {
            const bool last = (t == nt - 2);
            const char* a1 = cA + (size_t)(t + 1) * kstep;
            const char* a2 = last ? nA : cA + (size_t)(t + 2) * kstep; const char* b2 = last ? nB : cB + (size_t)(t + 2) * kstep;
            const char* a3 = a2 + kstep; const char* b3 = b2 + kstep;
            if (last && has_next) S.a_ready(nxt);
            if constexpr (SP2) {
            PG8_LDB(B0, 0, 0); PG8_LDB(B1, 0, 1); PG8_SCHED; PG8_LDA(At, 0, 0); PG8_STAGE(PG8_SA(1, 1), a1 + hstep, voffA);
            PG8_WAIT_V(8); PG8_WAIT_L(0); PG8_BAR; PG8_MMA(0, 0, At, B0); PG8_MMA(0, 1, At, B1); PG8_BAR; PG8_SCHED;
            PG8_LDA(At, 0, 1); PG8_STAGE(PG8_SB(0, 0), b2, voffB); PG8_STAGE(PG8_SB(0, 1), b2 + hstep, voffB); PG8_STAGE(PG8_SA(0, 0), a2, voffA);
            PG8_WAIT_V(8); PG8_WAIT_L(0); PG8_BAR; PG8_MMA(1, 0, At, B0); PG8_MMA(1, 1, At, B1); PG8_BAR; PG8_SCHED;
            PG8_LDB(B0, 1, 0); PG8_LDB(B1, 1, 1); PG8_SCHED; PG8_LDA(At, 1, 0); PG8_STAGE(PG8_SA(0, 1), a2 + hstep, voffA);
            PG8_WAIT_V(8); PG8_WAIT_L(0); PG8_BAR; PG8_MMA(0, 0, At, B0); PG8_MMA(0, 1, At, B1); PG8_BAR; PG8_SCHED;
            PG8_LDA(At, 1, 1); PG8_STAGE(PG8_SB(1, 0), b3, voffB); PG8_STAGE(PG8_SB(1, 1), b3 + hstep, voffB); PG8_STAGE(PG8_SA(1, 0), a3, voffA);
            PG8_WAIT_V(8); PG8_WAIT_L(0); PG8_BAR; PG8_MMA(1, 0, At, B0); PG8_MMA(1, 1, At, B1); PG8_BAR; PG8_SCHED;
            } else {
            PG8_LDB(B0, 0, 0); PG8_SCHED; PG8_LDA(At, 0, 0); PG8_STAGE(PG8_SA(1, 1), a1 + hstep, voffA);
            PG8_WAIT_L(8); PG8_BAR; PG8_WAIT_L(0); PG8_MMA(0, 0, At, B0); PG8_BAR; PG8_SCHED;
            PG8_LDB(B1, 0, 1); PG8_STAGE(PG8_SB(0, 0), b2, voffB);
            PG8_BAR; PG8_WAIT_L(0); PG8_MMA(0, 1, At, B1); PG8_BAR;
            PG8_LDA(At, 0, 1); PG8_STAGE(PG8_SA(0, 0), a2, voffA);
            PG8_BAR; PG8_WAIT_L(0); PG8_MMA(1, 0, At, B0); PG8_BAR; PG8_SCHED;
            PG8_STAGE(PG8_SB(0, 1), b2 + hstep, voffB);
            PG8_WAIT_V(6); PG8_BAR; PG8_MMA(1, 1, At, B1); PG8_BAR;
            PG8_LDB(B0, 1, 0); PG8_SCHED; PG8_LDA(At, 1, 0); PG8_STAGE(PG8_SA(0, 1), a2 + hstep, voffA);
            PG8_WAIT_L(8); PG8_BAR; PG8_WAIT_L(0); PG8_MMA(0, 0, At, B0); PG8_BAR; PG8_SCHED;
            PG8_LDB(B1, 1, 1); PG8_STAGE(PG8_SB(1, 0), b3, voffB);
            PG8_BAR; PG8_WAIT_L(0); PG8_MMA(0, 1, At, B1); PG8_BAR;
            PG8_LDA(At, 1, 1); PG8_STAGE(PG8_SA(1, 0), a3, voffA);
            PG8_BAR; PG8_WAIT_L(0); PG8_MMA(1, 0, At, B0); PG8_BAR; PG8_SCHED;
            PG8_STAGE(PG8_SB(1, 1), b3 + hstep, voffB);
            PG8_WAIT_V(6); PG8_BAR; PG8_MMA(1, 1, At, B1); PG8_BAR;
            }
        }
        if constexpr (ALIGN_EPI) { if (wr == 0) PG8_BAR; }
        if constexpr (!Epi::AFTER_DRAIN) { E(acc, cur, wr, wc, fr, fq); S.done(cur); }
        if (!has_next) break;
#pragma unroll
        for (int a = 0; a < 2; ++a)
#pragma unroll
            for (int b = 0; b < 2; ++b)
#pragma unroll
                for (int m = 0; m < 4; ++m)
#pragma unroll
                    for (int n = 0; n < 2; ++n) acc[a][b][m][n] = (f32x4){0.f, 0.f, 0.f, 0.f};
        cur = nxt; cA = nA; cB = nB; ++ui;
        if constexpr (ALIGN_EPI) { if (wr == 1) PG8_BAR; }
    }
    PG8_WAIT_V(0);
    if constexpr (!ALIGN_EPI) { if (wr == 0) PG8_BAR; }
    PG8_BAR;
    if constexpr (Epi::AFTER_DRAIN) { E.fused(acc, cur, wr, wc, fr, fq, lds, wid, lane); S.done(cur); }
#undef PG8_SA
#undef PG8_SB
#undef PG8_STAGE
#undef PG8_LDA
#undef PG8_LDB
#undef PG8_MMA
#undef PG8_WAIT_V
#undef PG8_WAIT_L
#undef PG8_BAR
#undef PG8_SCHED
}
}

#define LAS __attribute__((address_space(3)))
typedef unsigned short bf16;
typedef unsigned v4u __attribute__((ext_vector_type(4)));
typedef unsigned v2u __attribute__((ext_vector_type(2)));
typedef float f32x4 __attribute__((ext_vector_type(4)));
typedef float f32x2 __attribute__((ext_vector_type(2)));
typedef float f32x16 __attribute__((ext_vector_type(16)));
typedef short bf16x8 __attribute__((ext_vector_type(8)));
#define DI __device__ __forceinline__
#define MFMA32(a, b, c) __builtin_amdgcn_mfma_f32_32x32x16_bf16((a), (b), (c), 0, 0, 0)
#define MFMA16(a, b, c) __builtin_amdgcn_mfma_f32_16x16x32_bf16((a), (b), (c), 0, 0, 0)

constexpr int LDS_BYTES = 147456;
constexpr int NTOK = 16384, NPT = 8192, DM = 1024, DIN = 8192;
constexpr size_t MiB = 1u << 20;
constexpr size_t WS_BAR = 65536;
constexpr size_t WS_LAM = 4096;
constexpr size_t WS_MOD = 1 * MiB;
constexpr size_t WS_ROPE = 1 * MiB + 256 * 1024;
constexpr size_t WS_POOLT = 1 * MiB + 768 * 1024;
constexpr size_t WS_WINT = 2 * MiB;
constexpr size_t WS_WOT = 18 * MiB;
constexpr size_t WS_WOUT3 = 21 * MiB;
constexpr size_t WS_HRAW = 27 * MiB;
constexpr size_t WS_H = 36 * MiB;
constexpr size_t WS_YHY = 68 * MiB;
constexpr size_t WS_ATZ = 84 * MiB;
constexpr size_t WS_PLZ = 100 * MiB;
constexpr size_t WS_PLU = 116 * MiB;
constexpr size_t WS_HYT = 132 * MiB;
constexpr size_t WS_Q = 196 * MiB;
constexpr size_t WS_K = 212 * MiB;
constexpr size_t WS_VT = 230 * MiB;
constexpr size_t WS_BBUF = 148 * MiB;
constexpr size_t WS_MERGED = 116 * MiB;
constexpr size_t WS_END = 248 * MiB;

struct Params { const float* in[30]; float* out; unsigned char* ws; };

DI unsigned f2bf(float f) { unsigned u = __builtin_bit_cast(unsigned, f); return (u + 0x7fffu + ((u >> 16) & 1u)) >> 16; }
DI unsigned pk2(float lo, float hi) { return f2bf(lo) | (f2bf(hi) << 16); }
DI float bf2f(unsigned h) { return __builtin_bit_cast(float, h << 16); }
DI float bflo(unsigned w) { return __builtin_bit_cast(float, w << 16); }
DI float bfhi(unsigned w) { return __builtin_bit_cast(float, w & 0xffff0000u); }
DI float siluf(float x) { return x * __builtin_amdgcn_rcpf(1.f + __expf(-x)); }
DI float sigmf(float x) { return __builtin_amdgcn_rcpf(1.f + __expf(-x)); }
#define LDS_WAIT() asm volatile("s_waitcnt lgkmcnt(0)" ::: "memory")

#define XB_TMO      128
#define XB_XCNT(j)  (256  + 64 * (j))
#define XB_XSUB(j)  (1280 + 64 * (j))
#define XB_XGEN(j)  (2304 + 64 * (j))
#define XB_TOP      3328
#define XB_TOPGEN   3392
#define XCD_BAR_WORDS 3456
#define XB_SPIN_CAP (1u << 18)

__device__ __forceinline__ unsigned xb_ld(unsigned* p)              { return __hip_atomic_load(p, __ATOMIC_RELAXED, __HIP_MEMORY_SCOPE_AGENT); }
__device__ __forceinline__ unsigned xb_add(unsigned* p, unsigned v) { return __hip_atomic_fetch_add(p, v, __ATOMIC_RELAXED, __HIP_MEMORY_SCOPE_AGENT); }
__device__ __forceinline__ unsigned xb_xcc_id() { return (unsigned)__builtin_amdgcn_s_getreg((3 << 11) | 20) & 0xFu; }
#define XB_SPIN(cond, bar) do { unsigned _sp = 0; while (cond) { __builtin_amdgcn_s_sleep(1); \
    if ((++_sp & 255u) == 0u) { if (xb_ld(&(bar)[XB_TMO])) break; if (_sp > XB_SPIN_CAP) { atomicAdd(&(bar)[XB_TMO], 1u); break; } } } } while (0)

struct XcdBarrier {
    unsigned* bar; unsigned x;
    volatile LAS unsigned* st;
};

__device__ __forceinline__ XcdBarrier xcd_barrier_post(unsigned* bar, volatile LAS unsigned* st) {
    XcdBarrier b; b.bar = bar; b.x = xb_xcc_id(); b.st = st;
    if (threadIdx.x == 0) (void)xb_add(&bar[XB_XCNT(b.x)], 1u);
    return b;
}
__device__ __forceinline__ void xcd_barrier_complete(unsigned* bar, unsigned x, unsigned& nloc, unsigned& nx) {
    const unsigned G = gridDim.x * gridDim.y * gridDim.z;
    unsigned sum, cnt, mine, sp = 0u;
    for (;;) {
        sum = 0u; cnt = 0u; mine = 0u;
#pragma unroll
        for (unsigned j = 0; j < 16; ++j) { const unsigned c = xb_ld(&bar[XB_XCNT(j)]); sum += c; cnt += (c > 0u) ? 1u : 0u; mine = (j == x) ? c : mine; }
        if (sum == G) break;
        __builtin_amdgcn_s_sleep(1);
        if ((++sp & 255u) == 0u) { if (xb_ld(&bar[XB_TMO])) break; if (sp > XB_SPIN_CAP) { atomicAdd(&bar[XB_TMO], 1u); break; } }
    }
    nloc = mine > 0u ? mine : 1u; nx = cnt > 0u ? cnt : 1u;
}

__device__ __forceinline__ void xcd_barrier(const XcdBarrier& b) {
    asm volatile("s_waitcnt vmcnt(0)" ::: "memory");
    __syncthreads();
    if (threadIdx.x == 0) {
        unsigned* bar = b.bar;
        __builtin_amdgcn_s_waitcnt(0);
        unsigned nloc = b.st[0], nx = b.st[1];
        if (nloc == 0u) { xcd_barrier_complete(bar, b.x, nloc, nx); b.st[0] = nloc; b.st[1] = nx; }
        const unsigned old = xb_add(&bar[XB_XSUB(b.x)], 1u);
        const unsigned gen = old / nloc;
        if (old + 1u == (gen + 1u) * nloc) {
            __builtin_amdgcn_fence(__ATOMIC_RELEASE, "agent");
            asm volatile("s_waitcnt vmcnt(0)" ::: "memory");
            const unsigned og = xb_add(&bar[XB_TOP], 1u);
            const unsigned tg = og / nx;
            if (og + 1u == (tg + 1u) * nx) xb_add(&bar[XB_TOPGEN], 1u);
            else XB_SPIN(xb_ld(&bar[XB_TOPGEN]) == tg, bar);
            __builtin_amdgcn_fence(__ATOMIC_ACQUIRE, "agent");
            xb_add(&bar[XB_XGEN(b.x)], 1u);
            asm volatile("s_waitcnt vmcnt(0)" ::: "memory");
        } else {
            XB_SPIN(xb_ld(&bar[XB_XGEN(b.x)]) == gen, bar);
            __builtin_amdgcn_fence(__ATOMIC_ACQUIRE, "agent");
            asm volatile("s_waitcnt vmcnt(0)" ::: "memory");
        }
    }
    __syncthreads();
}

DI void tr_item(const float* src, size_t lds_, bf16* dst, size_t ldd, LAS float* scr, int lane) {
    float tv[32];
#pragma unroll
    for (int i = 0; i < 32; ++i) { const int kk = 2 * i + (lane >> 5); tv[i] = src[(size_t)kk * lds_ + (lane & 31)]; }
#pragma unroll
    for (int i = 0; i < 32; ++i) { const int kk = 2 * i + (lane >> 5); scr[kk * 33 + (lane & 31)] = tv[i]; }
    LDS_WAIT(); asm volatile("" ::: "memory");
    const int c = lane & 7;
#pragma unroll
    for (int j = 0; j < 4; ++j) { const int n = (lane >> 3) + 8 * j; const LAS float* s = scr + (8 * c) * 33 + n;
        v4u o; o.x = pk2(s[0 * 33], s[1 * 33]); o.y = pk2(s[2 * 33], s[3 * 33]); o.z = pk2(s[4 * 33], s[5 * 33]); o.w = pk2(s[6 * 33], s[7 * 33]);
        *(v4u*)(dst + (size_t)n * ldd + 8 * c) = o; }
    LDS_WAIT(); asm volatile("" ::: "memory");
}

DI void hraw_item(const Params& P, LAS unsigned char* lds, int l, int stream, int t0, int tid);
DI void phase_a(const Params& P, LAS unsigned char* lds, int tid, int bid, int G) {
    const float* c = P.in[4]; const float* cctx = P.in[5]; const float* w_ada = P.in[7]; const float* b_ada = P.in[8];
    float* mod = (float*)(P.ws + WS_MOD);
    LAS float* sc = (LAS float*)lds; LAS float* red = sc + 5 * 1024;
    for (int it = bid; it < 192; it += G) {
        const int l = it / 96, n0 = (it % 96) * 32;
        for (int idx = tid; idx < 5 * 1024; idx += 512) { const int r = idx >> 10, k = idx & 1023; const float cv = r == 0 ? cctx[k] : c[(r - 1) * 1024 + k]; sc[idx] = cv / (1.f + __expf(-cv)); }
        __syncthreads();
        const int cq = tid & 7, kg = tid >> 3; f32x4 acc[5]; f32x4 w[16];
#pragma unroll
        for (int r = 0; r < 5; ++r) acc[r] = (f32x4){0.f, 0.f, 0.f, 0.f};
#pragma unroll
        for (int kk = 0; kk < 16; ++kk) w[kk] = *(const f32x4*)(w_ada + ((size_t)l * 1024 + kg * 16 + kk) * 3072 + n0 + 4 * cq);
#pragma unroll
        for (int kk = 0; kk < 16; ++kk)
#pragma unroll
            for (int r = 0; r < 5; ++r) acc[r] += sc[r * 1024 + kg * 16 + kk] * w[kk];
#pragma unroll
        for (int r = 0; r < 5; ++r) *(LAS f32x4*)(red + (kg * 5 + r) * 32 + 4 * cq) = acc[r];
        __syncthreads();
        if (tid < 160) { const int r = tid >> 5, col = tid & 31; float s = b_ada[l * 3072 + n0 + col];
            for (int g = 0; g < 64; ++g) s += red[(g * 5 + r) * 32 + col];
            mod[(l * 5 + r) * 3072 + n0 + col] = s; }
        __syncthreads();
    }
    if (bid == 0 && tid < 2) {
        const int l = tid; const float* lq = P.in[21] + l * 128; const float* lk = P.in[22] + l * 128; float s0 = 0.f, s1 = 0.f;
        for (int i = 0; i < 64; ++i) { s0 += lq[i] * lk[i]; s1 += lq[64 + i] * lk[64 + i]; }
        const float lam_init = 0.8f - 0.6f * expf(-0.3f * (float)l);
        ((float*)(P.ws + WS_LAM))[l] = expf(s0) - expf(s1) + lam_init;
    }
}

DI void hraw_item(const Params& P, LAS unsigned char* lds, int l, int stream, int t0, int tid) {
    const int L = stream ? 2048 : 256;
    const float* w1 = P.in[12] + l * 33 * 64; const float* b1 = P.in[13] + l * 64; const float* w2 = P.in[14] + l * 64 * 64; const float* b2 = P.in[15] + l * 64;
    const float* w3 = P.in[16] + (size_t)l * 64 * 2048; const float* fq = P.in[17] + l * 128;
    bf16* out = (bf16*)(P.ws + WS_HRAW) + (stream ? 0 : (size_t)2 * 512 * 2 * 2048);
    LAS float* z = (LAS float*)lds; LAS float* h1 = z + 8 * 33 + 8; LAS float* h2 = h1 + 512; LAS float* w1s = h2 + 512; LAS float* w2s = w1s + 33 * 64;
    { const f32x4 a0 = *(const f32x4*)(w2 + 4 * tid), a1 = *(const f32x4*)(w2 + 2048 + 4 * tid);
      f32x4 b0 = (f32x4){0.f, 0.f, 0.f, 0.f}; const f32x4* w1v = (const f32x4*)w1; b0 = w1v[tid < 528 ? tid : 0]; f32x4 b1 = w1v[tid + 512 < 528 ? tid + 512 : 0];
      *(LAS f32x4*)(w2s + 4 * tid) = a0; *(LAS f32x4*)(w2s + 2048 + 4 * tid) = a1;
      *(LAS f32x4*)(w1s + 4 * tid) = b0; if (tid + 512 < 528) *(LAS f32x4*)(w1s + 4 * (tid + 512)) = b1; }
    if (tid < 8 * 33) { const int pos = tid / 33, j = tid % 33; const int t = t0 + pos; float v;
        if (j == 0) v = (float)t / (float)(L - 1);
        else { const int b = (j - 1) & 15; const float f = 1e-4f + (float)b * ((15.f - 1e-4f) / 15.f); const float w = 6.283185307179586f * (float)t / (float)L;
               v = (j <= 16) ? cosf(f * w) : -sinf(f * w); }
        z[pos * 33 + j] = v; }
    __syncthreads();
    { const int pos = tid >> 6, n = tid & 63; float a = b1[n];
#pragma unroll
      for (int j = 0; j < 33; ++j) a += z[pos * 33 + j] * w1s[j * 64 + n];
      h1[pos * 64 + n] = sinf(fq[n] * a); }
    __syncthreads();
    { const int pos = tid >> 6, n = tid & 63; float a = b2[n];
#pragma unroll 16
      for (int j = 0; j < 64; ++j) a += h1[pos * 64 + j] * w2s[j * 64 + n];
      h2[pos * 64 + n] = sinf(fq[64 + n] * a); }
    __syncthreads();
    { f32x4 acc[8];
#pragma unroll
      for (int p = 0; p < 8; ++p) acc[p] = (f32x4){0.f, 0.f, 0.f, 0.f};
#pragma unroll 1
      for (int k0 = 0; k0 < 64; k0 += 4) { f32x4 w[4];
#pragma unroll
          for (int kk = 0; kk < 4; ++kk) w[kk] = *(const f32x4*)(w3 + (size_t)(k0 + kk) * 2048 + 4 * tid);
#pragma unroll
          for (int p = 0; p < 8; ++p) { const f32x4 ha = *(const LAS f32x4*)(h2 + p * 64 + k0);
              acc[p] += ha[0] * w[0] + ha[1] * w[1] + ha[2] * w[2] + ha[3] * w[3]; } }
      const int n0 = 4 * tid, dir = n0 >> 10, o = (n0 >> 9) & 1;
#pragma unroll
      for (int e = 0; e < 4; ++e) { const int cc = (n0 & 511) + e; const float delta = 3.0701134573253944f + (float)cc * (12.280453829301578f / 511.f); float v[8];
#pragma unroll
          for (int p = 0; p < 8; ++p) { const float tn = (float)(t0 + p) / (float)(L - 1); v[p] = acc[p][e] * __expf(-tn * delta); }
          v4u w; w.x = pk2(v[0], v[1]); w.y = pk2(v[2], v[3]); w.z = pk2(v[4], v[5]); w.w = pk2(v[6], v[7]);
          *(v4u*)(out + ((size_t)((o * 512 + cc) * 2 + dir)) * L + t0) = w; } }
    __syncthreads();
}

DI void phase_p0(const Params& P, LAS unsigned char* lds, int l, const float* xsrcP, const float* xsrcS, int tid, int lane, int wave, int bid, int G) {
    const int gw = bid * 8 + wave, NGW = G * 8;
    LAS float* scr = (LAS float*)(lds + wave * 16384);
    bf16* WinT = (bf16*)(P.ws + WS_WINT); bf16* WoT = (bf16*)(P.ws + WS_WOT); bf16* Wout3 = (bf16*)(P.ws + WS_WOUT3); bf16* poolT = (bf16*)(P.ws + WS_POOLT);
    const float* w_in = P.in[9] + (size_t)l * 1024 * 8192;
    constexpr int I_IN = 16 * 256, I_O = 3 * 256, I_OUT = 512, I_PL = 32, I_CV = 512;
    constexpr int NIT = I_IN + I_O + I_OUT + I_PL + I_CV;
    for (int it = gw; it < NIT; it += NGW) {
        int r = it; const float* src; size_t sld; bf16* dst; size_t dld;
        if (r < I_IN) { const int kb = r >> 8, nb = r & 255, n0 = nb * 32; int drow = n0;
            if (n0 >= 2048 && n0 < 3072) { const int tb = n0 & ~255, lb = (n0 >> 5) & 7; drow = tb + 128 * (lb & 1) + 32 * (lb >> 1); }
            src = w_in + (size_t)(64 * kb) * 8192 + n0; sld = 8192; dst = WinT + (size_t)drow * 1024 + 64 * kb; dld = 1024; }
        else if ((r -= I_IN) < I_O) { const int j = r >> 8, q = r & 255, kb = q >> 5, nb = q & 31; const float* W = (j == 0 ? P.in[26] : j == 1 ? P.in[27] : P.in[28]) + (size_t)l * 512 * 1024;
            src = W + (size_t)(64 * kb) * 1024 + 32 * nb; sld = 1024; dst = WoT + (size_t)(j * 1024 + 32 * nb) * 512 + 64 * kb; dld = 512; }
        else if ((r -= I_O) < I_OUT) { const int kb = r >> 5, nb = r & 31; const float* W = P.in[29] + (size_t)l * 1024 * 1024;
            src = W + (size_t)(64 * kb) * 1024 + 32 * nb; sld = 1024; dst = Wout3 + (size_t)(32 * nb) * 1024 + 64 * kb; dld = 1024; }
        else if ((r -= I_OUT) < I_PL) { const int g = r >> 3, q = r & 7, kb = q >> 2, nb = q & 3; const float* W = P.in[24] + (size_t)(l * 4 + g) * 16384;
            src = W + (size_t)(64 * kb) * 128 + 32 * nb; sld = 128; dst = poolT + (size_t)g * 16384 + (size_t)(32 * nb) * 128 + 64 * kb; dld = 128; }
        else { r -= I_PL; const int b = r >> 7, q = r & 127, h = q >> 5, q2 = q & 31, kb = q2 >> 2, nb = q2 & 3;
            src = P.in[3] + ((size_t)(b * 2 + l) * 512 + 64 * kb) * 512 + h * 128 + 32 * nb; sld = 512;
            dst = (bf16*)(P.ws + WS_VT + 8 * MiB) + ((size_t)(b * 4 + h) * 128 + 32 * nb) * 2560 + 2048 + 64 * kb; dld = 2560; }
        tr_item(src, sld, dst, dld, scr, lane);
    }
    __syncthreads();
    { bf16* kS = (bf16*)(P.ws + WS_K + 8 * MiB);
      for (int idx = bid * 512 + tid; idx < 4 * 512 * 4 * 2 * 16; idx += G * 512) {
          const int d4 = idx & 15, map = (idx >> 4) & 1, h = (idx >> 5) & 3, p = (idx >> 7) & 511, b = idx >> 16;
          const f32x4 v = *(const f32x4*)(P.in[2] + ((((size_t)(b * 2 + l) * 512 + p) * 4 + h) * 2 + map) * 64 + d4 * 4);
          v2u w; w.x = pk2(v.x, v.y); w.y = pk2(v.z, v.w);
          *(v2u*)(kS + (((size_t)(b * 4 + h) * 2 + map) * 2560 + 2048 + p) * 64 + d4 * 4) = w; } }
    { const float* g = P.in[6] + l * 1024; const float* mod = (const float*)(P.ws + WS_MOD) + l * 5 * 3072; bf16* H = (bf16*)(P.ws + WS_H);
      f32x4 gg[4];
#pragma unroll
      for (int j = 0; j < 4; ++j) gg[j] = *(const f32x4*)(g + 4 * lane + 256 * j);
      const int HB = G >= 256 ? G - 32 : G; const int NGWH = HB * 8;
      if (bid < HB)
      for (int m0 = gw; m0 < NTOK; m0 += 2 * NGWH) {
          f32x4 v[2][4], sh[2][4], scl[2][4]; float s[2] = {0.f, 0.f};
#pragma unroll
          for (int u = 0; u < 2; ++u) { const int m = m0 + u * NGWH < NTOK ? m0 + u * NGWH : m0; const float* xr = m < NPT ? xsrcP + (size_t)m * 1024 : xsrcS + (size_t)(m - NPT) * 1024;
              const int r = m < NPT ? 0 : 1 + ((m - NPT) >> 11); const float* md = mod + r * 3072;
#pragma unroll
              for (int j = 0; j < 4; ++j) { const int c0 = 4 * lane + 256 * j; v[u][j] = *(const f32x4*)(xr + c0); sh[u][j] = *(const f32x4*)(md + c0); scl[u][j] = *(const f32x4*)(md + 1024 + c0); } }
#pragma unroll
          for (int u = 0; u < 2; ++u) { const int m = m0 + u * NGWH; if (m < NTOK) {
#pragma unroll
              for (int j = 0; j < 4; ++j) s[u] += (v[u][j].x * v[u][j].x + v[u][j].y * v[u][j].y) + (v[u][j].z * v[u][j].z + v[u][j].w * v[u][j].w);
#pragma unroll
              for (int o = 1; o < 64; o <<= 1) s[u] += __shfl_xor(s[u], o);
              const float rstd = rsqrtf(s[u] * (1.f / 1024.f) + 1e-6f);
#pragma unroll
              for (int j = 0; j < 4; ++j) { const int c0 = 4 * lane + 256 * j;
                  const f32x4 o = v[u][j] * rstd * gg[j] * (scl[u][j] + 1.f) + sh[u][j]; v2u w; w.x = pk2(o.x, o.y); w.y = pk2(o.z, o.w);
                  *(v2u*)(H + (size_t)m * 1024 + c0) = w; } } }
      } }
    for (int n = 0; ; ++n) {
        int item;
        if (G >= 256) { if (n >= 2) break; item = n == 0 ? (bid < 256 ? bid : -1) : (bid >= G - 32 ? 256 + bid - (G - 32) : -1); }
        else { item = bid + n * G; if (item >= 288) break; }
        if (item < 0) continue;
        const int stream = item < 256 ? 1 : 0; const int t0 = (stream ? item : item - 256) * 8; hraw_item(P, lds, l, stream, t0, tid);
    }
}

using pg8::Unit; using pg8::cvt_pk_bf16;
DI v4u pack8(f32x4 a, f32x4 b) { v4u w; w.x = cvt_pk_bf16(a[0], a[1]); w.y = cvt_pk_bf16(a[2], a[3]); w.z = cvt_pk_bf16(b[0], b[1]); w.w = cvt_pk_bf16(b[2], b[3]); return w; }
DI f32x4 silu4(f32x4 v) { return (f32x4){siluf(v[0]), siluf(v[1]), siluf(v[2]), siluf(v[3])}; }

struct EpiHyT {
    static constexpr bool PERM = true, AFTER_DRAIN = false; bf16* O;
    DI void operator()(const f32x4 (&acc)[2][2][4][2], const Unit& u, int wr, int wc, int fr, int fq) const {
        const bool act = u.pm >= 6; const int row0 = u.pm * 256 + wr * 64 + fr, col0 = u.pn * 256 + wc * 32 + 8 * fq;
#pragma unroll
        for (int ai = 0; ai < 2; ++ai)
#pragma unroll
            for (int m = 0; m < 4; ++m) { bf16* rowp = O + (size_t)(row0 + ai * 128 + m * 16) * NTOK + col0;
#pragma unroll
                for (int bj = 0; bj < 2; ++bj) { f32x4 v0 = acc[ai][bj][m][0], v1 = acc[ai][bj][m][1]; if (act) { v0 = silu4(v0); v1 = silu4(v1); }
                    *(v4u*)(rowp + bj * 128) = pack8(v0, v1); } }
    }
};

struct EpiB {
    static constexpr bool PERM = true, AFTER_DRAIN = false;
    int l; const float *gq, *gk, *ropec, *ropes; unsigned char* ws; float* newk; float* newv;
    DI void operator()(const f32x4 (&acc)[2][2][4][2], const Unit& u, int wr, int wc, int fr, int fq) const {
        const int pn = u.pn; const bool isS = u.pm >= 32;
        const int tok0 = u.pm * 256 + wr * 64 + fr;
        if (pn < 4) {
            const bool isk = pn >= 2; const int hd = 2 * (pn & 1) + (wc >> 1), map = wc & 1; const float* g = isk ? gk : gq;
            f32x4 gv[2][2];
#pragma unroll
            for (int bj = 0; bj < 2; ++bj)
#pragma unroll
                for (int n = 0; n < 2; ++n) gv[bj][n] = *(const f32x4*)(g + 32 * bj + 8 * fq + 4 * n);
            bf16* base = (bf16*)(ws + (isk ? WS_K : WS_Q) + (isS ? 8 * MiB : 0)); const int Lb = isS ? (isk ? 2560 : 2048) : 256;
            float invv[2][2];
#pragma unroll
            for (int n = 0; n < 2; ++n)
#pragma unroll
                for (int p = 0; p < 2; ++p) invv[n][p] = __expf(-(float)(4 * fq + 2 * n + p) * (9.210340371976184f / 16.f));
#pragma unroll
            for (int ai = 0; ai < 2; ++ai)
#pragma unroll
                for (int m = 0; m < 4; ++m) {
                    const int tok = tok0 + ai * 128 + m * 16; int b, t; if (isS) { const int tt = tok - NPT; b = tt >> 11; t = tt & 2047; } else { b = tok >> 8; t = tok & 255; }
                    float ss = 0.f; f32x4 v[2][2];
#pragma unroll
                    for (int bj = 0; bj < 2; ++bj)
#pragma unroll
                        for (int n = 0; n < 2; ++n) { const f32x4 x = acc[ai][bj][m][n]; ss += (x[0] * x[0] + x[1] * x[1]) + (x[2] * x[2] + x[3] * x[3]); }
                    ss += __shfl_xor(ss, 16); ss += __shfl_xor(ss, 32);
                    const float rstd = rsqrtf(ss * (1.f / 64.f) + 1e-6f);
#pragma unroll
                    for (int bj = 0; bj < 2; ++bj)
#pragma unroll
                        for (int n = 0; n < 2; ++n) v[bj][n] = acc[ai][bj][m][n] * rstd * gv[bj][n];
                    if (isk && !isS) { float* nk = newk + ((size_t)(b * 2 + l) * 256 + t) * 512 + hd * 128 + map * 64 + 8 * fq;
#pragma unroll
                        for (int bj = 0; bj < 2; ++bj)
#pragma unroll
                            for (int n = 0; n < 2; ++n) *(f32x4*)(nk + 32 * bj + 4 * n) = v[bj][n]; }
                    if (isS) {
                        int tl = t; asm volatile("" : "+v"(tl)); const float rowf = (float)(tl >> 6), colf = (float)(tl & 63);
#pragma unroll
                        for (int bj = 0; bj < 2; ++bj)
#pragma unroll
                            for (int n = 0; n < 2; ++n) { const float base = bj == 0 ? rowf : colf; const float a0 = base * invv[n][0], a1 = base * invv[n][1];
                                const float r0 = a0 * 0.15915494309189535f, r1 = a1 * 0.15915494309189535f; const float c0 = __builtin_amdgcn_cosf(r0), s0 = __builtin_amdgcn_sinf(r0), c1 = __builtin_amdgcn_cosf(r1), s1 = __builtin_amdgcn_sinf(r1);
                                const f32x4 x = v[bj][n]; v[bj][n] = (f32x4){x[0] * c0 - x[1] * s0, x[0] * s0 + x[1] * c0, x[2] * c1 - x[3] * s1, x[2] * s1 + x[3] * c1}; }
                    }
                    if (!isk) {
#pragma unroll
                        for (int bj = 0; bj < 2; ++bj)
#pragma unroll
                            for (int n = 0; n < 2; ++n) v[bj][n] = v[bj][n] * 0.18033688011112042f;
                    }
                    bf16* dp = base + ((size_t)((b * 4 + hd) * 2 + map) * Lb + t) * 64 + 8 * fq;
#pragma unroll
                    for (int bj = 0; bj < 2; ++bj) *(v4u*)(dp + 32 * bj) = pack8(v[bj][0], v[bj][1]);
                }
        } else if (pn < 6) {
            bf16* vt = (bf16*)(ws + WS_VT + (isS ? 8 * MiB : 0)); const int Lk = isS ? 2560 : 256;
#pragma unroll
            for (int ai = 0; ai < 2; ++ai)
#pragma unroll
                for (int m = 0; m < 4; ++m) {
                    const int tok = tok0 + ai * 128 + m * 16; int b, t; if (isS) { const int tt = tok - NPT; b = tt >> 11; t = tt & 2047; } else { b = tok >> 8; t = tok & 255; }
#pragma unroll
                    for (int bj = 0; bj < 2; ++bj) { const int hd = 2 * (pn - 4) + bj;
#pragma unroll
                        for (int n = 0; n < 2; ++n) { const int dv = 32 * wc + 8 * fq + 4 * n; const f32x4 x = acc[ai][bj][m][n];
                            if (!isS) *(f32x4*)(newv + ((size_t)(b * 2 + l) * 256 + t) * 512 + hd * 128 + dv) = x;
                            bf16* vp = vt + ((size_t)(b * 4 + hd) * 128 + dv) * Lk + t;
#pragma unroll
                            for (int e = 0; e < 4; ++e) vp[(size_t)e * Lk] = (bf16)f2bf(x[e]); } }
                }
        } else {
            const int which = (pn - 6) >> 1; bf16* dst = (bf16*)(ws + (which == 0 ? WS_ATZ : which == 1 ? WS_PLU : WS_PLZ)); const bool act = which != 1;
            const int col0 = 256 * ((pn - 6) & 1) + 32 * wc + 8 * fq;
#pragma unroll
            for (int ai = 0; ai < 2; ++ai)
#pragma unroll
                for (int m = 0; m < 4; ++m) { bf16* rowp = dst + (size_t)(tok0 + ai * 128 + m * 16) * 512 + col0;
#pragma unroll
                    for (int bj = 0; bj < 2; ++bj) { f32x4 v0 = acc[ai][bj][m][0], v1 = acc[ai][bj][m][1]; if (act) { v0 = silu4(v0); v1 = silu4(v1); }
                        *(v4u*)(rowp + bj * 128) = pack8(v0, v1); } }
        }
    }
};

struct BrOrder {
    int G, c;
    DI bool next(int i, Unit& u) const { const int L = i * G + c; if (L >= 768) return false; const int j = L >> 8, r0 = L & 255;
        int tm, tn; if (G == 256) { tm = 8 * (r0 & 7) + ((r0 >> 3) & 7); tn = r0 >> 6; } else { const int r = (r0 & 7) * 32 + (r0 >> 3); tm = r >> 2; tn = r & 3; }
        u.pm = j * 64 + tm; u.pn = j * 4 + tn; return true; }
    DI void a_ready(const Unit&) const {}
    DI void done(const Unit&) const {}
};
struct EpiBr {
    static constexpr bool PERM = true, AFTER_DRAIN = false; bf16* O;
    DI void operator()(const f32x4 (&acc)[2][2][4][2], const Unit& u, int wr, int wc, int fr, int fq) const {
        const int row0 = (u.pm & 63) * 256 + wr * 64 + fr, col0 = u.pn * 256 + wc * 32 + 8 * fq;
#pragma unroll
        for (int ai = 0; ai < 2; ++ai)
#pragma unroll
            for (int m = 0; m < 4; ++m) { bf16* rowp = O + (size_t)(row0 + ai * 128 + m * 16) * 3072 + col0;
#pragma unroll
                for (int bj = 0; bj < 2; ++bj) *(v4u*)(rowp + bj * 128) = pack8(acc[ai][bj][m][0], acc[ai][bj][m][1]); }
    }
};
struct EpiGate {
    static constexpr bool PERM = true, AFTER_DRAIN = false; const bf16* B; bf16* M;
    DI void operator()(const f32x4 (&acc)[2][2][4][2], const Unit& u, int wr, int wc, int fr, int fq) const {
        const int j = u.pn >> 2; const int row0 = u.pm * 256 + wr * 64 + fr, col0 = u.pn * 256 + wc * 32 + 8 * fq, mc0 = (u.pn & 3) * 256 + wc * 32 + 8 * fq;
        const bf16* bb = B + (size_t)row0 * 3072 + col0; bf16* mb = M + (size_t)row0 * 1024 + mc0;
#pragma unroll
        for (int ai = 0; ai < 2; ++ai) {
            v4u bv[4][2], mv[4][2];
#pragma unroll
            for (int m = 0; m < 4; ++m)
#pragma unroll
                for (int bj = 0; bj < 2; ++bj) { bv[m][bj] = *(const v4u*)(bb + (size_t)(ai * 128 + m * 16) * 3072 + bj * 128);
                    if (j > 0) { const unsigned long long* mq = (const unsigned long long*)(mb + (size_t)(ai * 128 + m * 16) * 1024 + bj * 128);
                        const unsigned long long q0 = __hip_atomic_load(mq, __ATOMIC_RELAXED, __HIP_MEMORY_SCOPE_AGENT), q1 = __hip_atomic_load(mq + 1, __ATOMIC_RELAXED, __HIP_MEMORY_SCOPE_AGENT);
                        mv[m][bj] = (v4u){(unsigned)q0, (unsigned)(q0 >> 32), (unsigned)q1, (unsigned)(q1 >> 32)}; }
                    else mv[m][bj] = (v4u){0u, 0u, 0u, 0u}; }
            asm volatile("s_waitcnt vmcnt(0)" ::: "memory");
#pragma unroll
            for (int m = 0; m < 4; ++m)
#pragma unroll
                for (int bj = 0; bj < 2; ++bj) { const v4u b = bv[m][bj], p = mv[m][bj]; const f32x4 g0 = acc[ai][bj][m][0], g1 = acc[ai][bj][m][1];
                    const f32x4 o0 = (f32x4){sigmf(g0[0]) * bflo(b.x) + bflo(p.x), sigmf(g0[1]) * bfhi(b.x) + bfhi(p.x), sigmf(g0[2]) * bflo(b.y) + bflo(p.y), sigmf(g0[3]) * bfhi(b.y) + bfhi(p.y)};
                    const f32x4 o1 = (f32x4){sigmf(g1[0]) * bflo(b.z) + bflo(p.z), sigmf(g1[1]) * bfhi(b.z) + bfhi(p.z), sigmf(g1[2]) * bflo(b.w) + bflo(p.w), sigmf(g1[3]) * bfhi(b.w) + bfhi(p.w)};
                    *(v4u*)(mb + (size_t)(ai * 128 + m * 16) * 1024 + bj * 128) = pack8(o0, o1); }
        }
    }
};
struct EpiOut {
    static constexpr bool PERM = true, AFTER_DRAIN = false; const float* xP; const float* xS; float* out; const float* mod;
    DI void operator()(const f32x4 (&acc)[2][2][4][2], const Unit& u, int wr, int wc, int fr, int fq) const {
        const int row0 = u.pm * 256 + wr * 64 + fr, col0 = u.pn * 256 + wc * 32 + 8 * fq;
        const int r = u.pm < 32 ? 0 : 1 + ((u.pm - 32) >> 3);
        const float* gt = mod + r * 3072 + 2048 + col0;
        f32x4 gv[2][2];
#pragma unroll
        for (int bj = 0; bj < 2; ++bj)
#pragma unroll
            for (int n = 0; n < 2; ++n) gv[bj][n] = *(const f32x4*)(gt + bj * 128 + 4 * n);
        const float* xb = (u.pm < 32 ? xP + (size_t)row0 * 1024 : xS + (size_t)(row0 - NPT) * 1024) + col0; float* ob = out + (size_t)row0 * 1024 + col0;
#pragma unroll
        for (int ai = 0; ai < 2; ++ai) {
            f32x4 xv[4][2][2];
#pragma unroll
            for (int m = 0; m < 4; ++m)
#pragma unroll
                for (int bj = 0; bj < 2; ++bj)
#pragma unroll
                    for (int n = 0; n < 2; ++n) xv[m][bj][n] = *(const f32x4*)(xb + (size_t)(ai * 128 + m * 16) * 1024 + bj * 128 + 4 * n);
            asm volatile("s_waitcnt vmcnt(0)" ::: "memory");
#pragma unroll
            for (int m = 0; m < 4; ++m)
#pragma unroll
                for (int bj = 0; bj < 2; ++bj)
#pragma unroll
                    for (int n = 0; n < 2; ++n) *(f32x4*)(ob + (size_t)(ai * 128 + m * 16) * 1024 + bj * 128 + 4 * n) = xv[m][bj][n] + gv[bj][n] * acc[ai][bj][m][n];
        }
    }
};

DI f32x4 conv4(const bf16* row, int s0, int t4, int L, float w0, float w1, float w2, float bias) {
    const bf16* p = row + s0 + t4; const v2u raw = *(const v2u*)p;
    const float x0 = bflo(raw.x), x1 = bfhi(raw.x), x2 = bflo(raw.y), x3 = bfhi(raw.y);
    const unsigned short rm = p[t4 > 0 ? -1 : 0], rp = p[(t4 + 4 < L) ? 4 : 3];
    const float xm = t4 > 0 ? bf2f(rm) : 0.f, xp = (t4 + 4 < L) ? bf2f(rp) : 0.f;
    return (f32x4){w0 * xm + w1 * x0 + w2 * x1 + bias, w0 * x0 + w1 * x1 + w2 * x2 + bias, w0 * x1 + w1 * x2 + w2 * x3 + bias, w0 * x2 + w1 * x3 + w2 * xp + bias};
}

#define LBAR() do { asm volatile("s_waitcnt lgkmcnt(0)" ::: "memory"); __builtin_amdgcn_s_barrier(); asm volatile("" ::: "memory"); } while (0)
struct Q4 { v2u raw; unsigned rm, rp; };
DI Q4 ld4(const bf16* row, int s0, int t4, int L) { const bf16* p = row + s0 + t4; Q4 q; q.raw = *(const v2u*)p; q.rm = p[t4 > 0 ? -1 : 0]; q.rp = p[(t4 + 4 < L) ? 4 : 3]; return q; }
DI f32x4 cv4(const Q4& q, int t4, int L, float w0, float w1, float w2, float bias) {
    const float x0 = bflo(q.raw.x), x1 = bfhi(q.raw.x), x2 = bflo(q.raw.y), x3 = bfhi(q.raw.y);
    const float xm = t4 > 0 ? bf2f(q.rm) : 0.f, xp = (t4 + 4 < L) ? bf2f(q.rp) : 0.f;
    return (f32x4){w0 * xm + w1 * x0 + w2 * x1 + bias, w0 * x0 + w1 * x1 + w2 * x2 + bias, w0 * x1 + w1 * x2 + w2 * x3 + bias, w0 * x2 + w1 * x3 + w2 * xp + bias};
}
DI void hyena_job(const Params& P, LAS unsigned char* lds, int l, int stream, int c, int tid, int lane, int wave) {
    const int L = stream ? 2048 : 256, Bn = stream ? 4 : 32, NB = L / 16, tokbase = stream ? NPT : 0;
    const int RCS = 2 * L + 16;
    const int RCB = 8 * RCS * 2, UN = Bn * (L + 256) + 256, UB = UN * 2;
    LAS bf16* RC = (LAS bf16*)lds; LAS bf16* U1 = (LAS bf16*)(lds + RCB); LAS bf16* U2 = (LAS bf16*)(lds + RCB + UB);
    LAS bf16* GR = (LAS bf16*)(lds + RCB + 2 * UB); LAS float* red = (LAS float*)(lds + RCB + 2 * UB + 8 * L);
    LAS bf16* GV = (LAS bf16*)(lds + RCB + 2 * UB + 8 * L + 64);
    const bf16* hyT = (const bf16*)(P.ws + WS_HYT);
    const bf16* rx1 = hyT + (size_t)c * NTOK; const bf16* rx2 = hyT + (size_t)(512 + c) * NTOK; const bf16* rv = hyT + (size_t)(1024 + c) * NTOK; const bf16* rz = hyT + (size_t)(1536 + c) * NTOK;
    const float* cw = P.in[10] + l * 3 * 1536; const float* cb = P.in[11] + l * 1536;
    const bf16* hraw = (const bf16*)(P.ws + WS_HRAW) + (stream ? 0 : (size_t)2 * 512 * 2 * 2048);
    const int a = lane & 15, g = lane >> 4, gb = g & 1, gh = g >> 1;
    const int kap = (16 - a) & 7, A8 = (a + 7) & ~7;
    const int i0 = stream ? 16 * wave : 0, b0 = stream ? 0 : 4 * wave;
    const int mlo = i0 - NB, nks = (NB + 16) / 2;
    const int t4o = 16 * (i0 + a) + 4 * g;
    v4u gr[2]; const int nvec = L / 2;
#pragma unroll
    for (int i = 0; i < 2; ++i) { const int idx = tid + 512 * i; const int e8 = (idx < nvec ? idx : 0) * 8; const int o = e8 / (2 * L), rem = e8 - o * 2 * L;
        gr[i] = *(const v4u*)(hraw + (size_t)((o * 512 + c) * 2) * L + rem); }
    Q4 qv[4], q1[4], q2[4]; v2u qz[4];
#pragma unroll
    for (int i = 0; i < 4; ++i) { const int q = tid + 512 * i; const int b = q / (L / 4), t4 = (q % (L / 4)) * 4; qv[i] = ld4(rv, tokbase + b * L, t4, L); }
#pragma unroll
    for (int b = 0; b < 4; ++b) { const int s0 = tokbase + (b0 + b) * L; q1[b] = ld4(rx1, s0, t4o, L); q2[b] = ld4(rx2, s0, t4o, L); qz[b] = *(const v2u*)(rz + s0 + t4o); }
    for (int i = tid; i < (2 * UB) / 16; i += 512) ((LAS v4u*)U1)[i] = (v4u){0u, 0u, 0u, 0u};
    LBAR();
#pragma unroll
    for (int i = 0; i < 2; ++i) { const int idx = tid + 512 * i; if (idx < nvec) *(LAS v4u*)(GR + idx * 8) = gr[i]; }
    { const float w0 = cw[1024 + c], w1 = cw[1536 + 1024 + c], w2 = cw[3072 + 1024 + c], bb = cb[1024 + c];
#pragma unroll
      for (int i = 0; i < 4; ++i) { const int q = tid + 512 * i; const int b = q / (L / 4), t4 = (q % (L / 4)) * 4; const f32x4 v = cv4(qv[i], t4, L, w0, w1, w2, bb);
          v2u w; w.x = pk2(v[0], v[1]); w.y = pk2(v[2], v[3]); *(LAS v2u*)(U1 + 256 + b * (L + 256) + t4) = w; } }
    LBAR();
    { const int per = (2 * L) / 512;
      float s0 = 0.f, s1 = 0.f;
      for (int k = 0; k < per; ++k) { const int e = tid + 512 * k; const float v0 = fabsf(bf2f(GR[e])), v1 = fabsf(bf2f(GR[2 * L + e])); const bool ok = e != L; s0 += ok ? v0 : 0.f; s1 += ok ? v1 : 0.f; }
#pragma unroll
      for (int of = 1; of < 64; of <<= 1) { s0 += __shfl_xor(s0, of); s1 += __shfl_xor(s1, of); }
      if (lane == 0) { red[wave * 2] = s0; red[wave * 2 + 1] = s1; } }
    LBAR();
    float inv[2];
#pragma unroll
    for (int o = 0; o < 2; ++o) { float sm = 0.f;
#pragma unroll
        for (int w = 0; w < 8; ++w) sm += red[w * 2 + o];
        inv[o] = 1.f / (sm + 1e-6f); }
#pragma unroll 1
    for (int o = 0; o < 2; ++o) {
        { const LAS bf16* G0 = GR + o * 2 * L; const float sc = inv[o];
          for (int x = tid; x < 2 * L + 32; x += 512) { const int d = L - x; const bool ok = d > -L && d < L; int idx = d >= 0 ? d : L - d; idx = idx < 0 ? 0 : (idx > 2 * L - 1 ? 2 * L - 1 : idx);
              const float v = bf2f(G0[idx]) * sc; GV[x] = (bf16)f2bf(ok ? v : 0.f); } }
        LBAR();
        for (int yq = tid; yq < RCS / 4; yq += 512) { const int y = 4 * yq; const LAS v2u* gp = (const LAS v2u*)(GV + y);
            const v2u a0 = gp[0], a1 = gp[1], a2 = gp[2]; const unsigned w[6] = {a0.x, a0.y, a1.x, a1.y, a2.x, a2.y};
#pragma unroll
            for (int k = 0; k < 8; ++k) { const int jd = k >> 1; v2u o2;
                if ((k & 1) == 0) { o2.x = w[jd]; o2.y = w[jd + 1]; }
                else { o2.x = __builtin_amdgcn_alignbit(w[jd + 1], w[jd], 16); o2.y = __builtin_amdgcn_alignbit(w[jd + 2], w[jd + 1], 16); }
                *(LAS v2u*)(RC + k * RCS + y) = o2; } }
        LBAR();
        LAS bf16* U = o == 0 ? U1 : U2;
        f32x4 acc[4];
#pragma unroll
        for (int b = 0; b < 4; ++b) acc[b] = (f32x4){0.f, 0.f, 0.f, 0.f};
        const LAS bf16* ap = RC + kap * RCS + L - 16 * (mlo + gh) - A8 + 8 * gb;
        const LAS bf16* bp = U + 256 + b0 * (L + 256) + 16 * (i0 + a - mlo - gh) + 8 * gb;
        bf16x8 af = *(const LAS bf16x8*)ap; bf16x8 bfr[4];
#pragma unroll
        for (int b = 0; b < 4; ++b) bfr[b] = *(const LAS bf16x8*)(bp + b * (L + 256));
#pragma unroll 4
        for (int ks = 0; ks < nks; ++ks) {
            const int kn = ks + 1 < nks ? ks + 1 : ks;
            const bf16x8 naf = *(const LAS bf16x8*)(ap - 32 * kn); bf16x8 nb[4];
#pragma unroll
            for (int b = 0; b < 4; ++b) nb[b] = *(const LAS bf16x8*)(bp - 32 * kn + b * (L + 256));
#pragma unroll
            for (int b = 0; b < 4; ++b) acc[b] = MFMA16(af, bfr[b], acc[b]);
            af = naf;
#pragma unroll
            for (int b = 0; b < 4; ++b) bfr[b] = nb[b];
        }
        const float bias = P.in[18][(l * 2 + o) * 512 + c];
        if (o == 0) {
            const float w0 = cw[c], w1 = cw[1536 + c], w2 = cw[3072 + c], bb = cb[c];
#pragma unroll
            for (int b = 0; b < 4; ++b) { const int bq = b0 + b; const f32x4 x1 = cv4(q1[b], t4o, L, w0, w1, w2, bb);
                const v2u uv = *(const LAS v2u*)(U1 + 256 + bq * (L + 256) + t4o);
                const f32x4 y = (f32x4){x1[0] * (acc[b][0] + bias * bflo(uv.x)), x1[1] * (acc[b][1] + bias * bfhi(uv.x)), x1[2] * (acc[b][2] + bias * bflo(uv.y)), x1[3] * (acc[b][3] + bias * bfhi(uv.y))};
                v2u w; w.x = pk2(y[0], y[1]); w.y = pk2(y[2], y[3]); *(LAS v2u*)(U2 + 256 + bq * (L + 256) + t4o) = w; }
        } else {
            const float w0 = cw[512 + c], w1 = cw[1536 + 512 + c], w2 = cw[3072 + 512 + c], bb = cb[512 + c];
            bf16* yh = (bf16*)(P.ws + WS_HYT) + (size_t)(1536 + c) * NTOK;
#pragma unroll
            for (int b = 0; b < 4; ++b) { const int bq = b0 + b; const int tok = tokbase + bq * L + t4o; const f32x4 x2 = cv4(q2[b], t4o, L, w0, w1, w2, bb);
                const v2u uv = *(const LAS v2u*)(U2 + 256 + bq * (L + 256) + t4o); const v2u zz = qz[b];
                const f32x4 y = (f32x4){x2[0] * (acc[b][0] + bias * bflo(uv.x)) * bflo(zz.x), x2[1] * (acc[b][1] + bias * bfhi(uv.x)) * bfhi(zz.x),
                                        x2[2] * (acc[b][2] + bias * bflo(uv.y)) * bflo(zz.y), x2[3] * (acc[b][3] + bias * bfhi(uv.y)) * bfhi(zz.y)};
                v2u w; w.x = pk2(y[0], y[1]); w.y = pk2(y[2], y[3]); *(v2u*)(yh + tok) = w; }
        }
        LBAR();
    }
    __syncthreads();
}

DI void yhy_transpose(const Params& P, LAS unsigned char* lds, int lane, int wave, int bid, int G) {
    const bf16* src0 = (const bf16*)(P.ws + WS_HYT) + (size_t)1536 * NTOK; bf16* dst0 = (bf16*)(P.ws + WS_YHY);
    LAS unsigned char* scr = lds + wave * 9216;
    for (int it = bid * 8 + wave; it < 2048; it += G * 8) {
        const int ch0 = (it >> 8) * 64, tok0 = (it & 255) * 64;
        v4u v[8];
#pragma unroll
        for (int i = 0; i < 8; ++i) { const int idx = lane + 64 * i, ch = idx >> 3, chunk = idx & 7; v[i] = *(const v4u*)(src0 + (size_t)(ch0 + ch) * NTOK + tok0 + chunk * 8); }
#pragma unroll
        for (int i = 0; i < 8; ++i) { const int idx = lane + 64 * i, ch = idx >> 3, chunk = idx & 7; *(LAS v4u*)(scr + ch * 144 + chunk * 16) = v[i]; }
        LDS_WAIT(); asm volatile("" ::: "memory");
#pragma unroll
        for (int i = 0; i < 8; ++i) { const int idx = lane + 64 * i, tok = idx >> 3, cc = idx & 7; const LAS bf16* p = (const LAS bf16*)(scr + (cc * 8) * 144) + tok;
            v4u o; o.x = (unsigned)p[0] | ((unsigned)p[72] << 16); o.y = (unsigned)p[144] | ((unsigned)p[216] << 16); o.z = (unsigned)p[288] | ((unsigned)p[360] << 16); o.w = (unsigned)p[432] | ((unsigned)p[504] << 16);
            *(v4u*)(dst0 + (size_t)(tok0 + tok) * 512 + ch0 + cc * 8) = o; }
        LDS_WAIT(); asm volatile("" ::: "memory");
    }
}

DI void merge_sum(const Params& P, int tid, int bid, int G) {
    const bf16* B = (const bf16*)(P.ws + WS_BBUF); bf16* M = (bf16*)(P.ws + WS_YHY);
    for (int idx0 = bid * 512 + tid; idx0 < NTOK * 128; idx0 += 4 * G * 512) {
        v4u a[4], b[4], c[4];
#pragma unroll
        for (int u = 0; u < 4; ++u) { const int idx = idx0 + u * G * 512 < NTOK * 128 ? idx0 + u * G * 512 : idx0; const int row = idx >> 7, c8 = (idx & 127) * 8; const bf16* p = B + (size_t)row * 3072 + c8;
            a[u] = *(const v4u*)p; b[u] = *(const v4u*)(p + 1024); c[u] = *(const v4u*)(p + 2048); }
#pragma unroll
        for (int u = 0; u < 4; ++u) { const int idx = idx0 + u * G * 512; if (idx < NTOK * 128) { const int row = idx >> 7, c8 = (idx & 127) * 8;
            const f32x4 lo = (f32x4){bflo(a[u].x) + bflo(b[u].x) + bflo(c[u].x), bfhi(a[u].x) + bfhi(b[u].x) + bfhi(c[u].x), bflo(a[u].y) + bflo(b[u].y) + bflo(c[u].y), bfhi(a[u].y) + bfhi(b[u].y) + bfhi(c[u].y)};
            const f32x4 hi = (f32x4){bflo(a[u].z) + bflo(b[u].z) + bflo(c[u].z), bfhi(a[u].z) + bfhi(b[u].z) + bfhi(c[u].z), bflo(a[u].w) + bflo(b[u].w) + bflo(c[u].w), bfhi(a[u].w) + bfhi(b[u].w) + bfhi(c[u].w)};
            v4u o; o.x = pk2(lo[0], lo[1]); o.y = pk2(lo[2], lo[3]); o.z = pk2(hi[0], hi[1]); o.w = pk2(hi[2], hi[3]);
            *(v4u*)(M + (size_t)row * 1024 + c8) = o; } }
    }
}

DI void attn_job(const Params& P, LAS unsigned char* lds, int l, int stream, int job, int tid, int lane, int wave) {
    const int Lq = stream ? 2048 : 256, Lk = stream ? 2560 : 256, nqb = Lq / 128;
    int jr = job; if ((256 % 8) == 0) { const int xcd = job & 7, idx = job >> 3; jr = xcd * 32 + idx; }
    const int qb = jr % nqb, bh = jr / nqb;
    const int qs = wave >> 1, map = wave & 1, r = lane & 31, hh = lane >> 5;
    const bf16* Q = (const bf16*)(P.ws + WS_Q + (stream ? 8 * MiB : 0)) + ((size_t)(bh * 2 + map) * Lq + qb * 128 + qs * 32 + r) * 64;
    const bf16* K = (const bf16*)(P.ws + WS_K + (stream ? 8 * MiB : 0)) + (size_t)(bh * 2) * Lk * 64;
    const bf16* VT = (const bf16*)(P.ws + WS_VT + (stream ? 8 * MiB : 0)) + (size_t)bh * 128 * Lk;
    bf16x8 qf[4];
#pragma unroll
    for (int ks = 0; ks < 4; ++ks) qf[ks] = *(const bf16x8*)(Q + 16 * ks + 8 * hh);
    constexpr int KTB = 18432, BUFB = 36864, PWOFF = 2 * BUFB;
    LAS unsigned char* pw = lds + PWOFF + wave * 4608;
    const bf16* ksrc[2]; int kdst[2]; const bf16* vsrc[2]; int vdst[2];
#pragma unroll
    for (int i = 0; i < 2; ++i) { const int idx = tid + 512 * i; const int mp = idx >> 9, key = (idx >> 3) & 63, ch = idx & 7;
        ksrc[i] = K + ((size_t)mp * Lk + key) * 64 + ch * 8; kdst[i] = mp * 9216 + key * 144 + ch * 16;
        const int dv = idx >> 3; vsrc[i] = VT + (size_t)dv * Lk + ch * 8; vdst[i] = KTB + dv * 144 + (16 * (ch >> 1) + 4 * (ch & 1)) * 2; }
    const int nkt = Lk / 64;
    v4u kr[2], vr[2];
#pragma unroll
    for (int i = 0; i < 2; ++i) { kr[i] = *(const v4u*)ksrc[i]; vr[i] = *(const v4u*)vsrc[i]; }
#pragma unroll
    for (int i = 0; i < 2; ++i) { *(LAS v4u*)(lds + kdst[i]) = kr[i]; *(LAS v2u*)(lds + vdst[i]) = (v2u){vr[i].x, vr[i].y}; *(LAS v2u*)(lds + vdst[i] + 16) = (v2u){vr[i].z, vr[i].w}; }
    __syncthreads();
    f32x16 oacc[4];
#pragma unroll
    for (int d = 0; d < 4; ++d)
#pragma unroll
        for (int i = 0; i < 16; ++i) oacc[d][i] = 0.f;
    float mrun = -1e30f, lsum = 0.f;
#pragma unroll 1
    for (int kt = 0; kt < nkt; ++kt) {
        const int buf = kt & 1; const bool more = kt + 1 < nkt;
        if (more) {
#pragma unroll
            for (int i = 0; i < 2; ++i) { kr[i] = *(const v4u*)(ksrc[i] + (size_t)(kt + 1) * 64 * 64); vr[i] = *(const v4u*)(vsrc[i] + (kt + 1) * 64); } }
        const LAS unsigned char* kt_ = lds + buf * BUFB + map * 9216; const LAS unsigned char* vt_ = lds + buf * BUFB + KTB;
        f32x16 s[2];
#pragma unroll
        for (int kh = 0; kh < 2; ++kh) {
#pragma unroll
            for (int i = 0; i < 16; ++i) s[kh][i] = 0.f;
#pragma unroll
            for (int ks = 0; ks < 4; ++ks) { const bf16x8 kf = *(const LAS bf16x8*)(kt_ + (32 * kh + r) * 144 + (16 * ks + 8 * hh) * 2); s[kh] = MFMA32(kf, qf[ks], s[kh]); }
        }
        float mx = s[0][0];
#pragma unroll
        for (int kh = 0; kh < 2; ++kh)
#pragma unroll
            for (int i = 0; i < 16; ++i) mx = fmaxf(mx, s[kh][i]);
        mx = fmaxf(mx, __shfl_xor(mx, 32));
        const float mnew = fmaxf(mrun, mx); const float alpha = __builtin_amdgcn_exp2f(mrun - mnew); mrun = mnew;
        float ps = 0.f;
#pragma unroll
        for (int kh = 0; kh < 2; ++kh)
#pragma unroll
            for (int i = 0; i < 16; ++i) { const float p = __builtin_amdgcn_exp2f(s[kh][i] - mnew); s[kh][i] = p; ps += p; }
        lsum = lsum * alpha + ps;
        if (!__all(alpha == 1.0f)) {
#pragma unroll
        for (int d = 0; d < 4; ++d)
#pragma unroll
            for (int i = 0; i < 16; ++i) oacc[d][i] *= alpha;
        }
#pragma unroll
        for (int k2 = 0; k2 < 4; ++k2) { const int kh = k2 >> 1, sb = 8 * (k2 & 1); v4u pk;
            asm volatile("v_cvt_pk_bf16_f32 %0, %4, %5\n\tv_cvt_pk_bf16_f32 %1, %6, %7\n\tv_cvt_pk_bf16_f32 %2, %8, %9\n\tv_cvt_pk_bf16_f32 %3, %10, %11\n\ts_nop 1"
                         : "=&v"(pk.x), "=&v"(pk.y), "=&v"(pk.z), "=&v"(pk.w)
                         : "v"(s[kh][sb]), "v"(s[kh][sb + 1]), "v"(s[kh][sb + 2]), "v"(s[kh][sb + 3]), "v"(s[kh][sb + 4]), "v"(s[kh][sb + 5]), "v"(s[kh][sb + 6]), "v"(s[kh][sb + 7]));
            const bf16x8 pf = __builtin_bit_cast(bf16x8, pk);
#pragma unroll
            for (int d = 0; d < 4; ++d) { const bf16x8 vf = *(const LAS bf16x8*)(vt_ + (32 * d + r) * 144 + (16 * k2 + 8 * hh) * 2); oacc[d] = MFMA32(vf, pf, oacc[d]); } }
        if (more) {
#pragma unroll
            for (int i = 0; i < 2; ++i) { *(LAS v4u*)(lds + (buf ^ 1) * BUFB + kdst[i]) = kr[i]; *(LAS v2u*)(lds + (buf ^ 1) * BUFB + vdst[i]) = (v2u){vr[i].x, vr[i].y}; *(LAS v2u*)(lds + (buf ^ 1) * BUFB + vdst[i] + 16) = (v2u){vr[i].z, vr[i].w}; } }
        __syncthreads();
    }
    lsum += __shfl_xor(lsum, 32);
    const float il = 1.f / lsum;
    LAS float* X = (LAS float*)lds + qs * 4096;
    if (map == 1) {
#pragma unroll
        for (int d = 0; d < 4; ++d)
#pragma unroll
            for (int i = 0; i < 16; ++i) { const int dv = 32 * d + (i & 3) + 8 * (i >> 2) + 4 * hh; X[dv * 32 + r] = oacc[d][i] * il; }
    }
    __syncthreads();
    if (map == 0) {
        const float lam = ((const float*)(P.ws + WS_LAM))[l]; const float lam_init = 0.8f - 0.6f * expf(-0.3f * (float)l);
        float ss = 0.f;
#pragma unroll
        for (int d = 0; d < 4; ++d)
#pragma unroll
            for (int i = 0; i < 16; ++i) { const int dv = 32 * d + (i & 3) + 8 * (i >> 2) + 4 * hh; const float o = oacc[d][i] * il - lam * X[dv * 32 + r]; oacc[d][i] = o; ss += o * o; }
        ss += __shfl_xor(ss, 32);
        const float rstd = rsqrtf(ss * (1.f / 128.f) + 1e-6f) * (1.f - lam_init);
        const float* sg = P.in[23] + l * 128;
        const int b = bh >> 2, h = bh & 3; const int tok = (stream ? NPT + b * 2048 : b * 256) + qb * 128 + qs * 32 + r;
        bf16* yat = (bf16*)(P.ws + WS_ATZ) + (size_t)tok * 512 + h * 128;
#pragma unroll
        for (int d = 0; d < 4; ++d) { f32x4 ggv[4]; v2u zzv[4];
#pragma unroll
            for (int rg = 0; rg < 4; ++rg) { const int dv = 32 * d + 8 * rg + 4 * hh; ggv[rg] = *(const f32x4*)(sg + dv); zzv[rg] = *(const v2u*)(yat + dv); }
#pragma unroll
            for (int rg = 0; rg < 4; ++rg) { const int dv = 32 * d + 8 * rg + 4 * hh; const f32x4 gg = ggv[rg]; const v2u zz = zzv[rg];
                v2u w; w.x = pk2(oacc[d][4 * rg] * rstd * gg[0] * bflo(zz.x), oacc[d][4 * rg + 1] * rstd * gg[1] * bfhi(zz.x));
                w.y = pk2(oacc[d][4 * rg + 2] * rstd * gg[2] * bflo(zz.y), oacc[d][4 * rg + 3] * rstd * gg[3] * bfhi(zz.y));
                *(v2u*)(yat + dv) = w; } }
    }
    __syncthreads();
}

template <int HALF>
DI void pool_means(const bf16* col2, int ts, int t0, int L, LAS bf16* Mt, int cp) {
    unsigned raw[48];
#pragma unroll
    for (int i = 8 - HALF; i < 40 + HALF; ++i) { const int tau = ts - 8 + i; const int tc = tau < 0 ? 0 : (tau >= L ? L - 1 : tau); const unsigned v = *(const unsigned*)(col2 + (size_t)tc * 512); raw[i] = (tau >= 0 && tau < L) ? v : 0u; }
    float s0 = 0.f, s1 = 0.f;
#pragma unroll
    for (int i = 8 - HALF; i < 8 + HALF; ++i) { s0 += bflo(raw[i]); s1 += bfhi(raw[i]); }
#pragma unroll
    for (int k = 0; k < 32; ++k) { const int t = ts + k; const int lo = t - HALF < 0 ? 0 : t - HALF, hi = t + HALF > L ? L : t + HALF; const float rc = 1.f / (float)(hi - lo);
        *(LAS unsigned*)(Mt + (t - t0) * 136 + 2 * cp) = pk2(s0 * rc - bflo(raw[k + 8]), s1 * rc - bfhi(raw[k + 8]));
        s0 += bflo(raw[k + 8 + HALF]) - bflo(raw[k + 8 - HALF]); s1 += bfhi(raw[k + 8 + HALF]) - bfhi(raw[k + 8 - HALF]); }
}
DI void pool_job(const Params& P, LAS unsigned char* lds, int l, int job, int tid, int lane, int wave) {
    const int tile = 8 * (job & 7) + ((job >> 3) & 7), g = job >> 6;
    const int tok0 = tile * 256; int t0, L; if (tile < 32) { t0 = 0; L = 256; } else { t0 = (tok0 - NPT) & 2047; L = 2048; }
    const bf16* plu = (const bf16*)(P.ws + WS_PLU); bf16* plz = (bf16*)(P.ws + WS_PLZ);
    LAS bf16* Mt = (LAS bf16*)lds; LAS bf16* PW = (LAS bf16*)(lds + 69632);
    { const bf16* src = (const bf16*)(P.ws + WS_POOLT) + (size_t)g * 16384;
      v4u t[4];
#pragma unroll
      for (int i = 0; i < 4; ++i) { const int q = tid + 512 * i; t[i] = *(const v4u*)(src + (q >> 4) * 128 + (q & 15) * 8); }
#pragma unroll
      for (int i = 0; i < 4; ++i) { const int q = tid + 512 * i; *(LAS v4u*)(PW + (q >> 4) * 136 + (q & 15) * 8) = t[i]; } }
    { const int cp = tid & 63, seg = tid >> 6; const bf16* col2 = plu + (size_t)(tok0 - t0) * 512 + g * 128 + 2 * cp;
      const int ts = t0 + seg * 32;
      if (g == 0) pool_means<1>(col2, ts, t0, L, Mt, cp); else if (g == 1) pool_means<2>(col2, ts, t0, L, Mt, cp); else if (g == 2) pool_means<4>(col2, ts, t0, L, Mt, cp); else pool_means<8>(col2, ts, t0, L, Mt, cp); }
    __syncthreads();
    const int r = lane & 31, hh = lane >> 5;
    f32x16 acc[4];
#pragma unroll
    for (int mb = 0; mb < 4; ++mb)
#pragma unroll
        for (int i = 0; i < 16; ++i) acc[mb][i] = 0.f;
#pragma unroll
    for (int ks = 0; ks < 8; ++ks) { const bf16x8 bfr = *(const LAS bf16x8*)(Mt + (32 * wave + r) * 136 + 16 * ks + 8 * hh);
#pragma unroll
        for (int mb = 0; mb < 4; ++mb) { const bf16x8 af = *(const LAS bf16x8*)(PW + (32 * mb + r) * 136 + 16 * ks + 8 * hh); acc[mb] = MFMA32(af, bfr, acc[mb]); } }
#pragma unroll
    for (int mb = 0; mb < 4; ++mb)
#pragma unroll
        for (int rg = 0; rg < 4; ++rg) { v2u w; w.x = pk2(acc[mb][4 * rg], acc[mb][4 * rg + 1]); w.y = pk2(acc[mb][4 * rg + 2], acc[mb][4 * rg + 3]);
            *(LAS v2u*)(Mt + (32 * wave + r) * 136 + 32 * mb + 8 * rg + 4 * hh) = w; }
    __syncthreads();
    { const float* psc = P.in[25] + l * 512 + g * 128; const int ch8 = (tid & 15) * 8; const f32x4 sc0 = *(const f32x4*)(psc + ch8), sc1 = *(const f32x4*)(psc + ch8 + 4);
      bf16* gp = plz + (size_t)tok0 * 512 + g * 128 + ch8; v4u zz[8];
#pragma unroll
      for (int i = 0; i < 8; ++i) { const int row = (tid >> 4) + 32 * i; zz[i] = *(const v4u*)(gp + (size_t)row * 512); }
#pragma unroll
      for (int i = 0; i < 8; ++i) { const int row = (tid >> 4) + 32 * i; const v4u d = *(const LAS v4u*)(Mt + row * 136 + ch8); const v4u z = zz[i];
          v4u o; o.x = pk2(bflo(d.x) * sc0[0] * bflo(z.x), bfhi(d.x) * sc0[1] * bfhi(z.x)); o.y = pk2(bflo(d.y) * sc0[2] * bflo(z.y), bfhi(d.y) * sc0[3] * bfhi(z.y));
          o.z = pk2(bflo(d.z) * sc1[0] * bflo(z.z), bfhi(d.z) * sc1[1] * bfhi(z.z)); o.w = pk2(bflo(d.w) * sc1[2] * bflo(z.w), bfhi(d.w) * sc1[3] * bfhi(z.w));
          *(v4u*)(gp + (size_t)row * 512) = o; } }
    __syncthreads();
}

#ifndef GALIGN
#define GALIGN true
#endif
#ifndef GSP2
#define GSP2 true
#endif
#ifndef PROBE_MASK
#define PROBE_MASK 0
#define PROBE_JOB 0
#endif
#define GSYNC() do { if (nts == 1 && P.ws == nullptr) grid.sync();   { XcdBarrier xb_; xb_.bar = (unsigned*)(P.ws + WS_BAR); xb_.x = xb_xcc_id(); xb_.st = (volatile LAS unsigned*)(lds + LDS_BYTES - 64); xcd_barrier(xb_); } if (PROBE_MASK != 0 && blockIdx.x == 0 && threadIdx.x == 0) { ((unsigned long long*)(P.ws + 8192))[nts] = __builtin_amdgcn_s_memrealtime(); } ++nts; } while (0)
__global__ void __launch_bounds__(512, 2) mk_fwd(Params P) {
    extern __shared__ __attribute__((aligned(16))) unsigned char lds_raw[];
    LAS unsigned char* lds = (LAS unsigned char*)lds_raw;
    cg::grid_group grid = cg::this_grid();
#define TLW() int tid_l = threadIdx.x; asm volatile("" : "+v"(tid_l)); const int tid = tid_l, lane = tid & 63, wave = __builtin_amdgcn_readfirstlane(tid >> 6); (void)lane; (void)wave
    const int G = gridDim.x, bid = blockIdx.x;
    unsigned char* ws = P.ws; int nts = 1; unsigned long long jtot = 0;
    volatile LAS unsigned* xst = (volatile LAS unsigned*)(lds + LDS_BYTES - 64);
    if (threadIdx.x < 16) xst[threadIdx.x] = 0u;
    __syncthreads();
    (void)xcd_barrier_post((unsigned*)(P.ws + WS_BAR), xst);
    if (PROBE_MASK != 0 && blockIdx.x == 0 && threadIdx.x == 0) ((unsigned long long*)(P.ws + 8192))[0] = __builtin_amdgcn_s_memrealtime();
#ifndef NO_PA
    { TLW(); phase_a(P, lds, tid, bid, G); }
#endif
    GSYNC();
#pragma unroll 1
    for (int l = 0; l < 2; ++l) {
        const float* xP = l == 0 ? P.in[0] : P.out; const float* xS = l == 0 ? P.in[1] : P.out + (size_t)NPT * 1024;
#ifndef NO_P0
        { TLW(); phase_p0(P, lds, l, xP, xS, tid, lane, wave, bid, G); }
#endif
        GSYNC();
        {
            { pg8::Gemm g{(const pg8::bf16_t*)(ws + WS_WINT), (const pg8::bf16_t*)(ws + WS_H), 2048, NTOK, 1024}; pg8::StaticOrder S; S.init(2048, NTOK, G, bid);
              EpiHyT E{(bf16*)(ws + WS_HYT)};
#ifndef NO_G1
              pg8::gemm_phase<EpiHyT, pg8::StaticOrder, GALIGN, GSP2>(lds, g, S, E);
#endif
 }
            { pg8::Gemm g{(const pg8::bf16_t*)(ws + WS_H), (const pg8::bf16_t*)(ws + WS_WINT) + (size_t)2048 * 1024, NTOK, 3072, 1024}; pg8::StaticOrder S; S.init(NTOK, 3072, G, bid);
              EpiB E{l, P.in[19] + l * 64, P.in[20] + l * 64, (const float*)(ws + WS_ROPE), (const float*)(ws + WS_ROPE) + 2048 * 32, ws, P.out + (size_t)2 * NPT * 1024, P.out + (size_t)3 * NPT * 1024};
#ifndef NO_G2
              pg8::gemm_phase<EpiB, pg8::StaticOrder, GALIGN, GSP2>(lds, g, S, E);
#endif
 }
        }
        GSYNC();
        {
            for (int j = bid; j < 1792; j += G) { TLW();
                const int jtype = j < 256 ? 5 : j < 512 ? 1 : j < 1024 ? 2 : j < 1536 ? 3 : 4; unsigned long long jt0 = 0; if (PROBE_JOB == jtype) jt0 = __builtin_amdgcn_s_memrealtime();
#ifndef NO_MIX
                if (j < 256) pool_job(P, lds, l, j, tid, lane, wave);
                else if (j < 512) attn_job(P, lds, l, 1, j - 256, tid, lane, wave);
                else if (j < 1024) hyena_job(P, lds, l, 1, j - 512, tid, lane, wave);
                else if (j < 1536) hyena_job(P, lds, l, 0, j - 1024, tid, lane, wave);
                else attn_job(P, lds, l, 0, j - 1536, tid, lane, wave);
#endif
                if (PROBE_JOB == jtype) jtot += __builtin_amdgcn_s_memrealtime() - jt0;
            }
        }
        GSYNC();
        { TLW(); yhy_transpose(P, lds, lane, wave, bid, G); }
        GSYNC();
        { pg8::Gemm g{(const pg8::bf16_t*)(ws + WS_YHY), (const pg8::bf16_t*)(ws + WS_WOT), 3 * NTOK, 3072, 512}; BrOrder S{G, bid};
          EpiBr E{(bf16*)(ws + WS_BBUF)};
#ifndef NO_G3
 pg8::gemm_phase<EpiBr, BrOrder, GALIGN, GSP2>(lds, g, S, E);
#endif
 }
        if (G != 256) GSYNC(); else { asm volatile("s_waitcnt vmcnt(0)" ::: "memory"); __syncthreads(); }
        { pg8::Gemm g{(const pg8::bf16_t*)(ws + WS_H), (const pg8::bf16_t*)(ws + WS_WINT) + (size_t)5120 * 1024, NTOK, 3072, 1024}; pg8::StaticOrder S; S.init(NTOK, 3072, G, bid);
          EpiGate E{(const bf16*)(ws + WS_BBUF), (bf16*)(ws + WS_MERGED)};
#ifndef NO_G4
 pg8::gemm_phase<EpiGate, pg8::StaticOrder, GALIGN, GSP2>(lds, g, S, E);
#endif
 }
        GSYNC();
        { pg8::Gemm g{(const pg8::bf16_t*)(ws + WS_MERGED), (const pg8::bf16_t*)(ws + WS_WOUT3), NTOK, 1024, 1024}; pg8::StaticOrder S; S.init(NTOK, 1024, G, bid);
          EpiOut E{xP, xS, P.out, (const float*)(ws + WS_MOD) + l * 5 * 3072}; pg8::gemm_phase<EpiOut, pg8::StaticOrder, GALIGN, GSP2>(lds, g, S, E); }
        if (l == 0 || PROBE_MASK != 0) GSYNC();
    }
    if (PROBE_MASK != 0 && blockIdx.x == 0 && threadIdx.x == 0) {
        const unsigned long long* ts = (const unsigned long long*)(P.ws + 8192); unsigned long long tot = 0;
        for (int i = 0; i < 15; ++i) if ((PROBE_MASK >> i) & 1) tot += ts[i + 1] - ts[i];
        if (PROBE_JOB != 0) tot = jtot;
        P.out[0] += (float)tot * (1e-5f * 4.0f);
    }
}

extern "C" void kernel_launch(void* const* d_in, const int* in_sizes, int n_in, void* d_out, int out_size, void* d_ws, size_t ws_size, hipStream_t stream) {
    static int grid = 0;
    if (grid == 0) {
        if (n_in != 30 || ws_size < WS_END) { fprintf(stderr, "kernel_launch: unexpected n_in %d / ws_size %zu\n", n_in, ws_size); grid = -1; return; }
        int dev = 0, cus = 0, per_cu = 0;
        hipGetDevice(&dev); hipDeviceGetAttribute(&cus, hipDeviceAttributeMultiprocessorCount, dev);
        if (hipFuncSetAttribute((const void*)mk_fwd, hipFuncAttributeMaxDynamicSharedMemorySize, LDS_BYTES) != hipSuccess) { fprintf(stderr, "kernel_launch: hipFuncSetAttribute failed\n"); grid = -1; return; }
        if (hipOccupancyMaxActiveBlocksPerMultiprocessor(&per_cu, (const void*)mk_fwd, 512, LDS_BYTES) != hipSuccess || per_cu < 1) { fprintf(stderr, "kernel_launch: occupancy query says %d\n", per_cu); per_cu = 1; }
        (void)hipGetLastError();
        grid = cus * per_cu;
    }
    if (grid < 0) return;
    if (hipMemsetAsync((char*)d_ws + WS_BAR, 0, 16384, stream) != hipSuccess) { fprintf(stderr, "kernel_launch: hipMemsetAsync failed\n"); return; }
    Params p{};
    for (int i = 0; i < 30; ++i) p.in[i] = (const float*)d_in[i];
    p.out = (float*)d_out; p.ws = (unsigned char*)d_ws;
    void* args[] = {&p};
    hipError_t e = hipLaunchCooperativeKernel((const void*)mk_fwd, dim3(grid), dim3(512), args, LDS_BYTES, stream);
    if (e != hipSuccess) fprintf(stderr, "cooperative launch failed: %s (grid %d)\n", hipGetErrorString(e), grid);
}
```
